# Optimizing an MI355X kernel written in HIP

```python
import math
import jax, jax.numpy as jnp
from jax import lax
import numpy as np

D_MODEL = 1024
BATCH = 16
SEQ = 4096
DEPTH = 1

HEAD_DIM = 64
N_DIFF_HEADS = D_MODEL // 2 // (2 * HEAD_DIM)
DIFF_WIDTH = N_DIFF_HEADS * 2 * HEAD_DIM
N_DIL_HEADS = D_MODEL // 2 // HEAD_DIM
DIL_WIDTH = N_DIL_HEADS * HEAD_DIM
MIX_WIDTH = DIFF_WIDTH + DIL_WIDTH
DIL_PATTERNS = ((128, 1), (512, 4), (2048, 16))
N_BUCKETS = 32
REL_MAX_DIST = 1024
Q_BLOCK = 128
N_EXPERTS = 16
EC_K = 2
D_FF = 256 * ((8 * D_MODEL // 3 + 255) // 256)
NORM_EPS = 1e-6
SUBLN_EPS = 1e-5
NEG = -1e30

kernel_name = 'hybrid_diffattn_dilated_ec_moe_encoder'


def rms_norm(x, g, eps=NORM_EPS):
    xf = x.astype(jnp.float32)
    y = xf * lax.rsqrt(jnp.mean(xf * xf, axis=-1, keepdims=True) + eps)
    return (y * g.astype(jnp.float32)).astype(x.dtype)


def t5_bucket(rel):
    half = N_BUCKETS // 2
    max_exact = half // 2
    n = jnp.abs(rel)
    nf = jnp.maximum(n, 1).astype(jnp.float32)
    large = max_exact + (jnp.log(nf / max_exact) / math.log(REL_MAX_DIST / max_exact)
                         * (half - max_exact)).astype(jnp.int32)
    large = jnp.minimum(large, half - 1)
    return jnp.where(rel > 0, half, 0) + jnp.where(n < max_exact, n, large)


def diff_attention(qa, ka, va, lam, lambda_init, subln_g, bias_a):
    B, S = qa.shape[:2]
    H = N_DIFF_HEADS
    q = qa.reshape(B, S, H, 2, HEAD_DIM) * (HEAD_DIM ** -0.5)
    k = ka.reshape(B, S, H, 2, HEAD_DIM)
    k1 = k[:, :, :, 0].transpose(0, 2, 1, 3)
    k2 = k[:, :, :, 1].transpose(0, 2, 1, 3)
    v = va.reshape(B, S, H, 2 * HEAD_DIM).transpose(0, 2, 1, 3)
    n_blk = S // Q_BLOCK

    def to_qblocks(t):
        return t.reshape(B, n_blk, Q_BLOCK, H, HEAD_DIM).transpose(1, 0, 3, 2, 4)

    q1b = to_qblocks(q[:, :, :, 0])
    q2b = to_qblocks(q[:, :, :, 1])
    kpos = jnp.arange(S, dtype=jnp.int32)

    def block(args):
        j, q1, q2 = args
        qpos = j * Q_BLOCK + jnp.arange(Q_BLOCK, dtype=jnp.int32)
        bias = jnp.take(bias_a, t5_bucket(kpos[None, :] - qpos[:, None]), axis=0)
        bias = bias.transpose(2, 0, 1).astype(jnp.float32)[None]
        s1 = jnp.einsum('bhqd,bhkd->bhqk', q1, k1).astype(jnp.float32) + bias
        s2 = jnp.einsum('bhqd,bhkd->bhqk', q2, k2).astype(jnp.float32) + bias
        p = jax.nn.softmax(s1, axis=-1) - lam * jax.nn.softmax(s2, axis=-1)
        return jnp.einsum('bhqk,bhkd->bhqd', p.astype(v.dtype), v)

    o = lax.map(block, (jnp.arange(n_blk, dtype=jnp.int32), q1b, q2b))
    o = o.transpose(1, 0, 3, 2, 4).reshape(B, S, H, 2 * HEAD_DIM)
    o = rms_norm(o, subln_g, SUBLN_EPS) * (1.0 - lambda_init)
    return o.reshape(B, S, DIFF_WIDTH)


def dilated_pattern(q, k, v, window, dil, bias_b):
    B, S, H, Dh = q.shape
    half = window // (2 * dil)
    blk = half
    unit = dil * blk
    sp = -(-S // unit) * unit
    m_len = sp // dil
    nb = m_len // blk

    def to_blocks(t):
        t = jnp.pad(t, ((0, 0), (0, sp - S), (0, 0), (0, 0)))
        t = t.reshape(B, m_len, dil, H, Dh).transpose(0, 2, 3, 1, 4)
        return t.reshape(B, dil, H, nb, blk, Dh)

    def with_neighbours(t):
        tp = jnp.pad(t, ((0, 0), (0, 0), (0, 0), (1, 1), (0, 0), (0, 0)))
        return jnp.concatenate([tp[:, :, :, :-2], tp[:, :, :, 1:-1], tp[:, :, :, 2:]], axis=4)

    qb = to_blocks(q * (Dh ** -0.5))
    kn = with_neighbours(to_blocks(k))
    vn = with_neighbours(to_blocks(v))
    off = (jnp.arange(3 * blk, dtype=jnp.int32)[None, :] - blk
           - jnp.arange(blk, dtype=jnp.int32)[:, None])
    in_band = jnp.abs(off) <= half
    m_key = (jnp.arange(nb, dtype=jnp.int32)[:, None] * blk
             + jnp.arange(3 * blk, dtype=jnp.int32)[None, :] - blk)
    pos_key = m_key[None] * dil + jnp.arange(dil, dtype=jnp.int32)[:, None, None]
    key_ok = (m_key >= 0)[None] & (pos_key < S)
    mask = key_ok[:, :, None, :] & in_band[None, None]
    bias = jnp.take(bias_b, t5_bucket(off * dil), axis=0).transpose(2, 0, 1).astype(jnp.float32)
    s = jnp.einsum('brhnqd,brhnkd->brhnqk', qb, kn).astype(jnp.float32) + bias[None, None, :, None]
    s = jnp.where(mask[None, :, None], s, NEG)
    lse = jax.nn.logsumexp(s, axis=-1)
    p = jnp.exp(s - lse[..., None])
    o = jnp.einsum('brhnqk,brhnkd->brhnqd', p.astype(v.dtype), vn)
    o = o.reshape(B, dil, H, m_len, Dh).transpose(0, 3, 1, 2, 4).reshape(B, sp, H, Dh)[:, :S]
    lse = lse.reshape(B, dil, H, m_len).transpose(0, 3, 1, 2).reshape(B, sp, H)[:, :S]
    return o, lse


def dilated_attention(qd, kd, vd, bias_b):
    B, S = qd.shape[:2]
    q = qd.reshape(B, S, N_DIL_HEADS, HEAD_DIM)
    k = kd.reshape(B, S, N_DIL_HEADS, HEAD_DIM)
    v = vd.reshape(B, S, N_DIL_HEADS, HEAD_DIM)
    outs, lses = [], []
    for window, dil in DIL_PATTERNS:
        o, lse = dilated_pattern(q, k, v, window, dil, bias_b)
        outs.append(o)
        lses.append(lse)
    w = jax.nn.softmax(jnp.stack(lses, axis=0), axis=0)
    o = jnp.sum(w[..., None] * jnp.stack(outs, axis=0).astype(jnp.float32), axis=0)
    return o.astype(qd.dtype).reshape(B, S, DIL_WIDTH)


def expert_choice_ffn(h, w_router, w_gate, w_up, w_down):
    B, S, D = h.shape
    cap = EC_K * S // N_EXPERTS
    aff = jax.nn.softmax((h @ w_router).astype(jnp.float32), axis=-1)
    g, idx = lax.top_k(aff.transpose(0, 2, 1), cap)
    g = g.transpose(1, 0, 2)
    idx = idx.transpose(1, 0, 2)
    b_rows = jnp.arange(B, dtype=jnp.int32)[:, None]

    def run_expert(args):
        wg, wu, wd, ie, ge = args
        xe = h[b_rows, ie]
        he = jax.nn.silu(xe @ wg) * (xe @ wu)
        return (he @ wd) * ge[..., None].astype(h.dtype)

    ye = lax.map(run_expert, (w_gate, w_up, w_down, idx, g))
    b_idx = jnp.arange(B, dtype=jnp.int32)[None, :, None]
    return jnp.zeros_like(h).at[b_idx, idx].add(ye)


def setup_inputs(seed: int = 0) -> dict:
    key = jax.random.key(seed)
    ks = jax.random.split(key, 16)
    f = jnp.float32
    n_in = 3 * DIFF_WIDTH + 3 * DIL_WIDTH
    nrm = lambda k, shape, s: jax.random.normal(k, shape, f) * s
    return {
        'x': nrm(ks[0], (BATCH, SEQ, D_MODEL), 1.0),
        'norm1_g': 1.0 + nrm(ks[1], (DEPTH, D_MODEL), 0.02),
        'w_in': nrm(ks[2], (DEPTH, D_MODEL, n_in), D_MODEL ** -0.5),
        'lam_q1': nrm(ks[3], (DEPTH, HEAD_DIM), 0.1),
        'lam_k1': nrm(ks[4], (DEPTH, HEAD_DIM), 0.1),
        'lam_q2': nrm(ks[5], (DEPTH, HEAD_DIM), 0.1),
        'lam_k2': nrm(ks[6], (DEPTH, HEAD_DIM), 0.1),
        'subln_g': 1.0 + nrm(ks[7], (DEPTH, 2 * HEAD_DIM), 0.02),
        'w_out': nrm(ks[8], (DEPTH, MIX_WIDTH, D_MODEL), MIX_WIDTH ** -0.5),
        'rel_bias': nrm(ks[9], (N_BUCKETS, N_DIFF_HEADS + N_DIL_HEADS), 0.2),
        'norm2_g': 1.0 + nrm(ks[10], (DEPTH, D_MODEL), 0.02),
        'w_router': nrm(ks[11], (DEPTH, D_MODEL, N_EXPERTS), D_MODEL ** -0.5),
        'w_gate': nrm(ks[12], (DEPTH, N_EXPERTS, D_MODEL, D_FF), D_MODEL ** -0.5),
        'w_up': nrm(ks[13], (DEPTH, N_EXPERTS, D_MODEL, D_FF), D_MODEL ** -0.5),
        'w_down': nrm(ks[14], (DEPTH, N_EXPERTS, D_FF, D_MODEL), D_FF ** -0.5),
        'norm_f_g': 1.0 + nrm(ks[15], (D_MODEL,), 0.02),
    }


def reference(x, norm1_g, w_in, lam_q1, lam_k1, lam_q2, lam_k2, subln_g, w_out, rel_bias,
              norm2_g, w_router, w_gate, w_up, w_down, norm_f_g):
    splits = [DIFF_WIDTH, 2 * DIFF_WIDTH, 3 * DIFF_WIDTH,
              3 * DIFF_WIDTH + DIL_WIDTH, 3 * DIFF_WIDTH + 2 * DIL_WIDTH]
    bias_a = rel_bias[:, :N_DIFF_HEADS]
    bias_b = rel_bias[:, N_DIFF_HEADS:]
    for l in range(DEPTH):
        lambda_init = 0.8 - 0.6 * math.exp(-0.3 * l)
        h = rms_norm(x, norm1_g[l])
        proj = h @ w_in[l]
        qa, ka, va, qd, kd, vd = jnp.split(proj, splits, axis=-1)
        lam = (jnp.exp(jnp.sum(lam_q1[l].astype(jnp.float32) * lam_k1[l].astype(jnp.float32)))
               - jnp.exp(jnp.sum(lam_q2[l].astype(jnp.float32) * lam_k2[l].astype(jnp.float32)))
               + lambda_init)
        oa = diff_attention(qa, ka, va, lam, lambda_init, subln_g[l], bias_a)
        od = dilated_attention(qd, kd, vd, bias_b)
        x = x + jnp.concatenate([oa, od], axis=-1) @ w_out[l]
        x = x + expert_choice_ffn(rms_norm(x, norm2_g[l]), w_router[l], w_gate[l], w_up[l], w_down[l])
    return rms_norm(x, norm_f_g)
```

```cpp
#include <hip/hip_runtime.h>
#include <cstdio>
#include <cstdint>

#ifndef MK_MODE
#define MK_MODE 0
#endif
#ifndef MK_NAIVE_ATTN
#define MK_NAIVE_ATTN 0
#endif

#ifndef MK_DIFF2
#ifndef MK_FP6
#define MK_FP6 1
#endif
#define MK_DIFF2 0
#endif

constexpr int BATCH = 16, SEQ = 4096, DM = 1024, NTOK = BATCH * SEQ, NIN = 3072, NE = 16, CAP = 512, DFF = 2816, EROWS = BATCH * CAP;
constexpr int NDH = 4, NLH = 8;
constexpr float LOG2E = 1.4426950408889634f, QSCALE = 0.125f * LOG2E;
constexpr float NORM_EPS = 1e-6f, SUBLN_EPS = 1e-5f, LAMBDA_INIT = 0.2f;
constexpr int COL_QA = 0, COL_KA = 512, COL_VA = 1024, COL_QD = 1536, COL_KD = 2048, COL_VD = 2560;

constexpr size_t MiB = 1u << 20;
constexpr size_t WS_CTL = 0, CTL_ZERO_BYTES = 1 * MiB;
constexpr size_t WS_WIN = 2 * MiB;
constexpr size_t WS_WOUT = 8 * MiB;
constexpr size_t WS_AFF = 10 * MiB;
constexpr size_t WS_IDX = 14 * MiB;
constexpr size_t WS_GATE = 14 * MiB + 512 * 1024;
constexpr size_t WS_INV = 15 * MiB;
constexpr size_t WS_W1T = 20 * MiB;
constexpr size_t WS_W2T = 108 * MiB;
constexpr size_t WS_H1 = 160 * MiB;
constexpr size_t WS_ATT = 160 * MiB;
constexpr size_t WS_PROJ = 288 * MiB;
constexpr size_t WS_DSCR = 672 * MiB;
constexpr size_t WS_H2 = 288 * MiB;
constexpr size_t WS_XE = 352 * MiB;
constexpr size_t WS_HE = 480 * MiB;
constexpr size_t WS_YE = 160 * MiB;
constexpr size_t WS_X2 = 896 * MiB;
constexpr size_t WS_END = 1024 * MiB;
static_assert(WS_W1T + (size_t)NE * 5632 * 1024 <= WS_W2T && WS_W2T + (size_t)NE * 1024 * 2816 <= WS_H1, "weights");
static_assert(WS_H1 + (size_t)NTOK * 1024 * 2 <= WS_PROJ && WS_PROJ + (size_t)NTOK * 3072 * 2 <= WS_DSCR && WS_DSCR + (size_t)224 * MiB <= WS_X2 && WS_X2 + (size_t)NTOK * 1024 * 2 <= WS_END, "dyn");
static_assert(WS_H2 + (size_t)NTOK * 1024 <= WS_XE && WS_XE + (size_t)NE * EROWS * 1024 <= WS_HE && WS_HE + (size_t)NE * EROWS * DFF <= WS_X2 && WS_YE + (size_t)NE * EROWS * 1024 * 2 <= WS_HE, "moe");
constexpr int CW_BAR = 4096;

constexpr int RING_OFF = 0, RING_BYTES = 131072;
constexpr int LDSCTL_OFF = RING_BYTES, MISC_OFF = LDSCTL_OFF + 320;
constexpr int LDS_BYTES = 147456;
constexpr int NWAVES = 8;

namespace pg8 {
#define PG8_LAS __attribute__((address_space(3)))
typedef unsigned short bf16_t;
typedef short bf16x8 __attribute__((ext_vector_type(8)));
typedef float f32x4 __attribute__((ext_vector_type(4)));
typedef unsigned u32x4 __attribute__((ext_vector_type(4)));
typedef int i32x4 __attribute__((ext_vector_type(4)));
typedef int i32x8 __attribute__((ext_vector_type(8)));
typedef unsigned u32x2 __attribute__((ext_vector_type(2)));
constexpr int BM = 256, BK = 64, HALF = 128, HTB = HALF * BK * 2  , STAGE_BYTES = 8 * HTB, NXCD = 8, WGM = 8;

__host__ __device__ __forceinline__ int lds_byte(int r, int c) { const int st = (r >> 4) * 2 + (c >> 5), rr = r & 15, cc = c & 31, ob = rr * 64 + cc * 2; return st * 1024 + (ob ^ (((ob >> 9) & 1) << 5)); }
__host__ __device__ __forceinline__ void stage_rc(int b, int& R, int& C) { const int st = b / 1024, sb = b % 1024, swz = sb ^ (((sb >> 9) & 1) << 5); R = (st >> 1) * 16 + swz / 64; C = (st & 1) * 32 + (swz % 64) / 2; }
__host__ __device__ __forceinline__ int perm32(int rho) { const int n = rho >> 4, i = rho & 15; return 8 * (i >> 2) + 4 * n + (i & 3); }

struct Unit { int pm, pn; };
struct Gemm { const bf16_t* A; const bf16_t* Bt; int M, N, K; };

struct StaticOrder {
    int nM, nN, nwg, G, c;
    __host__ __device__ void init(int M, int N, int G_, int c_) { nM = M / BM; nN = N / BM; nwg = nM * nN; G = G_; c = c_; }
    __host__ __device__ bool next(int i, Unit& u) const {
        const long L = (long)i * G + c; if (L >= nwg) return false;
        int wgid = (int)L; { const int q = nwg / NXCD, r = nwg % NXCD, xcd = wgid % NXCD, off = wgid / NXCD; wgid = (xcd < r ? xcd * (q + 1) : r * (q + 1) + (xcd - r) * q) + off; }
        const int nig = WGM * nN, gid = wgid / nig, fm = gid * WGM, gsz = (nM - fm) < WGM ? (nM - fm) : WGM;
        u.pm = fm + ((wgid % nig) % gsz); u.pn = (wgid % nig) / gsz; return true;
    }
    __device__ __forceinline__ void a_ready(const Unit&) const {}
    __device__ __forceinline__ void done(const Unit&) const {}
};

__device__ __forceinline__ unsigned cvt_pk_bf16(float lo, float hi) { unsigned r; asm volatile("v_cvt_pk_bf16_f32 %0, %1, %2" : "=v"(r) : "v"(lo), "v"(hi)); return r; }
typedef float f32x2 __attribute__((ext_vector_type(2)));
struct MoeOrder {
    StaticOrder so; int pn_per_e;
    __device__ void init(int N, int G_, int c_) { so.init(16 * 8192, N, G_, c_); pn_per_e = N / BM; }
    __device__ bool next(int i, Unit& u) const { Unit v; if (!so.next(i, v)) return false; u.pm = v.pm; u.pn = (v.pm >> 5) * pn_per_e + v.pn; return true; }
    __device__ __forceinline__ void a_ready(const Unit&) const {}
    __device__ __forceinline__ void done(const Unit&) const {}
};
__device__ __forceinline__ float clamp448(float v) { return __builtin_fminf(__builtin_fmaxf(v, -448.f), 448.f); }
struct EpiProj {
    static constexpr bool PERM = true, AFTER_DRAIN = false;
    bf16_t* O; float qscale;
    __device__ __forceinline__ void operator()(const f32x4 (&acc)[2][2][4][2], const Unit& u, int wr, int wc, int fr, int fq) const {
        const int row0 = u.pm * BM + wr * 64 + fr, col0 = u.pn * BM + wc * 32 + 8 * fq;
        const float sc = (u.pn < 2 || u.pn == 6 || u.pn == 7) ? qscale : 1.f;
#pragma unroll
        for (int ai = 0; ai < 2; ++ai)
#pragma unroll
            for (int m = 0; m < 4; ++m) { bf16_t* rowp = O + (size_t)(row0 + ai * HALF + m * 16) * 3072 + col0;
#pragma unroll
                for (int bj = 0; bj < 2; ++bj) { const f32x4 v0 = acc[ai][bj][m][0] * sc, v1 = acc[ai][bj][m][1] * sc;
                    u32x4 w; w.x = cvt_pk_bf16(v0[0], v0[1]); w.y = cvt_pk_bf16(v0[2], v0[3]); w.z = cvt_pk_bf16(v1[0], v1[1]); w.w = cvt_pk_bf16(v1[2], v1[3]);
                    *(u32x4*)(rowp + bj * HALF) = w; } }
    }
};
struct EpiResBf16 {
    static constexpr bool PERM = true, AFTER_DRAIN = false;
    const float* base; bf16_t* out;
    __device__ __forceinline__ void operator()(const f32x4 (&acc)[2][2][4][2], const Unit& u, int wr, int wc, int fr, int fq) const {
        const int col0 = u.pn * BM + wc * 32 + 8 * fq;
#pragma unroll
        for (int ai = 0; ai < 2; ++ai)
#pragma unroll
            for (int m = 0; m < 4; ++m) { const size_t off = (size_t)(u.pm * BM + ai * HALF + wr * 64 + m * 16 + fr) * 1024 + col0;
#pragma unroll
                for (int bj = 0; bj < 2; ++bj) { const f32x4 v0 = *(const f32x4*)(base + off + bj * HALF) + acc[ai][bj][m][0], v1 = *(const f32x4*)(base + off + bj * HALF + 4) + acc[ai][bj][m][1];
                    u32x4 w; w.x = cvt_pk_bf16(v0[0], v0[1]); w.y = cvt_pk_bf16(v0[2], v0[3]); w.z = cvt_pk_bf16(v1[0], v1[1]); w.w = cvt_pk_bf16(v1[2], v1[3]);
                    *(u32x4*)(out + off + bj * HALF) = w; } }
    }
};
#ifdef EMU6
constexpr float XS8 = X6, WS8 = W6, WS8D = W6D, HS8 = H6;
__device__ __forceinline__ float q6(float t) { const float a = __builtin_fminf(__builtin_fabsf(t), 7.5f); const float st = a < 2.f ? 8.f : (a < 4.f ? 4.f : 2.f); const float r = __builtin_rintf(a * st) / st; return __builtin_copysignf(r, t); }
#elif MK_FP6
constexpr float XS8 = 2.f, WS8 = 64.f, WS8D = 128.f, HS8 = 8.f;
__device__ __forceinline__ float q6(float t) { return t; }
#else
constexpr float XS8 = 8.f, WS8 = 128.f, WS8D = 128.f, HS8 = 8.f;
__device__ __forceinline__ float q6(float t) { return t; }
#endif
struct EpiSwiGLU8 {
    static constexpr bool PERM = true, AFTER_DRAIN = false;
    unsigned char* O;
    __device__ __forceinline__ void operator()(const f32x4 (&acc)[2][2][4][2], const Unit& u, int wr, int wc, int fr, int fq) const {
        const int pnl = u.pn % 22;
        const int row0 = u.pm * BM + wr * 64 + fr, col0 = pnl * 128 + wc * 32 + 8 * fq;
        constexpr float inv = 1.f / (XS8 * WS8);
#pragma unroll
        for (int ai = 0; ai < 2; ++ai)
#pragma unroll
            for (int m = 0; m < 4; ++m) { unsigned char* rowp = O + (size_t)(row0 + ai * HALF + m * 16) * 2816 + col0;
#ifdef EPI_DUP
              for (int rep = 0; rep < 2; ++rep) {
                float rsc = 1.f; asm volatile("" : "+v"(rsc));
#endif
                float h[8];
#pragma unroll
                for (int n = 0; n < 2; ++n)
#pragma unroll
                    for (int j = 0; j < 4; j += 2) {
#ifdef EPI_DUP
                        const f32x2 ag = {acc[ai][0][m][n][j] * rsc, acc[ai][0][m][n][j + 1] * rsc}, au = {acc[ai][1][m][n][j], acc[ai][1][m][n][j + 1]};
#else
                        const f32x2 ag = {acc[ai][0][m][n][j], acc[ai][0][m][n][j + 1]}, au = {acc[ai][1][m][n][j], acc[ai][1][m][n][j + 1]};
#endif

                        const f32x2 t = ag * (-inv * 1.4426950408889634f); f32x2 d; d.x = __builtin_amdgcn_exp2f(t.x); d.y = __builtin_amdgcn_exp2f(t.y); d = d + 1.0f;
                        f32x2 r; r.x = __builtin_amdgcn_rcpf(d.x); r.y = __builtin_amdgcn_rcpf(d.y);
                        const f32x2 hv = (ag * au) * (r * (inv * inv * HS8));
                        h[n * 4 + j] = q6(__builtin_amdgcn_fmed3f(hv.x, -448.f, 448.f)); h[n * 4 + j + 1] = q6(__builtin_amdgcn_fmed3f(hv.y, -448.f, 448.f)); }
                int w0 = 0, w1 = 0;
                w0 = __builtin_amdgcn_cvt_pk_fp8_f32(h[0], h[1], w0, false); w0 = __builtin_amdgcn_cvt_pk_fp8_f32(h[2], h[3], w0, true);
                w1 = __builtin_amdgcn_cvt_pk_fp8_f32(h[4], h[5], w1, false); w1 = __builtin_amdgcn_cvt_pk_fp8_f32(h[6], h[7], w1, true);
#ifdef EPI_DUP
                if (rep == 0) { asm volatile("" :: "v"(w0), "v"(w1)); continue; }
#endif
                u32x2 w; w.x = (unsigned)w0; w.y = (unsigned)w1; *(u32x2*)rowp = w;
#ifdef EPI_DUP
              }
#endif
            }
    }
};
struct EpiDown8 {
    static constexpr bool PERM = true, AFTER_DRAIN = false;
    bf16_t* O; const float* gate;
    __device__ __forceinline__ void operator()(const f32x4 (&acc)[2][2][4][2], const Unit& u, int wr, int wc, int fr, int fq) const {
        const int pnl = u.pn & 3;
        const int row0 = u.pm * BM + wr * 64 + fr, col0 = pnl * BM + wc * 32 + 8 * fq;
#pragma unroll
        for (int ai = 0; ai < 2; ++ai)
#pragma unroll
            for (int m = 0; m < 4; ++m) { const int row = row0 + ai * HALF + m * 16; const float gt = gate[row] * (1.f / (HS8 * WS8D)); bf16_t* rowp = O + (size_t)row * 1024 + col0;
#pragma unroll
                for (int bj = 0; bj < 2; ++bj) { const f32x4 v0 = acc[ai][bj][m][0] * gt, v1 = acc[ai][bj][m][1] * gt;
                    u32x4 w; w.x = cvt_pk_bf16(v0[0], v0[1]); w.y = cvt_pk_bf16(v0[2], v0[3]); w.z = cvt_pk_bf16(v1[0], v1[1]); w.w = cvt_pk_bf16(v1[2], v1[3]);
                    *(u32x4*)(rowp + bj * HALF) = w; } }
    }
};

struct FragBf { bf16x8 v[2]; };
struct FragF8 { i32x8 v; };
template <bool F8> struct FragSel { typedef FragBf type; };
template <> struct FragSel<true> { typedef FragF8 type; };
__device__ __forceinline__ void frag_ld(FragBf& f, const PG8_LAS unsigned char* p) { f.v[0] = *(const PG8_LAS bf16x8*)p; f.v[1] = *(const PG8_LAS bf16x8*)(p + 1024); }
__device__ __forceinline__ void frag_ld(FragF8& f, const PG8_LAS unsigned char* p) { const i32x4 lo = *(const PG8_LAS i32x4*)p, hi = *(const PG8_LAS i32x4*)(p + 1024); f.v = __builtin_shufflevector(lo, hi, 0, 1, 2, 3, 4, 5, 6, 7); }
__device__ __forceinline__ f32x4 frag_mma(const FragBf& b, const FragBf& a, f32x4 c) { c = __builtin_amdgcn_mfma_f32_16x16x32_bf16(b.v[0], a.v[0], c, 0, 0, 0); return __builtin_amdgcn_mfma_f32_16x16x32_bf16(b.v[1], a.v[1], c, 0, 0, 0); }
__device__ __forceinline__ f32x4 frag_mma(const FragF8& b, const FragF8& a, f32x4 c) { asm volatile("v_mfma_f32_16x16x128_f8f6f4 %0, %1, %2, %0" : "+v"(c) : "v"(b.v), "v"(a.v)); return c; }
template <class Epi, class Sched, bool ALIGN_EPI = false, bool SP2 = false, bool F8 = false>
__device__ __forceinline__ void gemm_phase(PG8_LAS unsigned char* lds, const Gemm g, const Sched& S, const Epi& E, const int wid  ) {
    int lane; asm volatile("v_mbcnt_lo_u32_b32 %0, -1, 0\n\tv_mbcnt_hi_u32_b32 %0, -1, %0" : "=v"(lane));
    const int tid = wid * 64 + lane, wr = wid >> 2, wc = wid & 3, fr = lane & 15, fq = lane >> 4;
    const int K = g.K, nt = K / BK;
    unsigned voffA[2], voffB[2];
#pragma unroll
    for (int i = 0; i < 2; ++i) { int R, C; stage_rc(tid * 16 + i * 8192, R, C); const int Rb = Epi::PERM ? ((R & ~31) + perm32(R & 31)) : R;
        voffA[i] = (unsigned)(R * K + C) * 2u; voffB[i] = (unsigned)(Rb * K + C) * 2u; }
    const size_t kstep = (size_t)(BK * 2);
    const size_t hstep = (size_t)HALF * K * 2;
    const size_t tstep = 2 * hstep;
    const unsigned ldsw = (unsigned)wid * 1024u;
    const int aoff = lds_byte(wr * 64 + fr, fq * 8), boff = lds_byte(wc * 32 + fr, fq * 8);
#define PG8_SA(b, h) (((b) * 2 + (h)) * HTB)
#define PG8_SB(b, h) ((4 + (b) * 2 + (h)) * HTB)
#define PG8_STAGE(bufoff, gbase, voff) do { _Pragma("unroll") for (int _i = 0; _i < 2; ++_i) \
        __builtin_amdgcn_global_load_lds((const unsigned*)((const char*)(gbase) + (voff)[_i]), (PG8_LAS unsigned*)(lds + (bufoff) + ldsw + _i * 8192), 16, 0, 0); } while (0)
#define PG8_LDA(dst, b, h) do { _Pragma("unroll") for (int m = 0; m < 4; ++m) frag_ld(dst[m], lds + PG8_SA(b, h) + aoff + m * 2048); } while (0)
#define PG8_LDB(dst, b, h) do { _Pragma("unroll") for (int n = 0; n < 2; ++n) frag_ld(dst[n], lds + PG8_SB(b, h) + boff + n * 2048); } while (0)
#define PG8_MMA(ai, bj, At, Bt) do { __builtin_amdgcn_s_setprio(1); _Pragma("unroll") for (int m = 0; m < 4; ++m) _Pragma("unroll") for (int n = 0; n < 2; ++n) \
        acc[ai][bj][m][n] = frag_mma(Bt[n], At[m], acc[ai][bj][m][n]); __builtin_amdgcn_s_setprio(0); } while (0)
#define PG8_WAIT_V(n) asm volatile("s_waitcnt vmcnt(" #n ")" ::: "memory")
#define PG8_WAIT_L(n) asm volatile("s_waitcnt lgkmcnt(" #n ")" ::: "memory")
#define PG8_BAR __builtin_amdgcn_s_barrier()
#define PG8_SCHED __builtin_amdgcn_sched_barrier(0)
    Unit cur, nxt; int ui = 0;
    if (!S.next(0, cur)) return;
    f32x4 acc[2][2][4][2];
#pragma unroll
    for (int a = 0; a < 2; ++a)
#pragma unroll
        for (int b = 0; b < 2; ++b)
#pragma unroll
            for (int m = 0; m < 4; ++m)
#pragma unroll
                for (int n = 0; n < 2; ++n) acc[a][b][m][n] = (f32x4){0.f, 0.f, 0.f, 0.f};
    typename FragSel<F8>::type At[4], B0[2], B1[2];
    const char* cA = (const char*)g.A + (size_t)cur.pm * tstep; const char* cB = (const char*)g.Bt + (size_t)cur.pn * tstep;
    S.a_ready(cur);
    if constexpr (SP2) {
        PG8_STAGE(PG8_SB(0, 0), cB, voffB); PG8_STAGE(PG8_SB(0, 1), cB + hstep, voffB); PG8_STAGE(PG8_SA(0, 0), cA, voffA); PG8_STAGE(PG8_SA(0, 1), cA + hstep, voffA);
        if (wr == 1) PG8_BAR;
        PG8_WAIT_V(2); PG8_BAR;
        PG8_STAGE(PG8_SB(1, 0), cB + kstep, voffB); PG8_STAGE(PG8_SA(1, 0), cA + kstep, voffA); PG8_STAGE(PG8_SB(1, 1), cB + hstep + kstep, voffB);
        PG8_WAIT_V(6); PG8_BAR;
    } else {
        PG8_STAGE(PG8_SB(0, 0), cB, voffB); PG8_STAGE(PG8_SA(0, 0), cA, voffA); PG8_STAGE(PG8_SB(0, 1), cB + hstep, voffB); PG8_STAGE(PG8_SA(0, 1), cA + hstep, voffA);
        if (wr == 1) PG8_BAR;
        PG8_WAIT_V(4); PG8_BAR;
        PG8_STAGE(PG8_SB(1, 0), cB + kstep, voffB); PG8_STAGE(PG8_SA(1, 0), cA + kstep, voffA); PG8_STAGE(PG8_SB(1, 1), cB + hstep + kstep, voffB);
        PG8_WAIT_V(6); PG8_BAR;
    }
    for (;;) {
        const bool has_next = S.next(ui + 1, nxt);
        const char* nA = has_next ? (const char*)g.A + (size_t)nxt.pm * tstep : cA; const char* nB = has_next ? (const char*)g.Bt + (size_t)nxt.pn * tstep : cB;
        for (int t = 0; t < nt; t += 2) {
            const bool last = (t == nt - 2);
            const char* a1 = cA + (size_t)(t + 1) * kstep;
            const char* a2 = last ? nA : cA + (size_t)(t + 2) * kstep; const char* b2 = last ? nB : cB + (size_t)(t + 2) * kstep;
            const char* a3 = a2 + kstep; const char* b3 = b2 + kstep;
            if (last && has_next) S.a_ready(nxt);
            if constexpr (SP2) {
            PG8_LDB(B0, 0, 0); PG8_LDB(B1, 0, 1); PG8_SCHED; PG8_LDA(At, 0, 0); PG8_STAGE(PG8_SA(1, 1), a1 + hstep, voffA);
            PG8_WAIT_V(8); PG8_WAIT_L(0); PG8_BAR; PG8_MMA(0, 0, At, B0); PG8_MMA(0, 1, At, B1); PG8_BAR; PG8_SCHED;
            PG8_LDA(At, 0, 1); PG8_STAGE(PG8_SB(0, 0), b2, voffB); PG8_STAGE(PG8_SB(0, 1), b2 + hstep, voffB); PG8_STAGE(PG8_SA(0, 0), a2, voffA);
            PG8_WAIT_V(8); PG8_WAIT_L(0); PG8_BAR; PG8_MMA(1, 0, At, B0); PG8_MMA(1, 1, At, B1); PG8_BAR; PG8_SCHED;
            PG8_LDB(B0, 1, 0); PG8_LDB(B1, 1, 1); PG8_SCHED; PG8_LDA(At, 1, 0); PG8_STAGE(PG8_SA(0, 1), a2 + hstep, voffA);
            PG8_WAIT_V(8); PG8_WAIT_L(0); PG8_BAR; PG8_MMA(0, 0, At, B0); PG8_MMA(0, 1, At, B1); PG8_BAR; PG8_SCHED;
            PG8_LDA(At, 1, 1); PG8_STAGE(PG8_SB(1, 0), b3, voffB); PG8_STAGE(PG8_SB(1, 1), b3 + hstep, voffB); PG8_STAGE(PG8_SA(1, 0), a3, voffA);
            PG8_WAIT_V(8); PG8_WAIT_L(0); PG8_BAR; PG8_MMA(1, 0, At, B0); PG8_MMA(1, 1, At, B1); PG8_BAR; PG8_SCHED;
            } else {
            PG8_LDB(B0, 0, 0); PG8_SCHED; PG8_LDA(At, 0, 0); PG8_STAGE(PG8_SA(1, 1), a1 + hstep, voffA);
            PG8_WAIT_L(8); PG8_BAR; PG8_WAIT_L(0); PG8_MMA(0, 0, At, B0); PG8_BAR; PG8_SCHED;
            PG8_LDB(B1, 0, 1); PG8_STAGE(PG8_SB(0, 0), b2, voffB);
            PG8_BAR; PG8_WAIT_L(0); PG8_MMA(0, 1, At, B1); PG8_BAR;
            PG8_LDA(At, 0, 1); PG8_STAGE(PG8_SA(0, 0), a2, voffA);
            PG8_BAR; PG8_WAIT_L(0); PG8_MMA(1, 0, At, B0); PG8_BAR; PG8_SCHED;
            PG8_STAGE(PG8_SB(0, 1), b2 + hstep, voffB);
            PG8_WAIT_V(6); PG8_BAR; PG8_MMA(1, 1, At, B1); PG8_BAR;
            PG8_LDB(B0, 1, 0); PG8_SCHED; PG8_LDA(At, 1, 0); PG8_STAGE(PG8_SA(0, 1), a2 + hstep, voffA);
            PG8_WAIT_L(8); PG8_BAR; PG8_WAIT_L(0); PG8_MMA(0, 0, At, B0); PG8_BAR; PG8_SCHED;
            PG8_LDB(B1, 1, 1); PG8_STAGE(PG8_SB(1, 0), b3, voffB);
            PG8_BAR; PG8_WAIT_L(0); PG8_MMA(0, 1, At, B1); PG8_BAR;
            PG8_LDA(At, 1, 1); PG8_STAGE(PG8_SA(1, 0), a3, voffA);
            PG8_BAR; PG8_WAIT_L(0); PG8_MMA(1, 0, At, B0); PG8_BAR; PG8_SCHED;
            PG8_STAGE(PG8_SB(1, 1), b3 + hstep, voffB);
            PG8_WAIT_V(6); PG8_BAR; PG8_MMA(1, 1, At, B1); PG8_BAR;
            }
        }
        if constexpr (F8) asm volatile("s_nop 15\n\ts_nop 7" ::: "memory");
        if constexpr (ALIGN_EPI) { if (wr == 0) PG8_BAR; }
        if constexpr (!Epi::AFTER_DRAIN) { E(acc, cur, wr, wc, fr, fq); S.done(cur); }
        if (!has_next) break;
#pragma unroll
        for (int a = 0; a < 2; ++a)
#pragma unroll
            for (int b = 0; b < 2; ++b)
#pragma unroll
                for (int m = 0; m < 4; ++m)
#pragma unroll
                    for (int n = 0; n < 2; ++n) acc[a][b][m][n] = (f32x4){0.f, 0.f, 0.f, 0.f};
        cur = nxt; cA = nA; cB = nB; ++ui;
        if constexpr (ALIGN_EPI) { if (wr == 1) PG8_BAR; }
    }
    PG8_WAIT_V(0);
    if constexpr (!ALIGN_EPI) { if (wr == 0) PG8_BAR; }
    PG8_BAR;
    if constexpr (Epi::AFTER_DRAIN) { E.fused(acc, cur, wr, wc, fr, fq, lds, wid, lane); S.done(cur); }
#undef PG8_SA
#undef PG8_SB
#undef PG8_STAGE
#undef PG8_LDA
#undef PG8_LDB
#undef PG8_MMA
#undef PG8_WAIT_V
#undef PG8_WAIT_L
#undef PG8_BAR
#undef PG8_SCHED
}

typedef unsigned u32x6 __attribute__((ext_vector_type(6)));
__device__ __forceinline__ f32x4 mma6(const u32x6& b, const u32x6& a, f32x4 c) { asm volatile("v_mfma_f32_16x16x128_f8f6f4 %0, %1, %2, %0 cbsz:2 blgp:2" : "+v"(c) : "v"(b), "v"(a)); return c; }
constexpr int F6_BLOCK = 24576, F6_KT = 8  , F6_BUF = 49152;
__host__ __device__ __forceinline__ int f6_p_off(int r, int fq) { return (r >> 4) * 1024 + (r & 15) * 64 + ((fq ^ (((r & 15) >> 3) << 1)) * 16); }
__host__ __device__ __forceinline__ int f6_q_off(int r, int fq) { return (r >> 4) * 512 + (r & 15) * 32 + ((fq ^ (((r & 15) >> 3) << 1)) * 8); }
template <class Epi, class Sched, bool ALIGN_EPI>
__device__ __forceinline__ void gemm_phase6(PG8_LAS unsigned char* lds, const unsigned char* Aimg, const unsigned char* Bimg, const Sched& S, const Epi& E, const int wid) {
    int lane; asm volatile("v_mbcnt_lo_u32_b32 %0, -1, 0\n\tv_mbcnt_hi_u32_b32 %0, -1, %0" : "=v"(lane));
    const int wr = wid >> 2, wc = wid & 3, fr = lane & 15, fq = lane >> 4;
    const unsigned goff = (unsigned)(wid * 1024 + lane * 16);
    const unsigned ldsw = (unsigned)wid * 1024u;
    const size_t kstep = F6_BLOCK, tstep = (size_t)F6_KT * F6_BLOCK;
    const int pa = f6_p_off(wr * 64 + fr, fq), qa = f6_q_off(wr * 64 + fr, fq), pb = f6_p_off(wc * 32 + fr, fq), qb = f6_q_off(wc * 32 + fr, fq);
#define F6_AP(b, h) ((b) * F6_BUF + (h) * 8192)
#define F6_BP(b, h) ((b) * F6_BUF + 16384 + (h) * 8192)
#define F6_AQ(b) ((b) * F6_BUF + 32768)
#define F6_BQ(b) ((b) * F6_BUF + 40960)
#define F6_ST(ldsoff, gptr) __builtin_amdgcn_global_load_lds((const unsigned*)((const char*)(gptr) + goff), (PG8_LAS unsigned*)(lds + (ldsoff) + ldsw), 16, 0, 0)
#define F6_STAGE_X(b, ga, gb) do { F6_ST(F6_BP(b, 0), (gb)); F6_ST(F6_BP(b, 1), (gb) + 8192); F6_ST(F6_BQ(b), (gb) + 16384); F6_ST(F6_AQ(b), (ga) + 16384); F6_ST(F6_AP(b, 0), (ga)); } while (0)
#define F6_STAGE_Y(b, ga) F6_ST(F6_AP(b, 1), (ga) + 8192)
#define F6_FRAG(dst, poff, qoff) do { const u32x4 _lo = *(const PG8_LAS u32x4*)(lds + (poff)); const u32x2 _hi = *(const volatile PG8_LAS u32x2*)(lds + (qoff));     dst = (u32x6){_lo.x, _lo.y, _lo.z, _lo.w, _hi.x, _hi.y}; } while (0)
#define F6_LDB(dst, b, h) do { _Pragma("unroll") for (int n = 0; n < 2; ++n) F6_FRAG(dst[n], F6_BP(b, h) + pb + n * 1024, F6_BQ(b) + (h) * 4096 + qb + n * 512); } while (0)
#define F6_LDA0(b) do { _Pragma("unroll") for (int m = 0; m < 4; ++m) F6_FRAG(At[m], F6_AP(b, 0) + pa + m * 1024, F6_AQ(b) + qa + m * 512); \
        _Pragma("unroll") for (int m = 0; m < 4; ++m) Aq[m] = *(const volatile PG8_LAS u32x2*)(lds + F6_AQ(b) + 4096 + qa + m * 512); } while (0)
#define F6_LDA1(b) do { _Pragma("unroll") for (int m = 0; m < 4; ++m) { const u32x4 _lo = *(const PG8_LAS u32x4*)(lds + F6_AP(b, 1) + pa + m * 1024); At[m] = (u32x6){_lo.x, _lo.y, _lo.z, _lo.w, Aq[m].x, Aq[m].y}; } } while (0)
#define F6_MMA(ai, bj, Bt) do { __builtin_amdgcn_s_setprio(1); _Pragma("unroll") for (int m = 0; m < 4; ++m) _Pragma("unroll") for (int n = 0; n < 2; ++n) \
        acc[ai][bj][m][n] = mma6(Bt[n], At[m], acc[ai][bj][m][n]); __builtin_amdgcn_s_setprio(0); } while (0)
#define F6_WAIT_V(n) asm volatile("s_waitcnt vmcnt(" #n ")" ::: "memory")
#define F6_WAIT_L(n) asm volatile("s_waitcnt lgkmcnt(" #n ")" ::: "memory")
#define F6_BAR __builtin_amdgcn_s_barrier()
#define F6_SCHED __builtin_amdgcn_sched_barrier(0)
    Unit cur, nxt; int ui = 0;
    if (!S.next(0, cur)) return;
    f32x4 acc[2][2][4][2];
#pragma unroll
    for (int a = 0; a < 2; ++a)
#pragma unroll
        for (int b = 0; b < 2; ++b)
#pragma unroll
            for (int m = 0; m < 4; ++m)
#pragma unroll
                for (int n = 0; n < 2; ++n) acc[a][b][m][n] = (f32x4){0.f, 0.f, 0.f, 0.f};
    u32x6 At[4], B0[2], B1[2]; u32x2 Aq[4];
    const char* cA = (const char*)Aimg + (size_t)cur.pm * tstep; const char* cB = (const char*)Bimg + (size_t)cur.pn * tstep;
    F6_STAGE_X(0, cA, cB); F6_STAGE_Y(0, cA);
    if (wr == 1) F6_BAR;
    F6_WAIT_V(1); F6_BAR;
    F6_STAGE_X(1, cA + kstep, cB + kstep);
    F6_WAIT_V(5); F6_BAR;
    for (;;) {
        const bool has_next = S.next(ui + 1, nxt);
        const char* nA = has_next ? (const char*)Aimg + (size_t)nxt.pm * tstep : cA; const char* nB = has_next ? (const char*)Bimg + (size_t)nxt.pn * tstep : cB;
        for (int t = 0; t < F6_KT; t += 2) {
            const bool last = (t == F6_KT - 2);
            const char* a1 = cA + (size_t)(t + 1) * kstep;
            const char* a2 = last ? nA : cA + (size_t)(t + 2) * kstep; const char* b2 = last ? nB : cB + (size_t)(t + 2) * kstep;
            const char* a3 = a2 + kstep; const char* b3 = b2 + kstep;
            F6_LDB(B0, 0, 0); F6_LDB(B1, 0, 1); F6_SCHED; F6_LDA0(0); F6_STAGE_Y(1, a1);
            F6_WAIT_V(6); F6_WAIT_L(0); F6_BAR; F6_MMA(0, 0, B0); F6_MMA(0, 1, B1); F6_BAR; F6_SCHED;
            F6_LDA1(0); F6_STAGE_X(0, a2, b2);
            F6_WAIT_V(6); F6_WAIT_L(0); F6_BAR; F6_MMA(1, 0, B0); F6_MMA(1, 1, B1); F6_BAR; F6_SCHED;
            F6_LDB(B0, 1, 0); F6_LDB(B1, 1, 1); F6_SCHED; F6_LDA0(1); F6_STAGE_Y(0, a2);
            F6_WAIT_V(6); F6_WAIT_L(0); F6_BAR; F6_MMA(0, 0, B0); F6_MMA(0, 1, B1); F6_BAR; F6_SCHED;
            F6_LDA1(1); F6_STAGE_X(1, a3, b3);
            F6_WAIT_V(6); F6_WAIT_L(0); F6_BAR; F6_MMA(1, 0, B0); F6_MMA(1, 1, B1); F6_BAR; F6_SCHED;
        }
        asm volatile("s_nop 15\n\ts_nop 7" ::: "memory");
        if constexpr (ALIGN_EPI) { if (wr == 0) F6_BAR; }
        E(acc, cur, wr, wc, fr, fq);
        if (!has_next) break;
#pragma unroll
        for (int a = 0; a < 2; ++a)
#pragma unroll
            for (int b = 0; b < 2; ++b)
#pragma unroll
                for (int m = 0; m < 4; ++m)
#pragma unroll
                    for (int n = 0; n < 2; ++n) acc[a][b][m][n] = (f32x4){0.f, 0.f, 0.f, 0.f};
        cur = nxt; cA = nA; cB = nB; ++ui;
        if constexpr (ALIGN_EPI) { if (wr == 1) F6_BAR; }
    }
    F6_WAIT_V(0);
    if constexpr (!ALIGN_EPI) { if (wr == 0) F6_BAR; }
    F6_BAR;
#undef F6_AP
#undef F6_BP
#undef F6_AQ
#undef F6_BQ
#undef F6_ST
#undef F6_STAGE_X
#undef F6_STAGE_Y
#undef F6_FRAG
#undef F6_LDB
#undef F6_LDA0
#undef F6_LDA1
#undef F6_MMA
#undef F6_WAIT_V
#undef F6_WAIT_L
#undef F6_BAR
#undef F6_SCHED
}
}

#define GAS __attribute__((address_space(1)))
#define LAS __attribute__((address_space(3)))
typedef unsigned short bf16;
typedef unsigned v4u __attribute__((ext_vector_type(4)));
typedef unsigned v2u __attribute__((ext_vector_type(2)));
typedef float f32x4 __attribute__((ext_vector_type(4)));
typedef float f32x16 __attribute__((ext_vector_type(16)));
typedef short bf16x8 __attribute__((ext_vector_type(8)));
typedef short s16x4 __attribute__((ext_vector_type(4)));
typedef GAS unsigned gu32;
#define RLX_AGENT __ATOMIC_RELAXED, __HIP_MEMORY_SCOPE_AGENT
#define LDS_WAIT() asm volatile("s_waitcnt lgkmcnt(0)" ::: "memory")
#define VM_WAIT() asm volatile("s_waitcnt vmcnt(0)" ::: "memory")
__device__ __forceinline__ unsigned f2bf(float f) { unsigned u = __builtin_bit_cast(unsigned, f); return (u + 0x7fffu + ((u >> 16) & 1u)) >> 16; }
__device__ __forceinline__ unsigned pk2(float lo, float hi) { return f2bf(lo) | (f2bf(hi) << 16); }
__device__ __forceinline__ float bf2f(unsigned short b) { return __builtin_bit_cast(float, (unsigned)b << 16); }
__device__ __forceinline__ float bflo(unsigned w) { return __builtin_bit_cast(float, w << 16); }
__device__ __forceinline__ float bfhi(unsigned w) { return __builtin_bit_cast(float, w & 0xffff0000u); }
__device__ __forceinline__ int fresh_lane() { int l; asm volatile("v_mbcnt_lo_u32_b32 %0, -1, 0\n\tv_mbcnt_hi_u32_b32 %0, -1, %0" : "=v"(l)); return l; }
__device__ __forceinline__ float wave_sum(float v) {
#pragma unroll
    for (int o = 1; o < 64; o <<= 1) v += __shfl_xor(v, o);
    return v;
}
__device__ __forceinline__ int t5_bucket(int rel) {
    const int n = rel < 0 ? -rel : rel;
    const int large = 8 + (n >= 15) + (n >= 27) + (n >= 50) + (n >= 91) + (n >= 166) + (n >= 305) + (n >= 559);
    return (rel > 0 ? 16 : 0) + (n < 8 ? n : large);
}

#define XB_TMO      128
#define XB_XCNT(j)  (256  + 64 * (j))
#define XB_XSUB(j)  (1280 + 64 * (j))
#define XB_XGEN(j)  (2304 + 64 * (j))
#define XB_TOP      3328
#define XB_TOPGEN   3392
#define XCD_BAR_WORDS 3456
#define XB_SPIN_CAP (1u << 18)

__device__ __forceinline__ unsigned xb_ld(unsigned* p)              { return __hip_atomic_load(p, __ATOMIC_RELAXED, __HIP_MEMORY_SCOPE_AGENT); }
__device__ __forceinline__ unsigned xb_add(unsigned* p, unsigned v) { return __hip_atomic_fetch_add(p, v, __ATOMIC_RELAXED, __HIP_MEMORY_SCOPE_AGENT); }
__device__ __forceinline__ unsigned xb_xcc_id() { return (unsigned)__builtin_amdgcn_s_getreg((3 << 11) | 20) & 0xFu; }
#define XB_SPIN(cond, bar) do { unsigned _sp = 0; while (cond) { __builtin_amdgcn_s_sleep(1); \
    if ((++_sp & 255u) == 0u) { if (xb_ld(&(bar)[XB_TMO])) break; if (_sp > XB_SPIN_CAP) { atomicAdd(&(bar)[XB_TMO], 1u); break; } } } } while (0)

struct XcdBarrier {
    unsigned* bar; unsigned x;
    volatile LAS unsigned* st;
};

__device__ __forceinline__ XcdBarrier xcd_barrier_post(unsigned* bar, volatile LAS unsigned* st, int tid) {
    XcdBarrier b; b.bar = bar; b.x = xb_xcc_id(); b.st = st;
    if (tid == 0) (void)xb_add(&bar[XB_XCNT(b.x)], 1u);
    return b;
}
__device__ __forceinline__ void xcd_barrier_complete(unsigned* bar, unsigned x, unsigned& nloc, unsigned& nx) {
    const unsigned G = gridDim.x * gridDim.y * gridDim.z;
    unsigned sum, cnt, mine, sp = 0u;
    for (;;) {
        sum = 0u; cnt = 0u; mine = 0u;
#pragma unroll
        for (unsigned j = 0; j < 16; ++j) { const unsigned c = xb_ld(&bar[XB_XCNT(j)]); sum += c; cnt += (c > 0u) ? 1u : 0u; mine = (j == x) ? c : mine; }
        if (sum == G) break;
        __builtin_amdgcn_s_sleep(1);
        if ((++sp & 255u) == 0u) { if (xb_ld(&bar[XB_TMO])) break; if (sp > XB_SPIN_CAP) { atomicAdd(&bar[XB_TMO], 1u); break; } }
    }
    nloc = mine > 0u ? mine : 1u; nx = cnt > 0u ? cnt : 1u;
}

__device__ __forceinline__ void xcd_barrier(const XcdBarrier& b, int tid) {
    asm volatile("s_waitcnt vmcnt(0)" ::: "memory");
    __syncthreads();
    if (tid == 0) {
        unsigned* bar = b.bar;
        __builtin_amdgcn_s_waitcnt(0);
        unsigned nloc = b.st[0], nx = b.st[1];
        if (nloc == 0u) { xcd_barrier_complete(bar, b.x, nloc, nx); b.st[0] = nloc; b.st[1] = nx; }
        const unsigned old = xb_add(&bar[XB_XSUB(b.x)], 1u);
        const unsigned gen = old / nloc;
        if (old + 1u == (gen + 1u) * nloc) {
            __builtin_amdgcn_fence(__ATOMIC_RELEASE, "agent");
            asm volatile("s_waitcnt vmcnt(0)" ::: "memory");
            const unsigned og = xb_add(&bar[XB_TOP], 1u);
            const unsigned tg = og / nx;
            if (og + 1u == (tg + 1u) * nx) xb_add(&bar[XB_TOPGEN], 1u);
            else XB_SPIN(xb_ld(&bar[XB_TOPGEN]) == tg, bar);
            __builtin_amdgcn_fence(__ATOMIC_ACQUIRE, "agent");
            xb_add(&bar[XB_XGEN(b.x)], 1u);
            asm volatile("s_waitcnt vmcnt(0)" ::: "memory");
        } else {
            XB_SPIN(xb_ld(&bar[XB_XGEN(b.x)]) == gen, bar);
            __builtin_amdgcn_fence(__ATOMIC_ACQUIRE, "agent");
            asm volatile("s_waitcnt vmcnt(0)" ::: "memory");
        }
    }
    __syncthreads();
}

struct Args {
    const float *x, *g1, *w_in, *lq1, *lk1, *lq2, *lk2, *subln, *w_out, *relb, *g2, *w_router, *w_gate, *w_up, *w_down, *gf;
    float* out; unsigned char* ws; int ph_lo, ph_hi, variant, pad;
};
struct Frame {
    LAS unsigned char* lds;
    volatile LAS unsigned* MISC;
    int wave, vcu, G;
};

__device__ __forceinline__ void transpose_item(const float* W, int N, bf16* WT, int KT, int k0, int n0, int orow0, LAS float* scr, int lane) {
#pragma unroll 32
    for (int i = 0; i < 32; ++i) { const int kk = 2 * i + (lane >> 5); scr[kk * 33 + (lane & 31)] = W[(size_t)(k0 + kk) * N + n0 + (lane & 31)]; }
    LDS_WAIT(); asm volatile("" ::: "memory");
    const int c = lane & 7;
#pragma unroll
    for (int j = 0; j < 4; ++j) { const int n = (lane >> 3) + 8 * j; const LAS float* s = scr + (8 * c) * 33 + n;
        v4u o; o.x = pk2(s[0 * 33], s[1 * 33]); o.y = pk2(s[2 * 33], s[3 * 33]); o.z = pk2(s[4 * 33], s[5 * 33]); o.w = pk2(s[6 * 33], s[7 * 33]);
        *(GAS v4u*)(WT + (size_t)(orow0 + n) * KT + k0 + 8 * c) = o; }
    LDS_WAIT(); asm volatile("" ::: "memory");
}
__device__ __forceinline__ int pk4_fp8(float a, float b, float c, float d) { a = pg8::q6(a); b = pg8::q6(b); c = pg8::q6(c); d = pg8::q6(d); int w = 0; w = __builtin_amdgcn_cvt_pk_fp8_f32(a, b, w, false); w = __builtin_amdgcn_cvt_pk_fp8_f32(c, d, w, true); return w; }
typedef float f32x4g __attribute__((ext_vector_type(4)));
__device__ __forceinline__ void t8_load(f32x4g (&wv)[16], const float* W, int N, int k0, int n0, int lane) {
    const float* src = W + (size_t)(k0 + 16 * (lane >> 4)) * N + n0 + 4 * (lane & 15);
#pragma unroll
    for (int j = 0; j < 16; ++j) wv[j] = __builtin_nontemporal_load((const GAS f32x4g*)(src + (size_t)j * N));
}
__device__ __forceinline__ void t8_store(const f32x4g (&wv)[16], unsigned char* WT, int KT, int k0, int orow0, int lane, float sc) {
    unsigned char* dst = WT + (size_t)(orow0 + 4 * (lane & 15)) * KT + k0 + 16 * (lane >> 4);
#pragma unroll
    for (int c = 0; c < 4; ++c) { v4u o;
#pragma unroll
        for (int q = 0; q < 4; ++q) o[q] = (unsigned)pk4_fp8(wv[4 * q][c] * sc, wv[4 * q + 1][c] * sc, wv[4 * q + 2][c] * sc, wv[4 * q + 3][c] * sc);
        __builtin_nontemporal_store(o, (GAS v4u*)(dst + (size_t)c * KT)); }
}
constexpr int CV_G1 = 16 * 44, CV_G = NE * CV_G1, CV_D1 = 44 * 16, CV_D = NE * CV_D1;
struct CvItem { const float* W; unsigned char* WT; int N, KT, k0, n0, orow0; float sc; };
__device__ __forceinline__ CvItem cv_decode(const Args& a, int r) {
    CvItem it;
    if (r < 2 * CV_G) { const int up = r >= CV_G; if (up) r -= CV_G; const int e = r / CV_G1, q = r % CV_G1, kb = q / 44, nb = q % 44, n0 = 64 * nb;
        it.W = (up ? a.w_up : a.w_gate) + (size_t)e * 1024 * DFF; it.N = DFF; it.WT = a.ws + WS_W1T + (size_t)e * 5632 * 1024; it.KT = 1024; it.k0 = 64 * kb; it.n0 = n0; it.orow0 = (n0 >> 7) * 256 + (n0 & 127) + (up ? 128 : 0); it.sc = pg8::WS8; }
    else { r -= 2 * CV_G; const int e = r / CV_D1, q = r % CV_D1, kb = q / 16, nb = q % 16;
        it.W = a.w_down + (size_t)e * DFF * 1024; it.N = 1024; it.WT = a.ws + WS_W2T + (size_t)e * 1024 * DFF; it.KT = DFF; it.k0 = 64 * kb; it.n0 = 64 * nb; it.orow0 = 64 * nb; it.sc = pg8::WS8D; }
    return it;
}
#if MK_FP6
typedef float f32x2g __attribute__((ext_vector_type(2)));
typedef float f32x16 __attribute__((ext_vector_type(16)));
typedef unsigned u32x6 __attribute__((ext_vector_type(6)));
__device__ __forceinline__ float clamp6(float v) { return __builtin_amdgcn_fmed3f(v, -7.5f, 7.5f); }
struct Cv6Item { const float* W; unsigned char* blk; int jb; };
__device__ __forceinline__ Cv6Item cv6_decode(const Args& a, int r) {
    Cv6Item it; const int up = r >= CV_G; if (up) r -= CV_G; const int e = r / CV_G1, q = r % CV_G1, kt = q / 88, nb = q % 88, n0 = 32 * nb;
    it.W = (up ? a.w_up : a.w_gate) + (size_t)e * 1024 * DFF + (size_t)(128 * kt) * DFF + n0;
    it.blk = a.ws + WS_W1T + (size_t)((e * 22 + (n0 >> 7)) * 8 + kt) * pg8::F6_BLOCK; it.jb = (up ? 128 : 0) + (n0 & 127);
    return it;
}
__device__ __forceinline__ void cv6_load(f32x2g (&wv)[32], const Cv6Item& it, int lane) {
    const float* src = it.W + (size_t)(32 * (lane >> 4)) * DFF + 2 * (lane & 15);
#pragma unroll
    for (int j = 0; j < 32; ++j) wv[j] = __builtin_nontemporal_load((const GAS f32x2g*)(src + (size_t)j * DFF));
}
__device__ __forceinline__ void cv6_store(const f32x2g (&wv)[32], const Cv6Item& it, int lane) {
    const int fq = lane >> 4;
#pragma unroll
    for (int i = 0; i < 2; ++i) { f32x16 lo, hi;
#pragma unroll
        for (int j = 0; j < 16; ++j) { lo[j] = clamp6(wv[j][i] * pg8::WS8); hi[j] = clamp6(wv[16 + j][i] * pg8::WS8); }
        const u32x6 pk = __builtin_amdgcn_cvt_scalef32_2xpk16_fp6_f32(lo, hi, 1.0f);
        const int x = 2 * (lane & 15) + i, rho = it.jb + ((x >> 2) & 1) * 16 + (x >> 3) * 4 + (x & 3), half = rho >> 7, rr = rho & 127;
        __builtin_nontemporal_store((v4u){pk[0], pk[1], pk[2], pk[3]}, (GAS v4u*)(it.blk + half * 8192 + pg8::f6_p_off(rr, fq)));
        __builtin_nontemporal_store((v2u){pk[4], pk[5]}, (GAS v2u*)(it.blk + 16384 + half * 4096 + pg8::f6_q_off(rr, fq))); }
}
__device__ __forceinline__ void cv6_run(const Args& a, int begin, int end, int cw, int CW) {
    const int lane = fresh_lane();
    int r = begin + cw; if (r >= end) return;
    f32x2g wa[32], wb[32];
    Cv6Item ia = cv6_decode(a, r), ib = ia;
    cv6_load(wa, ia, lane);
    for (;;) {
        const bool hb = r + CW < end;
        if (hb) { ib = cv6_decode(a, r + CW); cv6_load(wb, ib, lane); }
        cv6_store(wa, ia, lane);
        if (!hb) break;
        r += CW;
        const bool ha = r + CW < end;
        if (ha) { ia = cv6_decode(a, r + CW); cv6_load(wa, ia, lane); }
        cv6_store(wb, ib, lane);
        if (!ha) break;
        r += CW;
    }
}
#endif
__device__ __forceinline__ void cv_run(Frame& F, const Args& a, int begin, int end, int cw, int CW) {
    const int lane = fresh_lane();
    int r = begin + cw; if (r >= end) return;
    f32x4g wa[16], wb[16];
    CvItem ia = cv_decode(a, r), ib = ia;
    t8_load(wa, ia.W, ia.N, ia.k0, ia.n0, lane);
    for (;;) {
        const bool hb = r + CW < end;
        if (hb) { ib = cv_decode(a, r + CW); t8_load(wb, ib.W, ib.N, ib.k0, ib.n0, lane); }
        t8_store(wa, ia.WT, ia.KT, ia.k0, ia.orow0, lane, ia.sc);
        if (!hb) break;
        r += CW;
        const bool ha = r + CW < end;
        if (ha) { ia = cv_decode(a, r + CW); t8_load(wa, ia.W, ia.N, ia.k0, ia.n0, lane); }
        t8_store(wb, ib.WT, ib.KT, ib.k0, ib.orow0, lane, ib.sc);
        if (!ha) break;
        r += CW;
    }
}
__device__ __forceinline__ void rms_row_to_bf16(const float* xrow, const float* g, bf16* orow, int lane) {
    const GAS f32x4* xr = (const GAS f32x4*)xrow + lane; const GAS f32x4* gr = (const GAS f32x4*)g + lane;
    f32x4 v[4]; float s = 0.f;
#pragma unroll
    for (int j = 0; j < 4; ++j) { v[j] = xr[64 * j]; s += (v[j].x * v[j].x + v[j].y * v[j].y) + (v[j].z * v[j].z + v[j].w * v[j].w); }
    const float rstd = 1.f / sqrtf(wave_sum(s) * (1.f / DM) + NORM_EPS);
    GAS unsigned long long* o8 = (GAS unsigned long long*)orow + lane;
#pragma unroll
    for (int j = 0; j < 4; ++j) { const f32x4 gg = gr[64 * j]; const f32x4 y = v[j] * rstd * gg;
        o8[64 * j] = (unsigned long long)pk2(y.x, y.y) | ((unsigned long long)pk2(y.z, y.w) << 32); }
}
__device__ __forceinline__ void p0_prologue(Frame& F, const Args& a) {
    LAS float* scr = (LAS float*)(F.lds + RING_OFF + F.wave * 16384);
    const int gw = F.vcu * NWAVES + F.wave, NGW = F.G * NWAVES, lane0 = fresh_lane();
    bf16* win_t = (bf16*)(a.ws + WS_WIN); bf16* wout_t = (bf16*)(a.ws + WS_WOUT);
    constexpr int I_IN = 16 * 96, I_OUT = 16 * 32;
    for (int it = gw; it < I_IN + I_OUT; it += NGW) {
        int r = it;
        if (r < I_IN) { const int kb = r / 96, nb = r % 96; transpose_item(a.w_in, NIN, win_t, 1024, 64 * kb, 32 * nb, 32 * nb, scr, lane0); continue; } r -= I_IN;
        { const int kb = r / 32, nb = r % 32; transpose_item(a.w_out, 1024, wout_t, 1024, 64 * kb, 32 * nb, 32 * nb, scr, lane0); }
    }
    bf16* h1 = (bf16*)(a.ws + WS_H1);
    for (int m = gw; m < NTOK; m += NGW) rms_row_to_bf16(a.x + (size_t)m * DM, a.g1, h1 + (size_t)m * DM, lane0);
#if MK_FP6
    cv6_run(a, 0, 2 * CV_G, gw, NGW);
    cv_run(F, a, 2 * CV_G, 2 * CV_G + CV_D, gw, NGW);
#else
    cv_run(F, a, 0, 2 * CV_G + CV_D, gw, NGW);
#endif
}

__device__ __forceinline__ float xshfl(float v, int lane, int msk) { return __builtin_bit_cast(float, __builtin_amdgcn_ds_bpermute((lane ^ msk) << 2, __builtin_bit_cast(int, v))); }
__device__ __forceinline__ float reduce16(const float (&v)[16], int lane) {
    float w8[8], w4[4], w2[2];
    const bool b5 = lane & 32, b4 = lane & 16, b3 = lane & 8, b2 = lane & 4;
#pragma unroll
    for (int j = 0; j < 8; ++j) { const float keep = b5 ? v[j + 8] : v[j], send = b5 ? v[j] : v[j + 8]; w8[j] = keep + xshfl(send, lane, 32); }
#pragma unroll
    for (int j = 0; j < 4; ++j) { const float keep = b4 ? w8[j + 4] : w8[j], send = b4 ? w8[j] : w8[j + 4]; w4[j] = keep + xshfl(send, lane, 16); }
#pragma unroll
    for (int j = 0; j < 2; ++j) { const float keep = b3 ? w4[j + 2] : w4[j], send = b3 ? w4[j] : w4[j + 2]; w2[j] = keep + xshfl(send, lane, 8); }
    float w1 = (b2 ? w2[1] : w2[0]) + xshfl(b2 ? w2[0] : w2[1], lane, 4);
    w1 += xshfl(w1, lane, 2); w1 += xshfl(w1, lane, 1);
    return w1;
}
__device__ __forceinline__ void p4_router(Frame& F, const Args& a) {
    LAS float* wrT = (LAS float*)(F.lds + RING_OFF);
#if MK_FP6
    LAS float* tr = (LAS float*)(F.lds + RING_OFF + 65536 + F.wave * 8192);
#endif
    const int lane = fresh_lane();
    for (int i = F.wave * 64 + lane; i < 1024 * 16; i += NWAVES * 64) { const int k = i >> 4, e = i & 15; wrT[e * 1024 + k] = a.w_router[i]; }
    __syncthreads();
    const int gw = F.vcu * NWAVES + F.wave, NGW = F.G * NWAVES;
    const bf16* x2 = (const bf16*)(a.ws + WS_X2); unsigned char* h2 = a.ws + WS_H2; float* aff = (float*)(a.ws + WS_AFF); int* inv = (int*)(a.ws + WS_INV);
    f32x4 gg[4];
#pragma unroll
    for (int j = 0; j < 4; ++j) gg[j] = ((const GAS f32x4*)a.g2 + lane)[64 * j];
    v2u xn[2][4];
#pragma unroll
    for (int t = 0; t < 2; ++t) { const GAS v2u* xr = (const GAS v2u*)(x2 + (size_t)(gw + t * NGW) * DM) + lane;
#pragma unroll
        for (int j = 0; j < 4; ++j) xn[t][j] = xr[64 * j]; }
    for (int m = gw; m < NTOK; m += 2 * NGW) {
        f32x4 v[2][4]; float ss[2] = {0.f, 0.f};
#pragma unroll
        for (int t = 0; t < 2; ++t)
#pragma unroll
            for (int j = 0; j < 4; ++j) { const v2u xw = xn[t][j]; v[t][j] = (f32x4){bflo(xw.x), bfhi(xw.x), bflo(xw.y), bfhi(xw.y)}; ss[t] += (v[t][j].x * v[t][j].x + v[t][j].y * v[t][j].y) + (v[t][j].z * v[t][j].z + v[t][j].w * v[t][j].w); }
        if (m + 2 * NGW < NTOK) {
#pragma unroll
            for (int t = 0; t < 2; ++t) { const GAS v2u* xr = (const GAS v2u*)(x2 + (size_t)(m + (2 + t) * NGW) * DM) + lane;
#pragma unroll
                for (int j = 0; j < 4; ++j) xn[t][j] = xr[64 * j]; } }
#pragma unroll
        for (int t = 0; t < 2; ++t) { const float rstd = 1.f / sqrtf(wave_sum(ss[t]) * (1.f / DM) + NORM_EPS);
#if MK_FP6
#pragma unroll
            for (int j = 0; j < 4; ++j) { v[t][j] = v[t][j] * rstd * gg[j]; const int idx = t * 1024 + 256 * j + 4 * lane;
                *(LAS f32x4*)((LAS unsigned char*)tr + (idx >> 5) * 128 + ((((idx >> 2) ^ (idx >> 5)) & 7) * 16)) = v[t][j] * pg8::XS8; } }
        { LDS_WAIT(); f32x16 lo, hi;
#pragma unroll
          for (int i = 0; i < 4; ++i) { const f32x4 q0 = *(const LAS f32x4*)((const LAS unsigned char*)tr + lane * 128 + (((i ^ lane) & 7) * 16)), q1 = *(const LAS f32x4*)((const LAS unsigned char*)tr + lane * 128 + ((((4 + i) ^ lane) & 7) * 16));
              lo[4 * i] = clamp6(q0.x); lo[4 * i + 1] = clamp6(q0.y); lo[4 * i + 2] = clamp6(q0.z); lo[4 * i + 3] = clamp6(q0.w);
              hi[4 * i] = clamp6(q1.x); hi[4 * i + 1] = clamp6(q1.y); hi[4 * i + 2] = clamp6(q1.z); hi[4 * i + 3] = clamp6(q1.w); }
          const u32x6 pk = __builtin_amdgcn_cvt_scalef32_2xpk16_fp6_f32(lo, hi, 1.0f);
          unsigned char* hrow = h2 + (size_t)(m + (lane >> 5) * NGW) * 768;
          *(GAS v4u*)(hrow + (lane & 31) * 16) = (v4u){pk[0], pk[1], pk[2], pk[3]}; *(GAS v2u*)(hrow + 512 + (lane & 31) * 8) = (v2u){pk[4], pk[5]};
          asm volatile("" ::: "memory"); }
#else
            GAS int* o4 = (GAS int*)(h2 + (size_t)(m + t * NGW) * DM) + lane;
#pragma unroll
            for (int j = 0; j < 4; ++j) { v[t][j] = v[t][j] * rstd * gg[j]; const f32x4 q = v[t][j] * pg8::XS8; o4[64 * j] = pk4_fp8(pg8::clamp448(q.x), pg8::clamp448(q.y), pg8::clamp448(q.z), pg8::clamp448(q.w)); } }
#endif
        float lg[2][16];
        typedef float f32x2r __attribute__((ext_vector_type(2)));
        f32x2r vp[4][4];
#pragma unroll
        for (int j = 0; j < 4; ++j) { vp[j][0] = (f32x2r){v[0][j].x, v[1][j].x}; vp[j][1] = (f32x2r){v[0][j].y, v[1][j].y}; vp[j][2] = (f32x2r){v[0][j].z, v[1][j].z}; vp[j][3] = (f32x2r){v[0][j].w, v[1][j].w}; }
#pragma unroll
        for (int e = 0; e < 16; ++e) { f32x2r acc = {0.f, 0.f};
#pragma unroll
            for (int j = 0; j < 4; ++j) { const f32x4 w = *(const LAS f32x4*)(wrT + e * 1024 + 256 * j + 4 * lane);
                acc = __builtin_elementwise_fma(vp[j][0], (f32x2r){w.x, w.x}, acc); acc = __builtin_elementwise_fma(vp[j][1], (f32x2r){w.y, w.y}, acc);
                acc = __builtin_elementwise_fma(vp[j][2], (f32x2r){w.z, w.z}, acc); acc = __builtin_elementwise_fma(vp[j][3], (f32x2r){w.w, w.w}, acc); }
            asm volatile("" : "+v"(acc));
            lg[0][e] = acc.x; lg[1][e] = acc.y; __builtin_amdgcn_sched_barrier(0); }
#pragma unroll
        for (int t = 0; t < 2; ++t) {
            __builtin_amdgcn_sched_barrier(0);
            const float lgt = reduce16(lg[t], lane);
            float mx = lgt;
#pragma unroll
            for (int o = 4; o < 64; o <<= 1) mx = fmaxf(mx, xshfl(mx, lane, o));
            const float ex = __expf(lgt - mx); float sum = ex;
#pragma unroll
            for (int o = 4; o < 64; o <<= 1) sum += xshfl(sum, lane, o);
            const int row = m + t * NGW, b = row >> 12, spos = row & 4095;
            if ((lane & 3) == 0) aff[((size_t)(b * 16 + (lane >> 2))) * SEQ + spos] = ex / sum;
            if (lane < 16) inv[(size_t)row * 16 + lane] = -1;
            __builtin_amdgcn_sched_barrier(0); }
    }
}

__device__ __forceinline__ int block_excl_scan(int v, LAS int* tmp, int tid, int& total) {
    const int lane = tid & 63, w = tid >> 6; int x = v;
#pragma unroll
    for (int o = 1; o < 64; o <<= 1) { const int t = __shfl_up(x, o); if (lane >= o) x += t; }
    if (lane == 63) tmp[w] = x;
    __syncthreads();
    int off = 0, tot = 0;
#pragma unroll
    for (int j = 0; j < 8; ++j) { const int t = tmp[j]; tot += t; if (j < w) off += t; }
    __syncthreads();
    total = tot; return off + x - v;
}
__device__ __forceinline__ void p5_topk(Frame& F, const Args& a) {
    LAS unsigned* keys = (LAS unsigned*)(F.lds + RING_OFF);
    LAS unsigned* hist = keys + 4096;
    LAS int* tmp = (LAS int*)(hist + 256);
    LAS unsigned* bc = (LAS unsigned*)(tmp + 8);
    const float* aff = (const float*)(a.ws + WS_AFF); float* gate = (float*)(a.ws + WS_GATE); int* inv = (int*)(a.ws + WS_INV);
    const int tid = F.wave * 64 + fresh_lane();
    for (int pr = F.vcu; pr < BATCH * NE; pr += F.G) {
        const int b = pr >> 4, e = pr & 15;
        const float* src = aff + (size_t)pr * SEQ;
        unsigned k[8];
#pragma unroll
        for (int j = 0; j < 8; ++j) k[j] = __builtin_bit_cast(unsigned, src[tid * 8 + j]);
        unsigned prefix = 0u, need = CAP;
#pragma unroll 1
        for (int pass = 0; pass < 4; ++pass) {
            const int shift = 24 - 8 * pass;
            if (tid < 256) hist[tid] = 0u;
            __syncthreads();
#pragma unroll
            for (int j = 0; j < 8; ++j) { const bool in = (pass == 0) || ((k[j] >> (shift + 8)) == prefix);
                if (in) __hip_atomic_fetch_add(hist + ((k[j] >> shift) & 255u), 1u, __ATOMIC_RELAXED, __HIP_MEMORY_SCOPE_WORKGROUP); }
            __syncthreads();
            {
                const int hb = tid < 256 ? (int)hist[255 - tid] : 0; int tot; const int above = block_excl_scan(hb, tmp, tid, tot);
                if (tid < 256 && above < (int)need && above + hb >= (int)need) { bc[0] = (prefix << 8) | (unsigned)(255 - tid); bc[1] = need - (unsigned)above; } }
            __syncthreads();
            prefix = bc[0]; need = bc[1];
            __syncthreads();
        }
        const unsigned T = prefix;
        int ceq = 0;
#pragma unroll
        for (int j = 0; j < 8; ++j) ceq += (k[j] == T);
        int tot; int eqr = block_excl_scan(ceq, tmp, tid, tot);
        int csel = 0; bool sel[8];
#pragma unroll
        for (int j = 0; j < 8; ++j) { sel[j] = (k[j] > T) || (k[j] == T && eqr < (int)need); eqr += (k[j] == T); csel += sel[j]; }
        int slot = block_excl_scan(csel, tmp, tid, tot);
#pragma unroll
        for (int j = 0; j < 8; ++j) if (sel[j]) { const int s = tid * 8 + j; const size_t o = ((size_t)e * BATCH + b) * CAP + slot;
            gate[o] = __builtin_bit_cast(float, k[j]); inv[((size_t)b * SEQ + s) * 16 + e] = slot; ((LAS int*)keys)[slot] = s; ++slot; }
        __syncthreads();
#if MK_FP6
        { const int lane = tid & 63, G = lane & 31, kt = G >> 2, fq = G & 3; const unsigned char* h2 = a.ws + WS_H2;
          unsigned char* xe = a.ws + WS_XE + ((size_t)(e * BATCH + b) * 2 * 8 + kt) * pg8::F6_BLOCK;
#pragma unroll 4
          for (int c = (tid >> 6) * 2 + (lane >> 5); c < CAP; c += 2 * NWAVES) { const int tok = b * SEQ + ((LAS int*)keys)[c];
              const unsigned char* src = h2 + (size_t)tok * 768; const v4u pv = *(const GAS v4u*)(src + G * 16); const v2u qv = *(const GAS v2u*)(src + 512 + G * 8);
              unsigned char* blk = xe + (size_t)(c >> 8) * 8 * pg8::F6_BLOCK; const int half = (c >> 7) & 1, rr = c & 127;
              *(GAS v4u*)(blk + half * 8192 + pg8::f6_p_off(rr, fq)) = pv; *(GAS v2u*)(blk + 16384 + half * 4096 + pg8::f6_q_off(rr, fq)) = qv; } }
#else
        { const int lane = tid & 63; const unsigned char* h2 = a.ws + WS_H2; unsigned char* xe = a.ws + WS_XE + ((size_t)e * BATCH + b) * CAP * DM;
#pragma unroll 4
          for (int c = tid >> 6; c < CAP; c += NWAVES) { const int tok = b * SEQ + ((LAS int*)keys)[c];
              ((GAS v4u*)(xe + (size_t)c * DM))[lane] = ((const GAS v4u*)(h2 + (size_t)tok * DM))[lane]; } }
#endif
        __syncthreads();
    }
}

__device__ __forceinline__ void p8_combine(Frame& F, const Args& a) {
    const int gw = F.vcu * NWAVES + F.wave, NGW = F.G * NWAVES, lane = fresh_lane();
    const bf16* ye = (const bf16*)(a.ws + WS_YE); const int* inv = (const int*)(a.ws + WS_INV); const bf16* x2 = (const bf16*)(a.ws + WS_X2);
    f32x4 gg[4];
#pragma unroll
    for (int j = 0; j < 4; ++j) gg[j] = ((const GAS f32x4*)a.gf + lane)[64 * j];
    v2u xn[4]; int slotn = -1;
    if (gw < NTOK) { const GAS v2u* xs = (const GAS v2u*)(x2 + (size_t)gw * DM) + lane;
#pragma unroll
        for (int j = 0; j < 4; ++j) xn[j] = xs[64 * j];
        slotn = (lane < 16) ? inv[(size_t)gw * 16 + lane] : -1; }
    for (int m = gw; m < NTOK; m += NGW) {
        f32x4 v[4];
#pragma unroll
        for (int j = 0; j < 4; ++j) v[j] = (f32x4){bflo(xn[j].x), bfhi(xn[j].x), bflo(xn[j].y), bfhi(xn[j].y)};
        const int myslot = slotn;
        if (m + NGW < NTOK) { const GAS v2u* xs = (const GAS v2u*)(x2 + (size_t)(m + NGW) * DM) + lane;
#pragma unroll
            for (int j = 0; j < 4; ++j) xn[j] = xs[64 * j];
            slotn = (lane < 16) ? inv[(size_t)(m + NGW) * 16 + lane] : -1; }
        const int b = m >> 12;
        unsigned mask = (unsigned)__ballot(myslot >= 0) & 0xFFFFu;
        while (mask) {
            const int e0 = __builtin_ctz(mask); mask &= mask - 1; const bool two = mask != 0u; const int e1 = two ? __builtin_ctz(mask) : e0; if (two) mask &= mask - 1;
            const int c0 = __builtin_amdgcn_readlane(myslot, e0), c1 = __builtin_amdgcn_readlane(myslot, e1);
            const GAS v2u* y0 = (const GAS v2u*)(ye + ((size_t)(e0 * BATCH + b) * CAP + c0) * DM) + lane; const GAS v2u* y1 = (const GAS v2u*)(ye + ((size_t)(e1 * BATCH + b) * CAP + c1) * DM) + lane;
            v2u w0[4], w1[4];
#pragma unroll
            for (int j = 0; j < 4; ++j) { w0[j] = __builtin_nontemporal_load(y0 + 64 * j); w1[j] = __builtin_nontemporal_load(y1 + 64 * j); }
#pragma unroll
            for (int j = 0; j < 4; ++j) { v[j].x += bflo(w0[j].x); v[j].y += bfhi(w0[j].x); v[j].z += bflo(w0[j].y); v[j].w += bfhi(w0[j].y); }
            if (two) {
#pragma unroll
                for (int j = 0; j < 4; ++j) { v[j].x += bflo(w1[j].x); v[j].y += bfhi(w1[j].x); v[j].z += bflo(w1[j].y); v[j].w += bfhi(w1[j].y); } }
        }
        float s = 0.f;
#pragma unroll
        for (int j = 0; j < 4; ++j) s += (v[j].x * v[j].x + v[j].y * v[j].y) + (v[j].z * v[j].z + v[j].w * v[j].w);
        const float rstd = 1.f / sqrtf(wave_sum(s) * (1.f / DM) + NORM_EPS);
        GAS f32x4* xr = (GAS f32x4*)(a.out + (size_t)m * DM) + lane;
#pragma unroll
        for (int j = 0; j < 4; ++j) __builtin_nontemporal_store(v[j] * rstd * gg[j], xr + 64 * j);
    }
}

namespace att {
#define KSWZ(row, colB) ((row) * 256 + ((colB) ^ (((row) & 7) << 4)))
#define KSWZ16(row, colB) ((row) * 256 + ((colB) ^ (((row) & 15) << 4)))
#define SBAR() __builtin_amdgcn_sched_barrier(0)
constexpr int SHM_V = 16384, SHM_K = 16384;
constexpr int L_V = 0, L_K = 2 * SHM_V, L_WS = 2 * SHM_V + 2 * SHM_K, L_T = L_WS + NWAVES * 256, TOFF = 704, TLEN = 1408;
constexpr int L_X = 0;
constexpr float THR = 8.f;
__device__ __forceinline__ int crow(int r, int hi) { return (r & 3) + 8 * (r >> 2) + 4 * hi; }
typedef float f32x2_t __attribute__((ext_vector_type(2))); typedef __bf16 bf16x2_t __attribute__((ext_vector_type(2)));
__device__ __forceinline__ unsigned cvtpk(float lo, float hi) { const f32x2_t v = {lo, hi}; return __builtin_bit_cast(unsigned, __builtin_convertvector(v, bf16x2_t)); }
__device__ __forceinline__ float fadd_s(float a, float b) { float r; asm("v_add_f32_e32 %0, %1, %2" : "=v"(r) : "v"(a), "v"(b)); return r; }
__device__ __forceinline__ bf16x8 ld8(const bf16* p) { return *reinterpret_cast<const bf16x8*>(p); }

__device__ __forceinline__ void partialSM(f32x16& p0, f32x16& p1, float& m_reg, float& alpha) {
    float mx4[4] = {p0[0], p0[1], p0[2], p0[3]};
#pragma unroll
    for (int r = 4; r < 16; ++r) mx4[r & 3] = fmaxf(mx4[r & 3], p0[r]);
#pragma unroll
    for (int r = 0; r < 16; ++r) mx4[r & 3] = fmaxf(mx4[r & 3], p1[r]);
    float pmax = fmaxf(fmaxf(mx4[0], mx4[1]), fmaxf(mx4[2], mx4[3]));
    { auto rr = __builtin_amdgcn_permlane32_swap(__float_as_uint(pmax), __float_as_uint(pmax), false, false); pmax = fmaxf(__uint_as_float(rr[0]), __uint_as_float(rr[1])); }
    float mn;
    if (__builtin_expect(__all(pmax - m_reg <= THR), 1)) { mn = m_reg; alpha = 1.f; }
    else { mn = fmaxf(m_reg, pmax); alpha = __builtin_amdgcn_exp2f(m_reg - mn); m_reg = mn; }
#pragma unroll
    for (int r = 0; r < 16; ++r) { p0[r] -= mn; p1[r] -= mn; }
#pragma unroll
    for (int r = 0; r < 16; ++r) p0[r] = __builtin_amdgcn_exp2f(p0[r]);
}
__device__ __forceinline__ void finishSM(f32x16& p0, f32x16& p1, float alpha, float& l_reg, bf16x8& pa0, bf16x8& pa1, bf16x8& pa2, bf16x8& pa3) {
#pragma unroll
    for (int r = 0; r < 16; ++r) p1[r] = __builtin_amdgcn_exp2f(p1[r]);
    float ps4[4] = {p0[0], p0[1], p0[2], p0[3]};
#pragma unroll
    for (int r = 4; r < 16; ++r) ps4[r & 3] += p0[r];
#pragma unroll
    for (int r = 0; r < 16; ++r) ps4[r & 3] += p1[r];
    float ps = (ps4[0] + ps4[1]) + (ps4[2] + ps4[3]);
    { auto rr = __builtin_amdgcn_permlane32_swap(__float_as_uint(ps), __float_as_uint(ps), false, false); ps = __uint_as_float(rr[0]) + __uint_as_float(rr[1]); }
    l_reg = l_reg * alpha + ps;
#define PK4(P, BASE, OUT) do { unsigned a0 = cvtpk(P[BASE + 0], P[BASE + 1]), a1 = cvtpk(P[BASE + 2], P[BASE + 3]);   \
    unsigned b0 = cvtpk(P[BASE + 4], P[BASE + 5]), b1 = cvtpk(P[BASE + 6], P[BASE + 7]);                              \
    auto r0 = __builtin_amdgcn_permlane32_swap(a0, b0, false, false); auto r1 = __builtin_amdgcn_permlane32_swap(a1, b1, false, false); \
    v4u w = {r0[0], r1[0], r0[1], r1[1]}; OUT = __builtin_bit_cast(bf16x8, w); } while (0)
    PK4(p0, 0, pa0); PK4(p0, 8, pa1); PK4(p1, 0, pa2); PK4(p1, 8, pa3);
#undef PK4
}
template <int NC4> __device__ __forceinline__ int v_st(int k, int c) { const int kk = (k & ~0xC) | ((k & 4) << 1) | ((k & 8) >> 1); return ((kk >> 3) * NC4 + (c >> 5)) * 512 + ((kk & 7) * 32 + (c & 31)) * 2; }
__device__ __forceinline__ int v_rd_base(int lane) { return ((lane & 3) << 3) | (((lane >> 2) & 3) << 6) | (((lane >> 4) & 1) << 5) | (((lane >> 5) & 1) << 8); }
template <int NC4> constexpr int v_rd_off(int d0, int ks, int half) { return d0 * 512 + ks * (NC4 * 1024) + half * (NC4 * 512); }
template <int OFF> __device__ __forceinline__ s16x4 tr_read(int vb) { s16x4 r; asm volatile("ds_read_b64_tr_b16 %0, %1 offset:%2" : "=&v"(r) : "v"(vb), "i"(OFF) : "memory"); return r; }
template <int NC4, int ND0, int KS> __device__ __forceinline__ void pv_step(f32x16 (&o)[ND0], int vb, bf16x8 pa) {
    s16x4 lo[ND0], hh[ND0];
#pragma unroll
    for (int d0 = 0; d0 < ND0; ++d0) {
        if (d0 == 0) { lo[0] = tr_read<v_rd_off<NC4>(0, KS, 0)>(vb); hh[0] = tr_read<v_rd_off<NC4>(0, KS, 1)>(vb); }
        if (d0 == 1) { lo[1] = tr_read<v_rd_off<NC4>(1, KS, 0)>(vb); hh[1] = tr_read<v_rd_off<NC4>(1, KS, 1)>(vb); }
        if (d0 == 2) { lo[2] = tr_read<v_rd_off<NC4>(2, KS, 0)>(vb); hh[2] = tr_read<v_rd_off<NC4>(2, KS, 1)>(vb); }
        if (d0 == 3) { lo[3] = tr_read<v_rd_off<NC4>(3, KS, 0)>(vb); hh[3] = tr_read<v_rd_off<NC4>(3, KS, 1)>(vb); } }
    asm volatile("s_waitcnt lgkmcnt(0)" ::: "memory"); SBAR();
#pragma unroll
    for (int d0 = 0; d0 < ND0; ++d0) { const bf16x8 vf = (bf16x8){lo[d0][0], lo[d0][1], lo[d0][2], lo[d0][3], hh[d0][0], hh[d0][1], hh[d0][2], hh[d0][3]};
        o[d0] = __builtin_amdgcn_mfma_f32_32x32x16_bf16(pa, vf, o[d0], 0, 0, 0); }
}
template <int NC4, int ND0> __device__ __forceinline__ void pv_all(f32x16 (&o)[ND0], int vb, bf16x8 pa0, bf16x8 pa1, bf16x8 pa2, bf16x8 pa3) {
    pv_step<NC4, ND0, 0>(o, vb, pa0); pv_step<NC4, ND0, 1>(o, vb, pa1); pv_step<NC4, ND0, 2>(o, vb, pa2); pv_step<NC4, ND0, 3>(o, vb, pa3);
}

__device__ __forceinline__ void diff_unit(const bf16* __restrict__ proj, bf16* __restrict__ attn, const float* relb, const float* subln, float lam, int b, int h, int qb,
                                          LAS unsigned char* lds, int tid) {
    const int wid = __builtin_amdgcn_readfirstlane(tid >> 6), lane = tid & 63, r32 = lane & 31, hi = lane >> 5, sub = wid >> 2, wq = wid & 3;
    LAS unsigned char* V_lds = lds + L_V; LAS unsigned char* K_lds = lds + L_K;
    LAS float* wsf = (LAS float*)(lds + L_WS) + wid * 64; LAS float* li_l = wsf; LAS float* al_l = wsf + 32;
    LAS float* T = (LAS float*)(lds + L_T);
    for (int i = tid; i < TLEN; i += NWAVES * 64) T[i] = relb[(unsigned)(t5_bucket(i - TOFF) * 12 + h)] * LOG2E;
    const float cneg = relb[15 * 12 + h] * LOG2E, cpos = relb[31 * 12 + h] * LOG2E;
    const size_t rowb = (size_t)b * SEQ;
    const int q0w = qb * 128 + wq * 32;
    const bf16* Kh = proj + rowb * NIN + COL_KA + h * 128; const bf16* Vh = proj + rowb * NIN + COL_VA + h * 128;
    float m_reg = -1e30f, l_reg = 0.f; f32x16 o[4]; bf16x8 qr[4];
#pragma unroll
    for (int d = 0; d < 4; ++d) o[d] = f32x16{};
    { const bf16* Qw = proj + (rowb + q0w + r32) * NIN + COL_QA + h * 128 + sub * 64 + hi * 8;
#pragma unroll
      for (int d0 = 0; d0 < 4; ++d0) qr[d0] = ld8(Qw + d0 * 16); }
    const int sr = tid >> 4, sc = (tid & 15) * 8, vst0 = v_st<4>(sr, sc), vst1 = v_st<4>(32 + sr, sc);
    const int vb0 = (int)(unsigned)(uintptr_t)V_lds + v_rd_base(lane);
    struct { bf16x8 vs0, vs1, ks0, ks1; } sr_[2];
#define SLOAD(i, k0) do { sr_[i].vs0 = ld8(&Vh[(size_t)((k0) + sr) * NIN + sc]); sr_[i].vs1 = ld8(&Vh[(size_t)((k0) + 32 + sr) * NIN + sc]); \
    sr_[i].ks0 = ld8(&Kh[(size_t)((k0) + sr) * NIN + sc]); sr_[i].ks1 = ld8(&Kh[(size_t)((k0) + 32 + sr) * NIN + sc]); } while (0)
#define SWRITE(bb, i) do { *(LAS bf16x8*)(V_lds + (bb) * SHM_V + vst0) = sr_[i].vs0; *(LAS bf16x8*)(V_lds + (bb) * SHM_V + vst1) = sr_[i].vs1; const int kc = sc * 2; \
    *(LAS bf16x8*)(K_lds + (bb) * SHM_K + KSWZ(sr, kc)) = sr_[i].ks0; *(LAS bf16x8*)(K_lds + (bb) * SHM_K + KSWZ(32 + sr, kc)) = sr_[i].ks1; } while (0)
#define SWAIT() asm volatile("s_waitcnt vmcnt(4)" ::: "memory")
#define RESC(a_) do { if (__any((a_) < 1.f)) { if (hi == 0) al_l[r32] = (a_); asm volatile("s_waitcnt lgkmcnt(0)" ::: "memory"); \
    _Pragma("unroll") for (int d = 0; d < 4; ++d) _Pragma("unroll") for (int r = 0; r < 16; ++r) o[d][r] *= al_l[crow(r, hi)]; } } while (0)
#define BINIT(P0, P1, kv0) do { const int d_ = (kv0) - q0w; \
    if (d_ > -622 && d_ < 590) { const LAS float* tp = T + (d_ - r32 + 4 * hi + TOFF); \
        _Pragma("unroll") for (int r = 0; r < 16; ++r) { P0[r] = tp[(r & 3) + 8 * (r >> 2)]; P1[r] = tp[32 + (r & 3) + 8 * (r >> 2)]; } } \
    else { const float c_ = d_ < 0 ? cneg : cpos; _Pragma("unroll") for (int r = 0; r < 16; ++r) { P0[r] = c_; P1[r] = c_; } } } while (0)
#define QKT(P0, P1, Ks) do { _Pragma("unroll") for (int d0 = 0; d0 < 4; ++d0) { const int cb = (sub * 64 + d0 * 16 + hi * 8) * 2; \
    const bf16x8 b0 = *(const LAS bf16x8*)((Ks) + KSWZ(r32, cb)); const bf16x8 b1 = *(const LAS bf16x8*)((Ks) + KSWZ(32 + r32, cb)); \
    P0 = __builtin_amdgcn_mfma_f32_32x32x16_bf16(b0, qr[d0], P0, 0, 0, 0); P1 = __builtin_amdgcn_mfma_f32_32x32x16_bf16(b1, qr[d0], P1, 0, 0, 0); } } while (0)
#define PVD0(vb) pv_all<4, 4>(o, vb, pa0, pa1, pa2, pa3)
    f32x16 pA0, pA1, pB0, pB1; float alA, alB; bf16x8 pa0, pa1, pa2, pa3; constexpr int NT = SEQ / 64;
    SLOAD(0, 0); asm volatile("s_waitcnt vmcnt(0)" ::: "memory"); SWRITE(0, 0); __syncthreads();
    BINIT(pA0, pA1, 0); QKT(pA0, pA1, K_lds); partialSM(pA0, pA1, m_reg, alA);
    SLOAD(1, 64); SLOAD(0, 128);
    SWAIT(); SWRITE(1, 1); __syncthreads();
#pragma unroll 1
    for (int j = 1; j + 1 < NT; j += 2) {
        SBAR(); BINIT(pB0, pB1, j * 64); QKT(pB0, pB1, K_lds + SHM_K);
        finishSM(pA0, pA1, alA, l_reg, pa0, pa1, pa2, pa3); SBAR();
        SLOAD(1, (j + 2) * 64); SBAR();
        PVD0(vb0); partialSM(pB0, pB1, m_reg, alB);
        __syncthreads(); SWAIT(); SWRITE(0, 0);
        RESC(alB); __syncthreads();
        SBAR(); BINIT(pA0, pA1, (j + 1) * 64); QKT(pA0, pA1, K_lds);
        finishSM(pB0, pB1, alB, l_reg, pa0, pa1, pa2, pa3); SBAR();
        if (j + 3 < NT) SLOAD(0, (j + 3) * 64); SBAR();
        PVD0(vb0 + SHM_V); partialSM(pA0, pA1, m_reg, alA);
        __syncthreads(); SWAIT(); SWRITE(1, 1);
        RESC(alA); __syncthreads();
    }
    SBAR(); BINIT(pB0, pB1, (NT - 1) * 64); QKT(pB0, pB1, K_lds + SHM_K);
    finishSM(pA0, pA1, alA, l_reg, pa0, pa1, pa2, pa3); SBAR();
    PVD0(vb0); partialSM(pB0, pB1, m_reg, alB);
    __syncthreads(); RESC(alB);
    finishSM(pB0, pB1, alB, l_reg, pa0, pa1, pa2, pa3); SBAR();
    PVD0(vb0 + SHM_V);
    if (hi == 0) li_l[r32] = l_reg; asm volatile("s_waitcnt lgkmcnt(0)" ::: "memory");
    float rli[16];
#pragma unroll
    for (int r = 0; r < 16; ++r) rli[r] = __builtin_amdgcn_rcpf(li_l[crow(r, hi)]);
    __syncthreads();
    LAS float* X = (LAS float*)(lds + L_X) + (size_t)wq * 4096 + lane;
    if (sub == 1) {
#pragma unroll
        for (int d0 = 0; d0 < 4; ++d0)
#pragma unroll
            for (int r = 0; r < 16; ++r) X[(d0 * 16 + r) * 64] = o[d0][r] * rli[r] * (-lam);
    }
    __syncthreads();
    if (sub == 0) {
        float ss[16];
#pragma unroll
        for (int r = 0; r < 16; ++r) ss[r] = 0.f;
#pragma unroll
        for (int d0 = 0; d0 < 4; ++d0)
#pragma unroll
            for (int r = 0; r < 16; ++r) { const float v = o[d0][r] * rli[r] + X[(d0 * 16 + r) * 64]; o[d0][r] = v; ss[r] += v * v; }
#pragma unroll
        for (int r = 0; r < 16; ++r) {
#pragma unroll
            for (int msk = 1; msk < 32; msk <<= 1) ss[r] += __shfl_xor(ss[r], msk);
            ss[r] = (1.f - LAMBDA_INIT) / sqrtf(ss[r] * (1.f / 128.f) + SUBLN_EPS); }
        float gsub[4];
#pragma unroll
        for (int d0 = 0; d0 < 4; ++d0) gsub[d0] = subln[d0 * 32 + r32];
        bf16* Ow = attn + (rowb + q0w) * DM + h * 128 + r32;
#pragma unroll
        for (int r = 0; r < 16; ++r) { const int orow = crow(r, hi);
#pragma unroll
            for (int d0 = 0; d0 < 4; ++d0) Ow[(size_t)orow * DM + d0 * 32] = (bf16)f2bf(o[d0][r] * ss[r] * gsub[d0]); }
    }
    __syncthreads();
#undef SLOAD
#undef SWRITE
#undef SWAIT
#undef RESC
#undef BINIT
#undef QKT
#undef PVD0
}

constexpr int D2_SLOT = 16384, D2_K = 0, D2_V = 3 * D2_SLOT, D2_WS = 6 * D2_SLOT, D2_T = D2_WS + NWAVES * 256;
static_assert(D2_T + TLEN * 4 <= RING_BYTES, "diff v2 LDS map");
#define D2_WAIT_BAR(N) asm volatile("s_waitcnt vmcnt(" #N ") lgkmcnt(0)\n\ts_barrier" ::: "memory")
__device__ __forceinline__ void softmax2(f32x16& p0, f32x16& p1, float& m_run, float& l_reg, bool first, float& alpha, bf16x8& pa0, bf16x8& pa1, bf16x8& pa2, bf16x8& pa3) {
    float mx4[4] = {p0[0], p0[1], p0[2], p0[3]};
#pragma unroll
    for (int r = 4; r < 16; ++r) mx4[r & 3] = fmaxf(mx4[r & 3], p0[r]);
#pragma unroll
    for (int r = 0; r < 16; ++r) mx4[r & 3] = fmaxf(mx4[r & 3], p1[r]);
    float pmax = fmaxf(fmaxf(mx4[0], mx4[1]), fmaxf(mx4[2], mx4[3]));
    { auto rr = __builtin_amdgcn_permlane32_swap(__float_as_uint(pmax), __float_as_uint(pmax), false, false); pmax = fmaxf(__uint_as_float(rr[0]), __uint_as_float(rr[1])); }
    alpha = 1.f;
    if (__builtin_expect(first || !__all(pmax <= THR), 0)) {
        const float delta = first ? pmax : fmaxf(pmax, 0.f);
        m_run += delta; alpha = first ? 1.f : __builtin_amdgcn_exp2f(-delta);
#pragma unroll
        for (int r = 0; r < 16; ++r) { p0[r] -= delta; p1[r] -= delta; }
    }
#pragma unroll
    for (int r = 0; r < 16; ++r) { p0[r] = __builtin_amdgcn_exp2f(p0[r]); p1[r] = __builtin_amdgcn_exp2f(p1[r]); }
    float ps4[4];
#pragma unroll
    for (int c = 0; c < 4; ++c) { float a_ = p0[4 * c] + p0[4 * c + 1]; a_ += p0[4 * c + 2]; a_ += p0[4 * c + 3]; a_ += p1[4 * c]; a_ += p1[4 * c + 1]; a_ += p1[4 * c + 2]; a_ += p1[4 * c + 3]; ps4[c] = a_; }
    float ps = (ps4[0] + ps4[1]) + (ps4[2] + ps4[3]);
    { auto rr = __builtin_amdgcn_permlane32_swap(__float_as_uint(ps), __float_as_uint(ps), false, false); ps = __uint_as_float(rr[0]) + __uint_as_float(rr[1]); }
    l_reg = l_reg * alpha + ps;
#define PK4(P, BASE, OUT) do { unsigned a0 = cvtpk(P[BASE + 0], P[BASE + 1]), a1 = cvtpk(P[BASE + 2], P[BASE + 3]);   \
    unsigned b0 = cvtpk(P[BASE + 4], P[BASE + 5]), b1 = cvtpk(P[BASE + 6], P[BASE + 7]);                              \
    auto r0 = __builtin_amdgcn_permlane32_swap(a0, b0, false, false); auto r1 = __builtin_amdgcn_permlane32_swap(a1, b1, false, false); \
    v4u w = {r0[0], r1[0], r0[1], r1[1]}; OUT = __builtin_bit_cast(bf16x8, w); } while (0)
    PK4(p0, 0, pa0); PK4(p0, 8, pa1); PK4(p1, 0, pa2); PK4(p1, 8, pa3);
#undef PK4
}
struct VFrag { s16x4 l0, h0, l1, h1; };
template <int KS, int DP> __device__ __forceinline__ void pv2_read(VFrag& f, int vb) {
    f.l0 = tr_read<v_rd_off<4>(2 * DP, KS, 0)>(vb); f.h0 = tr_read<v_rd_off<4>(2 * DP, KS, 1)>(vb); f.l1 = tr_read<v_rd_off<4>(2 * DP + 1, KS, 0)>(vb); f.h1 = tr_read<v_rd_off<4>(2 * DP + 1, KS, 1)>(vb);
}
template <int DP> __device__ __forceinline__ void pv2_mma(f32x16 (&o1)[4], f32x16 (&o2)[4], const VFrag& f, bf16x8 pa, bf16x8 pb) {
#define PK(L, H) (bf16x8){L[0], L[1], L[2], L[3], H[0], H[1], H[2], H[3]}
    const bf16x8 v0 = PK(f.l0, f.h0), v1 = PK(f.l1, f.h1);
#undef PK
    o1[2 * DP] = __builtin_amdgcn_mfma_f32_32x32x16_bf16(pa, v0, o1[2 * DP], 0, 0, 0); o1[2 * DP + 1] = __builtin_amdgcn_mfma_f32_32x32x16_bf16(pa, v1, o1[2 * DP + 1], 0, 0, 0);
    o2[2 * DP] = __builtin_amdgcn_mfma_f32_32x32x16_bf16(pb, v0, o2[2 * DP], 0, 0, 0); o2[2 * DP + 1] = __builtin_amdgcn_mfma_f32_32x32x16_bf16(pb, v1, o2[2 * DP + 1], 0, 0, 0);
}
#define PV2_W4() do { asm volatile("s_waitcnt lgkmcnt(4)" ::: "memory"); SBAR(); } while (0)
__device__ __forceinline__ void pv2_all(f32x16 (&o1)[4], f32x16 (&o2)[4], int vb, const bf16x8 (&pa)[4], const bf16x8 (&pb)[4]) {
    VFrag fa, fb;
    pv2_read<0, 0>(fa, vb);
    pv2_read<0, 1>(fb, vb); PV2_W4(); pv2_mma<0>(o1, o2, fa, pa[0], pb[0]); SBAR();
    pv2_read<1, 0>(fa, vb); PV2_W4(); pv2_mma<1>(o1, o2, fb, pa[0], pb[0]); SBAR();
    pv2_read<1, 1>(fb, vb); PV2_W4(); pv2_mma<0>(o1, o2, fa, pa[1], pb[1]); SBAR();
    pv2_read<2, 0>(fa, vb); PV2_W4(); pv2_mma<1>(o1, o2, fb, pa[1], pb[1]); SBAR();
    pv2_read<2, 1>(fb, vb); PV2_W4(); pv2_mma<0>(o1, o2, fa, pa[2], pb[2]); SBAR();
    pv2_read<3, 0>(fa, vb); PV2_W4(); pv2_mma<1>(o1, o2, fb, pa[2], pb[2]); SBAR();
    pv2_read<3, 1>(fb, vb); PV2_W4(); pv2_mma<0>(o1, o2, fa, pa[3], pb[3]); SBAR();
    asm volatile("s_waitcnt lgkmcnt(0)" ::: "memory"); SBAR(); pv2_mma<1>(o1, o2, fb, pa[3], pb[3]);
}
#undef PV2_W4
__device__ __forceinline__ void diff_unit2(const bf16* __restrict__ proj, bf16* __restrict__ attn, const float* relb, const float* subln, float lam, int b, int h, int qb,
                                           LAS unsigned char* lds, int tid_in) {
    int tid = tid_in; asm volatile("" : "+v"(tid));
    const int wid = __builtin_amdgcn_readfirstlane(tid >> 6), lane = tid & 63, r32 = lane & 31, hi = lane >> 5;
    LAS float* wsf = (LAS float*)(lds + D2_WS) + wid * 64; LAS float* T = (LAS float*)(lds + D2_T);
    for (int i = tid; i < TLEN; i += NWAVES * 64) T[i] = relb[(unsigned)(t5_bucket(i - TOFF) * 12 + h)] * LOG2E;
    const float cneg = __builtin_bit_cast(float, __builtin_amdgcn_readfirstlane(__builtin_bit_cast(int, relb[15 * 12 + h] * LOG2E))), cpos = __builtin_bit_cast(float, __builtin_amdgcn_readfirstlane(__builtin_bit_cast(int, relb[31 * 12 + h] * LOG2E)));
    const size_t rowb = (size_t)b * SEQ;
    const int q0w = qb * 256 + wid * 32;
    const bf16* Kh = proj + rowb * NIN + COL_KA + h * 128; const bf16* Vh = proj + rowb * NIN + COL_VA + h * 128;
    unsigned kofs, vofs;
    { const int pc = 2 * wid;
        const int rK = 4 * pc + (lane >> 4), cK = (lane & 15) ^ (rK & 15); kofs = (unsigned)(rK * NIN + cK * 8);
        const int sV = 2 * pc + (lane >> 5), kk = (sV >> 2) * 8 + ((lane & 31) >> 2), kV = (kk & ~0xC) | ((kk & 4) << 1) | ((kk & 8) >> 1), cV = (sV & 3) * 32 + (lane & 3) * 8;
        vofs = (unsigned)(kV * NIN + cV); }
#define D2_DMA(t, slot) do { const bf16* kt_ = Kh + (size_t)(t) * 64 * NIN; const bf16* vt_ = Vh + (size_t)(t) * 64 * NIN; \
    __builtin_amdgcn_global_load_lds((const unsigned*)(kt_ + kofs), (LAS unsigned*)(lds + D2_K + (slot) + (2 * wid) * 1024), 16, 0, 0); \
    __builtin_amdgcn_global_load_lds((const unsigned*)(kt_ + ((kofs ^ 32u) + 4u * NIN)), (LAS unsigned*)(lds + D2_K + (slot) + (2 * wid + 1) * 1024), 16, 0, 0); \
    __builtin_amdgcn_global_load_lds((const unsigned*)(vt_ + vofs), (LAS unsigned*)(lds + D2_V + (slot) + (2 * wid) * 1024), 16, 0, 0); \
    __builtin_amdgcn_global_load_lds((const unsigned*)(vt_ + (vofs + 64u)), (LAS unsigned*)(lds + D2_V + (slot) + (2 * wid + 1) * 1024), 16, 0, 0); } while (0)
    bf16x8 qr[8];
    { const bf16* Qu = proj + (rowb + q0w) * NIN + COL_QA + h * 128; const unsigned qo = (unsigned)(r32 * NIN + hi * 8);
#pragma unroll
      for (int d0 = 0; d0 < 8; ++d0) qr[d0] = ld8(Qu + (qo + d0 * 16)); }
    D2_DMA(0, 0); D2_DMA(1, D2_SLOT);
    f32x16 o1[4], o2[4];
#pragma unroll
    for (int d = 0; d < 4; ++d) { o1[d] = f32x16{}; o2[d] = f32x16{}; }
    float m_run[2] = {0.f, 0.f}, l_reg[2] = {0.f, 0.f};
    const int vbase = (int)(unsigned)(uintptr_t)(lds + D2_V) + v_rd_base(lane);
    constexpr int NT = SEQ / 64;
    int sl_cur = 0, sl_nxt2 = 2 * D2_SLOT;
#pragma unroll 1
    for (int j = 0; j < NT; ++j) {
        if (j + 1 < NT) D2_WAIT_BAR(4); else D2_WAIT_BAR(0);
        if (j + 2 < NT) D2_DMA(j + 2, sl_nxt2);
        const LAS unsigned char* Ks = lds + D2_K + sl_cur;
        const int d_ = j * 64 - q0w; const bool near = d_ > -622 && d_ < 590; const float cfar = d_ < 0 ? cneg : cpos; const bool first = (j == 0);
        const LAS float* tp = T + (d_ - r32 + 4 * hi + TOFF);
        bf16x8 pa[2][4]; float alpha[2];
#pragma unroll
        for (int s2 = 0; s2 < 2; ++s2) {
            f32x16 p0, p1;
            if (near) {
#pragma unroll
                for (int r = 0; r < 16; ++r) { p0[r] = tp[(r & 3) + 8 * (r >> 2)] - m_run[s2]; p1[r] = tp[32 + (r & 3) + 8 * (r >> 2)] - m_run[s2]; } }
            else { const float c_ = cfar - m_run[s2];
#pragma unroll
                for (int r = 0; r < 16; ++r) { p0[r] = c_; p1[r] = c_; } }
#pragma unroll
            for (int d0 = 0; d0 < 4; ++d0) { const int cb = ((4 * s2 + d0) * 16 + hi * 8) * 2;
                const bf16x8 b0 = *(const LAS bf16x8*)(Ks + KSWZ16(r32, cb)); const bf16x8 b1 = *(const LAS bf16x8*)(Ks + KSWZ16(32 + r32, cb));
                p0 = __builtin_amdgcn_mfma_f32_32x32x16_bf16(b0, qr[4 * s2 + d0], p0, 0, 0, 0); p1 = __builtin_amdgcn_mfma_f32_32x32x16_bf16(b1, qr[4 * s2 + d0], p1, 0, 0, 0); }
            softmax2(p0, p1, m_run[s2], l_reg[s2], first, alpha[s2], pa[s2][0], pa[s2][1], pa[s2][2], pa[s2][3]);
            SBAR();
        }
        if (__any(alpha[0] < 1.f)) { if (hi == 0) wsf[r32] = alpha[0]; asm volatile("s_waitcnt lgkmcnt(0)" ::: "memory");
#pragma unroll
            for (int d = 0; d < 4; ++d)
#pragma unroll
                for (int r = 0; r < 16; ++r) o1[d][r] *= wsf[crow(r, hi)]; }
        if (__any(alpha[1] < 1.f)) { if (hi == 0) wsf[32 + r32] = alpha[1]; asm volatile("s_waitcnt lgkmcnt(0)" ::: "memory");
#pragma unroll
            for (int d = 0; d < 4; ++d)
#pragma unroll
                for (int r = 0; r < 16; ++r) o2[d][r] *= wsf[32 + crow(r, hi)]; }
        const int vb = vbase + sl_cur;
        asm volatile("s_waitcnt lgkmcnt(0)" ::: "memory"); SBAR();
        pv2_all(o1, o2, vb, pa[0], pa[1]);
        sl_cur = (sl_cur == 2 * D2_SLOT) ? 0 : sl_cur + D2_SLOT; sl_nxt2 = (sl_nxt2 == 2 * D2_SLOT) ? 0 : sl_nxt2 + D2_SLOT;
    }
    asm volatile("s_waitcnt lgkmcnt(0)\n\ts_barrier" ::: "memory");
    int lane2; asm volatile("v_mbcnt_lo_u32_b32 %0, -1, 0\n\tv_mbcnt_hi_u32_b32 %0, -1, %0" : "=v"(lane2));
    const int r32e = lane2 & 31, hie = lane2 >> 5;
    LAS float* wse = (LAS float*)(lds + D2_WS) + wid * 64;
    if (hie == 0) { wse[r32e] = l_reg[0]; wse[32 + r32e] = l_reg[1]; }
    asm volatile("s_waitcnt lgkmcnt(0)" ::: "memory");
    float ss[16];
    int nlb = __builtin_amdgcn_readfirstlane(__builtin_bit_cast(int, lam)) ^ (int)0x80000000u; asm volatile("" : "+s"(nlb)); const float nlam = __builtin_bit_cast(float, nlb);
#pragma unroll
    for (int r = 0; r < 16; ++r) { const float ra = __builtin_amdgcn_rcpf(wse[crow(r, hie)]), rb = nlam * __builtin_amdgcn_rcpf(wse[32 + crow(r, hie)]); float acc = 0.f;
#pragma unroll
        for (int d0 = 0; d0 < 4; ++d0) { const float v = o1[d0][r] * ra + o2[d0][r] * rb; o1[d0][r] = v; acc += v * v; }
        ss[r] = acc; }
#pragma unroll
    for (int r = 0; r < 16; ++r) {
#pragma unroll
        for (int msk = 1; msk < 32; msk <<= 1) ss[r] += __builtin_bit_cast(float, __builtin_amdgcn_ds_bpermute((lane2 ^ msk) << 2, __builtin_bit_cast(int, ss[r])));
        ss[r] = (1.f - LAMBDA_INIT) * __builtin_amdgcn_rsqf(ss[r] * (1.f / 128.f) + SUBLN_EPS); }
    float gsub[4];
#pragma unroll
    for (int d0 = 0; d0 < 4; ++d0) gsub[d0] = subln[d0 * 32 + r32e];
    bf16* Ou = attn + (rowb + q0w) * DM + h * 128;
#pragma unroll
    for (int r = 0; r < 16; ++r) { const unsigned oo = (unsigned)(crow(r, hie) * DM + r32e);
#pragma unroll
        for (int d0 = 0; d0 < 4; d0 += 2) { const unsigned pk = cvtpk(o1[d0][r] * ss[r] * gsub[d0], o1[d0 + 1][r] * ss[r] * gsub[d0 + 1]); Ou[oo + d0 * 32] = (bf16)(pk & 0xffffu); Ou[oo + d0 * 32 + 32] = (bf16)(pk >> 16); } }
#undef D2_DMA
}

constexpr int D3_K = 0, D3_V = 4 * D2_SLOT, D3_WS = RING_BYTES + 1024, D3_T = D3_WS + NWAVES * 256, D3_FLAG = D3_T + TLEN * 4;
static_assert(D3_V + 4 * D2_SLOT <= RING_BYTES && D3_FLAG + 4 <= LDS_BYTES, "diff v3 LDS map");
__device__ __forceinline__ void softmax3(f32x16& p0, f32x16& p1, float& l_reg, bf16x8& pa0, bf16x8& pa1, bf16x8& pa2, bf16x8& pa3) {
#pragma unroll
    for (int r = 0; r < 16; ++r) { p0[r] = __builtin_amdgcn_exp2f(p0[r]); p1[r] = __builtin_amdgcn_exp2f(p1[r]); }
    float ps4[4];
#pragma unroll
    for (int c = 0; c < 4; ++c) { float a_ = p0[4 * c] + p0[4 * c + 1]; a_ += p0[4 * c + 2]; a_ += p0[4 * c + 3]; a_ += p1[4 * c]; a_ += p1[4 * c + 1]; a_ += p1[4 * c + 2]; a_ += p1[4 * c + 3]; ps4[c] = a_; }
    float ps = (ps4[0] + ps4[1]) + (ps4[2] + ps4[3]);
    { auto rr = __builtin_amdgcn_permlane32_swap(__float_as_uint(ps), __float_as_uint(ps), false, false); ps = __uint_as_float(rr[0]) + __uint_as_float(rr[1]); }
    l_reg += ps;
#define PK4(P, BASE, OUT) do { unsigned a0 = cvtpk(P[BASE + 0], P[BASE + 1]), a1 = cvtpk(P[BASE + 2], P[BASE + 3]);   \
    unsigned b0 = cvtpk(P[BASE + 4], P[BASE + 5]), b1 = cvtpk(P[BASE + 6], P[BASE + 7]);                              \
    auto r0 = __builtin_amdgcn_permlane32_swap(a0, b0, false, false); auto r1 = __builtin_amdgcn_permlane32_swap(a1, b1, false, false); \
    v4u w = {r0[0], r1[0], r0[1], r1[1]}; OUT = __builtin_bit_cast(bf16x8, w); } while (0)
    PK4(p0, 0, pa0); PK4(p0, 8, pa1); PK4(p1, 0, pa2); PK4(p1, 8, pa3);
#undef PK4
}
__device__ __forceinline__ bool diff_unit3(const bf16* __restrict__ proj, bf16* __restrict__ attn, const float* relb, const float* subln, float lam, int b, int h, int qb,
                                           LAS unsigned char* lds, int tid_in) {
    int tid = tid_in; asm volatile("" : "+v"(tid));
    const int wid = __builtin_amdgcn_readfirstlane(tid >> 6), lane = tid & 63, r32 = lane & 31, hi = lane >> 5;
    LAS float* wsf = (LAS float*)(lds + D3_WS) + wid * 64; LAS float* T = (LAS float*)(lds + D3_T);
    const float cneg = __builtin_bit_cast(float, __builtin_amdgcn_readfirstlane(__builtin_bit_cast(int, relb[15 * 12 + h] * LOG2E))), cpos = __builtin_bit_cast(float, __builtin_amdgcn_readfirstlane(__builtin_bit_cast(int, relb[31 * 12 + h] * LOG2E)));
    const size_t rowb = (size_t)b * SEQ;
    const int q0w = qb * 256 + wid * 32;
    const bool refneg = (qb >= 8);
    const float cref = refneg ? cneg : cpos, cother = (refneg ? cpos : cneg) - cref;
    for (int i = tid; i < TLEN; i += NWAVES * 64) T[i] = relb[(unsigned)(t5_bucket(i - TOFF) * 12 + h)] * LOG2E - cref;
    if (tid == 0) *(LAS unsigned*)(lds + D3_FLAG) = 0u;
    const bf16* Kh = proj + rowb * NIN + COL_KA + h * 128; const bf16* Vh = proj + rowb * NIN + COL_VA + h * 128;
    unsigned kofs, vofs;
    { const int pc = 2 * wid;
        const int rK = 4 * pc + (lane >> 4), cK = (lane & 15) ^ (rK & 15); kofs = (unsigned)(rK * NIN + cK * 8);
        const int sV = 2 * pc + (lane >> 5), kk = (sV >> 2) * 8 + ((lane & 31) >> 2), kV = (kk & ~0xC) | ((kk & 4) << 1) | ((kk & 8) >> 1), cV = (sV & 3) * 32 + (lane & 3) * 8;
        vofs = (unsigned)(kV * NIN + cV); }
#define D2_DMA(t, slot) do { const bf16* kt_ = Kh + (size_t)(t) * 64 * NIN; const bf16* vt_ = Vh + (size_t)(t) * 64 * NIN; \
    __builtin_amdgcn_global_load_lds((const unsigned*)(kt_ + kofs), (LAS unsigned*)(lds + D3_K + (slot) + (2 * wid) * 1024), 16, 0, 0); \
    __builtin_amdgcn_global_load_lds((const unsigned*)(kt_ + ((kofs ^ 32u) + 4u * NIN)), (LAS unsigned*)(lds + D3_K + (slot) + (2 * wid + 1) * 1024), 16, 0, 0); \
    __builtin_amdgcn_global_load_lds((const unsigned*)(vt_ + vofs), (LAS unsigned*)(lds + D3_V + (slot) + (2 * wid) * 1024), 16, 0, 0); \
    __builtin_amdgcn_global_load_lds((const unsigned*)(vt_ + (vofs + 64u)), (LAS unsigned*)(lds + D3_V + (slot) + (2 * wid + 1) * 1024), 16, 0, 0); } while (0)
    bf16x8 qr[8];
    { const bf16* Qu = proj + (rowb + q0w) * NIN + COL_QA + h * 128; const unsigned qo = (unsigned)(r32 * NIN + hi * 8);
#pragma unroll
      for (int d0 = 0; d0 < 8; ++d0) qr[d0] = ld8(Qu + (qo + d0 * 16)); }
    D2_DMA(0, 0); D2_DMA(1, D2_SLOT);
    f32x16 o1[4], o2[4];
#pragma unroll
    for (int d = 0; d < 4; ++d) { o1[d] = f32x16{}; o2[d] = f32x16{}; }
    float l_reg[2] = {0.f, 0.f};
    const int vbase = (int)(unsigned)(uintptr_t)(lds + D3_V) + v_rd_base(lane);
    constexpr int NT = SEQ / 64;
    bf16x8 pa[2][4];
#define D3_SM(jj, slk) do { const LAS unsigned char* Ks = lds + D3_K + (slk); \
        const int d_ = (jj) * 64 - q0w; const bool near = d_ > -622 && d_ < 590; const bool zero_init = !near && ((d_ < 0) == refneg); \
        const LAS float* tp = T + (d_ - r32 + 4 * hi + TOFF); \
        _Pragma("unroll") for (int s2 = 0; s2 < 2; ++s2) { \
            f32x16 p0, p1; \
            if (zero_init) { p0 = f32x16{}; p1 = f32x16{}; } \
            else if (near) { _Pragma("unroll") for (int r = 0; r < 16; ++r) { p0[r] = tp[(r & 3) + 8 * (r >> 2)]; p1[r] = tp[32 + (r & 3) + 8 * (r >> 2)]; } } \
            else { _Pragma("unroll") for (int r = 0; r < 16; ++r) { p0[r] = cother; p1[r] = cother; } } \
            _Pragma("unroll") for (int d0 = 0; d0 < 4; ++d0) { const int cb = ((4 * s2 + d0) * 16 + hi * 8) * 2; \
                const bf16x8 b0 = *(const LAS bf16x8*)(Ks + KSWZ16(r32, cb)); const bf16x8 b1 = *(const LAS bf16x8*)(Ks + KSWZ16(32 + r32, cb)); \
                p0 = __builtin_amdgcn_mfma_f32_32x32x16_bf16(b0, qr[4 * s2 + d0], p0, 0, 0, 0); p1 = __builtin_amdgcn_mfma_f32_32x32x16_bf16(b1, qr[4 * s2 + d0], p1, 0, 0, 0); } \
            softmax3(p0, p1, l_reg[s2], pa[s2][0], pa[s2][1], pa[s2][2], pa[s2][3]); \
            SBAR(); } } while (0)
#define D3_PV(slv) do { asm volatile("s_waitcnt lgkmcnt(0)" ::: "memory"); SBAR(); pv2_all(o1, o2, vbase + (slv), pa[0], pa[1]); SBAR(); } while (0)
#define D3_NEXT(x) ((x) == 3 * D2_SLOT ? 0 : (x) + D2_SLOT)
    int sl_prev = 3 * D2_SLOT, sl_cur = 0, sl_nxt2 = 2 * D2_SLOT;
    if (wid < 4) {
#pragma unroll 1
        for (int j = 0; j < NT; ++j) {
            if (j + 1 < NT) D2_WAIT_BAR(4); else D2_WAIT_BAR(0);
            if (j + 2 < NT) D2_DMA(j + 2, sl_nxt2);
            D3_SM(j, sl_cur);
            D3_PV(sl_cur);
            sl_cur = D3_NEXT(sl_cur); sl_nxt2 = D3_NEXT(sl_nxt2);
        }
    } else {
#pragma unroll 1
        for (int j = 0; j < NT; ++j) {
            if (j + 1 < NT) D2_WAIT_BAR(4); else D2_WAIT_BAR(0);
            if (j + 2 < NT) D2_DMA(j + 2, sl_nxt2);
            if (j >= 1) D3_PV(sl_prev);
            D3_SM(j, sl_cur);
            sl_prev = sl_cur; sl_cur = D3_NEXT(sl_cur); sl_nxt2 = D3_NEXT(sl_nxt2);
        }
        D3_PV(sl_prev);
    }
#undef D3_SM
#undef D3_PV
#undef D3_NEXT
    if (!((l_reg[0] > 1e-30f) && (l_reg[0] < 1e30f) && (l_reg[1] > 1e-30f) && (l_reg[1] < 1e30f))) *(LAS unsigned*)(lds + D3_FLAG) = 1u;
    asm volatile("s_waitcnt lgkmcnt(0)\n\ts_barrier" ::: "memory");
    const bool good = (*(const LAS unsigned*)(lds + D3_FLAG) == 0u);
    int lane2; asm volatile("v_mbcnt_lo_u32_b32 %0, -1, 0\n\tv_mbcnt_hi_u32_b32 %0, -1, %0" : "=v"(lane2));
    const int r32e = lane2 & 31, hie = lane2 >> 5;
    LAS float* wse = (LAS float*)(lds + D3_WS) + wid * 64;
    if (hie == 0) { wse[r32e] = l_reg[0]; wse[32 + r32e] = l_reg[1]; }
    asm volatile("s_waitcnt lgkmcnt(0)" ::: "memory");
    float ss[16];
    int nlb = __builtin_amdgcn_readfirstlane(__builtin_bit_cast(int, lam)) ^ (int)0x80000000u; asm volatile("" : "+s"(nlb)); const float nlam = __builtin_bit_cast(float, nlb);
#pragma unroll
    for (int r = 0; r < 16; ++r) { const float ra = __builtin_amdgcn_rcpf(wse[crow(r, hie)]), rb = nlam * __builtin_amdgcn_rcpf(wse[32 + crow(r, hie)]); float acc = 0.f;
#pragma unroll
        for (int d0 = 0; d0 < 4; ++d0) { const float v = o1[d0][r] * ra + o2[d0][r] * rb; o1[d0][r] = v; acc += v * v; }
        ss[r] = acc; }
#pragma unroll
    for (int r = 0; r < 16; ++r) {
#pragma unroll
        for (int msk = 1; msk < 32; msk <<= 1) ss[r] += __builtin_bit_cast(float, __builtin_amdgcn_ds_bpermute((lane2 ^ msk) << 2, __builtin_bit_cast(int, ss[r])));
        ss[r] = (1.f - LAMBDA_INIT) * __builtin_amdgcn_rsqf(ss[r] * (1.f / 128.f) + SUBLN_EPS); }
    float gsub[4];
#pragma unroll
    for (int d0 = 0; d0 < 4; ++d0) gsub[d0] = subln[d0 * 32 + r32e];
    { LAS unsigned char* stb = lds + wid * 8192; LAS unsigned* stg = (LAS unsigned*)stb; const bool odd = r32e & 1;
#pragma unroll
      for (int r = 0; r < 16; ++r) { const int row = crow(r, hie);
          const float v0 = o1[0][r] * ss[r] * gsub[0], v1 = o1[1][r] * ss[r] * gsub[1], v2 = o1[2][r] * ss[r] * gsub[2], v3 = o1[3][r] * ss[r] * gsub[3];
          const float ga = __builtin_bit_cast(float, __builtin_amdgcn_update_dpp(0, __builtin_bit_cast(int, odd ? v0 : v1), 0xB1, 0xF, 0xF, false));
          const float gb = __builtin_bit_cast(float, __builtin_amdgcn_update_dpp(0, __builtin_bit_cast(int, odd ? v2 : v3), 0xB1, 0xF, 0xF, false));
          const unsigned pa_ = odd ? cvtpk(ga, v1) : cvtpk(v0, ga), pb_ = odd ? cvtpk(gb, v3) : cvtpk(v2, gb);
          const int dw = odd ? 16 + (r32e >> 1) : (r32e >> 1);
          stg[row * 64 + dw] = pa_; stg[row * 64 + 32 + dw] = pb_; }
      asm volatile("s_waitcnt lgkmcnt(0)" ::: "memory");
      bf16* Ou = attn + (rowb + q0w) * DM + h * 128;
#pragma unroll
      for (int g = 0; g < 8; ++g) { const int row = g * 4 + (lane2 >> 4), ch = lane2 & 15;
          const v4u wv = *(const LAS v4u*)(stb + row * 256 + ch * 16);
          *(v4u*)(Ou + (unsigned)(row * DM + ch * 8)) = wv; } }
    asm volatile("s_waitcnt lgkmcnt(0)\n\ts_barrier" ::: "memory");
    return good;
#undef D2_DMA
}
#undef D2_WAIT_BAR

constexpr int DL_K = 0, DL_V = 65536;
constexpr int DL_T = RING_BYTES + 1024, DT_OFF = 128, DT_LEN = 256;
constexpr int DL_WS = DL_T + 3 * DT_LEN * 4;
static_assert(DL_WS + NWAVES * 256 <= LDS_BYTES, "dilated LDS map");
constexpr size_t DSCR_O = 0, DSCR_L = (size_t)3 * 1024 * 64 * 2, DSCR_BYTES = DSCR_L + 3 * 1024 * 4;
#define KSWZ64(row, colB) ((row) * 128 + ((colB) ^ (((row) & 7) << 4)))
__device__ __forceinline__ void dil_load(bf16x8 (&buf)[8], const bf16* __restrict__ tile0, size_t gstride, unsigned voff) {
#pragma unroll
    for (int g = 0; g < 8; ++g) buf[g] = ld8(tile0 + g * gstride + voff);
}
template <int HALF> __device__ __forceinline__ void dil_softmax(f32x16& p0, f32x16& p1, float& m_reg, float& l_reg, float& alpha, bf16x8& pa0, bf16x8& pa1, bf16x8& pa2, bf16x8& pa3) {
    float mx4[4];
    if constexpr (HALF != 2) { mx4[0] = p0[0]; mx4[1] = p0[1]; mx4[2] = p0[2]; mx4[3] = p0[3];
#pragma unroll
        for (int r = 4; r < 16; ++r) mx4[r & 3] = fmaxf(mx4[r & 3], p0[r]); }
    else { mx4[0] = p1[0]; mx4[1] = p1[1]; mx4[2] = p1[2]; mx4[3] = p1[3]; }
    if constexpr (HALF != 1) {
#pragma unroll
        for (int r = (HALF == 2 ? 4 : 0); r < 16; ++r) mx4[r & 3] = fmaxf(mx4[r & 3], p1[r]); }
    float pmax = fmaxf(fmaxf(mx4[0], mx4[1]), fmaxf(mx4[2], mx4[3]));
    { auto rr = __builtin_amdgcn_permlane32_swap(__float_as_uint(pmax), __float_as_uint(pmax), false, false); pmax = fmaxf(__uint_as_float(rr[0]), __uint_as_float(rr[1])); }
    float mn;
    if (__builtin_expect(__all(pmax - m_reg <= THR), 1)) { mn = m_reg; alpha = 1.f; }
    else { mn = fmaxf(m_reg, pmax); alpha = __builtin_amdgcn_exp2f(m_reg - mn); m_reg = mn; }
    if constexpr (HALF != 2) {
#pragma unroll
        for (int r = 0; r < 16; ++r) p0[r] = __builtin_amdgcn_exp2f(p0[r] - mn); }
    if constexpr (HALF != 1) {
#pragma unroll
        for (int r = 0; r < 16; ++r) p1[r] = __builtin_amdgcn_exp2f(p1[r] - mn); }
    float ps4[4];
#pragma unroll
    for (int c = 0; c < 4; ++c) { float a_ = 0.f;
        if constexpr (HALF != 2) { a_ = p0[4 * c] + p0[4 * c + 1]; a_ += p0[4 * c + 2]; a_ += p0[4 * c + 3]; }
        if constexpr (HALF != 1) { a_ += p1[4 * c]; a_ += p1[4 * c + 1]; a_ += p1[4 * c + 2]; a_ += p1[4 * c + 3]; }
        ps4[c] = a_; }
    float ps = (ps4[0] + ps4[1]) + (ps4[2] + ps4[3]);
    { auto rr = __builtin_amdgcn_permlane32_swap(__float_as_uint(ps), __float_as_uint(ps), false, false); ps = __uint_as_float(rr[0]) + __uint_as_float(rr[1]); }
    l_reg = l_reg * alpha + ps;
#define PK4(P, BASE, OUT) do { unsigned a0 = cvtpk(P[BASE + 0], P[BASE + 1]), a1 = cvtpk(P[BASE + 2], P[BASE + 3]);   \
    unsigned b0 = cvtpk(P[BASE + 4], P[BASE + 5]), b1 = cvtpk(P[BASE + 6], P[BASE + 7]);                              \
    auto r0 = __builtin_amdgcn_permlane32_swap(a0, b0, false, false); auto r1 = __builtin_amdgcn_permlane32_swap(a1, b1, false, false); \
    v4u w = {r0[0], r1[0], r0[1], r1[1]}; OUT = __builtin_bit_cast(bf16x8, w); } while (0)
    if constexpr (HALF != 2) { PK4(p0, 0, pa0); PK4(p0, 8, pa1); }
    if constexpr (HALF != 1) { PK4(p1, 0, pa2); PK4(p1, 8, pa3); }
#undef PK4
}
template <int T, int QH> __device__ __forceinline__ void dil_step_sm(f32x16 (&o)[2], const bf16x8 (&qr)[4], float& m_reg, float& l_reg, const LAS float* Tb, const LAS unsigned char* Kt, LAS float* wsf,
                                                                      int r32, int hi, bf16x8& pa0, bf16x8& pa1, bf16x8& pa2, bf16x8& pa3) {
    constexpr int HALF = (T == 0 && QH == 1) ? 2 : ((T == 2 && QH == 0) ? 1 : 0);
    f32x16 p0, p1;
    { const LAS float* tp = Tb + (64 * T - 64 - 32 * QH - r32 + 4 * hi + DT_OFF);
      if constexpr (HALF != 2) {
#pragma unroll
        for (int r = 0; r < 16; ++r) p0[r] = tp[(r & 3) + 8 * (r >> 2)]; }
      if constexpr (HALF != 1) {
#pragma unroll
        for (int r = 0; r < 16; ++r) p1[r] = tp[32 + (r & 3) + 8 * (r >> 2)]; } }
#pragma unroll
    for (int d0 = 0; d0 < 4; ++d0) { const int cb = (d0 * 16 + hi * 8) * 2;
        if constexpr (HALF != 2) { const bf16x8 k0 = *(const LAS bf16x8*)(Kt + KSWZ64(r32, cb)); p0 = __builtin_amdgcn_mfma_f32_32x32x16_bf16(k0, qr[d0], p0, 0, 0, 0); }
        if constexpr (HALF != 1) { const bf16x8 k1 = *(const LAS bf16x8*)(Kt + KSWZ64(32 + r32, cb)); p1 = __builtin_amdgcn_mfma_f32_32x32x16_bf16(k1, qr[d0], p1, 0, 0, 0); } }
    float alpha;
    dil_softmax<HALF>(p0, p1, m_reg, l_reg, alpha, pa0, pa1, pa2, pa3);
    if (__any(alpha < 1.f)) { if (hi == 0) wsf[r32] = alpha; asm volatile("s_waitcnt lgkmcnt(0)" ::: "memory");
#pragma unroll
        for (int d = 0; d < 2; ++d)
#pragma unroll
            for (int r = 0; r < 16; ++r) o[d][r] *= wsf[crow(r, hi)]; }
}
template <int T, int QH> __device__ __forceinline__ void dil_step_pv(f32x16 (&o)[2], int vb, bf16x8 pa0, bf16x8 pa1, bf16x8 pa2, bf16x8 pa3) {
    constexpr int HALF = (T == 0 && QH == 1) ? 2 : ((T == 2 && QH == 0) ? 1 : 0);
    asm volatile("s_waitcnt lgkmcnt(0)" ::: "memory"); SBAR();
    if constexpr (HALF != 2) { pv_step<2, 2, 0>(o, vb, pa0); pv_step<2, 2, 1>(o, vb, pa1); }
    if constexpr (HALF != 1) { pv_step<2, 2, 2>(o, vb, pa2); pv_step<2, 2, 3>(o, vb, pa3); }
    SBAR();
}
struct DilState { bf16x8 buf[8]; bf16x8 qr[2][4]; };
__device__ __forceinline__ void dil_prefetch(DilState& st, const bf16* __restrict__ proj, int b, int h, int sb, int it, int lane) {
    const int r32 = lane & 31, hi = lane >> 5;
    const int p = it >> 4, w = it & 15, dsh = 2 * p;
    const int per = 16 >> dsh, res = w / per, mq0 = sb * (1024 >> dsh) + (w % per) * 64;
    const size_t rowb = (size_t)b * SEQ; const int t_lo = (mq0 - 64 < 0) ? 1 : 0;
    const size_t gstride = ((size_t)8 << dsh) * NIN; const unsigned voff = (unsigned)(((lane >> 3) << dsh) * NIN + (lane & 7) * 8);
    const bf16* colK = proj + (rowb + res) * NIN + COL_KD + h * 64;
    dil_load(st.buf, colK + ((size_t)(mq0 - 64 + 64 * t_lo) << dsh) * NIN, gstride, voff);
#pragma unroll
    for (int qh = 0; qh < 2; ++qh) { const bf16* Qw = proj + (rowb + ((size_t)(mq0 + 32 * qh + r32) << dsh) + res) * NIN + COL_QD + h * 64 + hi * 8;
#pragma unroll
      for (int d0 = 0; d0 < 4; ++d0) st.qr[qh][d0] = ld8(Qw + d0 * 16); }
}
__device__ __forceinline__ void dil_item(DilState& st, const bf16* __restrict__ proj, bf16* scrO, float* scrL, int b, int h, int sb, int it, int it_next, LAS unsigned char* lds, int wid, int lane_in) {
    int lane = lane_in; asm volatile("" : "+v"(lane));
    const int r32 = lane & 31, hi = lane >> 5;
    const int p = it >> 4, w = it & 15, dsh = 2 * p;
    const int per = 16 >> dsh, res = w / per, mq0 = sb * (1024 >> dsh) + (w % per) * 64, m_len = SEQ >> dsh;
    const LAS float* Tb = (const LAS float*)(lds + DL_T) + p * DT_LEN; LAS float* wsf = (LAS float*)(lds + DL_WS) + wid * 64;
    LAS unsigned char* Kt = lds + DL_K + wid * 8192; LAS unsigned char* Vt = lds + DL_V + wid * 8192;
    const int vb = (int)(unsigned)(uintptr_t)Vt + v_rd_base(lane);
    const size_t rowb = (size_t)b * SEQ;
    const int t_lo = (mq0 - 64 < 0) ? 1 : 0, t_hi = (mq0 + 64 >= m_len) ? 1 : 2;
    bf16x8 (&buf)[8] = st.buf; bf16x8 (&qr)[2][4] = st.qr;
    const size_t gstride = ((size_t)8 << dsh) * NIN; const unsigned voff = (unsigned)(((lane >> 3) << dsh) * NIN + (lane & 7) * 8);
    const bf16* colK = proj + (rowb + res) * NIN + COL_KD + h * 64; const bf16* colV = proj + (rowb + res) * NIN + COL_VD + h * 64;
    f32x16 o[2][2];
#pragma unroll
    for (int qh = 0; qh < 2; ++qh) { o[qh][0] = f32x16{}; o[qh][1] = f32x16{}; }
    float m_reg[2] = {-1e4f, -1e4f}, l_reg[2] = {0.f, 0.f};
#define DIL_TILE(T) do { if ((T) >= t_lo && (T) <= t_hi) { const int kbase = mq0 - 64 + 64 * (T); bf16x8 pa0, pa1, pa2, pa3; \
        _Pragma("unroll") for (int g = 0; g < 8; ++g) *(LAS bf16x8*)(Kt + KSWZ64(g * 8 + (lane >> 3), (lane & 7) * 16)) = buf[g];        \
        dil_load(buf, colV + ((size_t)kbase << dsh) * NIN, gstride, voff);                                                                \
        dil_step_sm<T, 0>(o[0], qr[0], m_reg[0], l_reg[0], Tb, Kt, wsf, r32, hi, pa0, pa1, pa2, pa3); \
        _Pragma("unroll") for (int g = 0; g < 8; ++g) *(LAS bf16x8*)(Vt + v_st<2>(g * 8 + (lane >> 3), (lane & 7) * 8)) = buf[g];          \
        if ((T) < t_hi) dil_load(buf, colK + ((size_t)(kbase + 64) << dsh) * NIN, gstride, voff);                                         \
        dil_step_pv<T, 0>(o[0], vb, pa0, pa1, pa2, pa3); \
        dil_step_sm<T, 1>(o[1], qr[1], m_reg[1], l_reg[1], Tb, Kt, wsf, r32, hi, pa0, pa1, pa2, pa3); \
        dil_step_pv<T, 1>(o[1], vb, pa0, pa1, pa2, pa3); } } while (0)
    DIL_TILE(0); DIL_TILE(1); DIL_TILE(2);
#undef DIL_TILE
    if (it_next >= 0) dil_prefetch(st, proj, b, h, sb, it_next, lane);
    LAS unsigned* stg = (LAS unsigned*)Kt;
#pragma unroll
    for (int qh = 0; qh < 2; ++qh) {
        if (hi == 0) { wsf[32 + r32] = l_reg[qh]; const int tl = (((mq0 + 32 * qh + r32) << dsh) + res) & 1023; scrL[p * 1024 + tl] = m_reg[qh] + __builtin_amdgcn_logf(l_reg[qh]); }
        asm volatile("s_waitcnt lgkmcnt(0)" ::: "memory");
        const bool odd = r32 & 1;
#pragma unroll
        for (int r = 0; r < 16; ++r) { const int i = 32 * qh + crow(r, hi); const float rl = __builtin_amdgcn_rcpf(wsf[32 + crow(r, hi)]);
            const float v0 = o[qh][0][r] * rl, v1 = o[qh][1][r] * rl;
            const float got = __builtin_bit_cast(float, __builtin_amdgcn_update_dpp(0, __builtin_bit_cast(int, odd ? v0 : v1), 0xB1, 0xF, 0xF, false));
            const unsigned pk = odd ? cvtpk(got, v1) : cvtpk(v0, got);
            stg[i * 32 + (odd ? 16 + (r32 >> 1) : (r32 >> 1))] = pk; }
        asm volatile("s_waitcnt lgkmcnt(0)" ::: "memory");
    }
#pragma unroll
    for (int g = 0; g < 8; ++g) { const int i = g * 8 + (lane >> 3), ch = lane & 7; const int tl = (((mq0 + i) << dsh) + res) & 1023;
        const v4u wv = *(const LAS v4u*)(Kt + i * 128 + ch * 16);
        *(v4u*)(scrO + ((size_t)p * 1024 + tl) * 64 + ch * 8) = wv; }
}
__device__ __forceinline__ void dil_unit(const bf16* __restrict__ proj, bf16* __restrict__ attn, const float* relb, float* scr, int b, int h, int sb, LAS unsigned char* lds, int tid) {
    const int wid = __builtin_amdgcn_readfirstlane(tid >> 6), lane = tid & 63;
    LAS float* T = (LAS float*)(lds + DL_T);
    for (int i = tid; i < 3 * DT_LEN; i += NWAVES * 64) { const int p = i / DT_LEN, off = i % DT_LEN - DT_OFF; const int dil = 1 << (2 * p);
        T[i] = (off >= -64 && off <= 64) ? relb[(unsigned)(t5_bucket(off * dil) * 12 + 4 + h)] * LOG2E : -1e30f; }
    __syncthreads();
    bf16* scrO = (bf16*)((unsigned char*)scr + DSCR_O); float* scrL = (float*)((unsigned char*)scr + DSCR_L);
    DilState st; dil_prefetch(st, proj, b, h, sb, wid, lane);
#pragma unroll 1
    for (int k = 0; k < 6; ++k) dil_item(st, proj, scrO, scrL, b, h, sb, k * 8 + wid, k < 5 ? (k + 1) * 8 + wid : -1, lds, wid, lane);
    asm volatile("s_waitcnt vmcnt(0)" ::: "memory");
    __syncthreads();
    __builtin_amdgcn_fence(__ATOMIC_ACQUIRE, "agent");
    asm volatile("s_waitcnt vmcnt(0)" ::: "memory");
#pragma unroll 1
    for (int n = 0; n < 16; ++n) { const int i = tid + 512 * n, tl = i >> 3, ch = i & 7;
        const float l0 = scrL[tl], l1 = scrL[1024 + tl], l2 = scrL[2048 + tl]; const float mx = fmaxf(l0, fmaxf(l1, l2));
        float w0 = __builtin_amdgcn_exp2f(l0 - mx), w1 = __builtin_amdgcn_exp2f(l1 - mx), w2 = __builtin_amdgcn_exp2f(l2 - mx); const float rs = 1.f / (w0 + w1 + w2); w0 *= rs; w1 *= rs; w2 *= rs;
        const v4u s0 = *(const v4u*)(scrO + (size_t)tl * 64 + ch * 8), s1 = *(const v4u*)(scrO + ((size_t)1024 + tl) * 64 + ch * 8), s2 = *(const v4u*)(scrO + ((size_t)2048 + tl) * 64 + ch * 8);
        f32x4 a0, a1;
        a0.x = bflo(s0.x) * w0 + bflo(s1.x) * w1 + bflo(s2.x) * w2; a0.y = bfhi(s0.x) * w0 + bfhi(s1.x) * w1 + bfhi(s2.x) * w2;
        a0.z = bflo(s0.y) * w0 + bflo(s1.y) * w1 + bflo(s2.y) * w2; a0.w = bfhi(s0.y) * w0 + bfhi(s1.y) * w1 + bfhi(s2.y) * w2;
        a1.x = bflo(s0.z) * w0 + bflo(s1.z) * w1 + bflo(s2.z) * w2; a1.y = bfhi(s0.z) * w0 + bfhi(s1.z) * w1 + bfhi(s2.z) * w2;
        a1.z = bflo(s0.w) * w0 + bflo(s1.w) * w1 + bflo(s2.w) * w2; a1.w = bfhi(s0.w) * w0 + bfhi(s1.w) * w1 + bfhi(s2.w) * w2;
        v4u wv; wv.x = pk2(a0.x, a0.y); wv.y = pk2(a0.z, a0.w); wv.z = pk2(a1.x, a1.y); wv.w = pk2(a1.z, a1.w);
        *(v4u*)(attn + ((size_t)b * SEQ + sb * 1024 + tl) * DM + 512 + h * 64 + ch * 8) = wv; }
    asm volatile("s_waitcnt vmcnt(0)" ::: "memory");
    __syncthreads();
}
#undef KSWZ
#undef KSWZ16
#undef KSWZ64
#undef SBAR
}

__device__ __forceinline__ void p2_attention(Frame& F, const Args& a) {
    const bf16* proj = (const bf16*)(a.ws + WS_PROJ); bf16* attn = (bf16*)(a.ws + WS_ATT);
    float s1 = 0.f, s2 = 0.f;
    for (int i = 0; i < 64; ++i) { s1 += a.lq1[i] * a.lk1[i]; s2 += a.lq2[i] * a.lk2[i]; }
    float lam_v = expf(s1) - expf(s2) + LAMBDA_INIT; asm volatile("" : "+v"(lam_v));
    const int lam_bits = __builtin_amdgcn_readfirstlane(__builtin_bit_cast(int, lam_v));
    const float lam = __builtin_bit_cast(float, lam_bits);
    const int bx = (int)blockIdx.x, G = F.G;
#ifndef NO_DIFF
#if MK_DIFF2
    if (a.variant != 2) for (int L = bx; L < 64 * 16; L += G) {
        int bh, qb; if (G == 256) { const int slot = (L & 255) >> 3; bh = (L >> 8) * 16 + (L & 7) * 2 + (slot >> 4); qb = slot & 15; } else { bh = L >> 4; qb = L & 15; }
        if (!att::diff_unit3(proj, attn, a.relb, a.subln, lam, bh >> 2, bh & 3, qb, F.lds + RING_OFF, F.wave * 64 + fresh_lane()))
            att::diff_unit2(proj, attn, a.relb, a.subln, lam, bh >> 2, bh & 3, qb, F.lds + RING_OFF, F.wave * 64 + fresh_lane());
    }
#else
    if (a.variant != 2) for (int L = bx; L < 64 * 32; L += G) {
        int bh, qb; if (G == 256) { bh = (L >> 8) * 8 + (L & 7); qb = (L & 255) >> 3; } else { bh = L >> 5; qb = L & 31; }
        att::diff_unit(proj, attn, a.relb, a.subln, lam, bh >> 2, bh & 3, qb, F.lds + RING_OFF, F.wave * 64 + fresh_lane());
    }
#endif
#endif
#ifndef NO_DIL
    float* scr = (float*)(a.ws + WS_DSCR + (size_t)bx * att::DSCR_BYTES);
    if (a.variant != 1) for (int L = bx; L < 128 * 4; L += G) {
        int bh, sb; if (G == 256) { bh = (L >> 8) * 64 + (L & 7) * 8 + ((L & 255) >> 5); sb = ((L & 255) >> 3) & 3; } else { bh = L >> 2; sb = L & 3; }
        att::dil_unit(proj, attn, a.relb, scr, bh >> 3, bh & 7, sb, F.lds + RING_OFF, F.wave * 64 + fresh_lane());
    }
#endif
}


constexpr int N_PHASES = 9;
__global__ void __launch_bounds__(NWAVES * 64, 2) mega(Args args) {
    extern __shared__ __attribute__((aligned(16))) unsigned char lds[];
    Frame F;
    F.lds = (LAS unsigned char*)lds;
    F.MISC = (volatile LAS unsigned*)(F.lds + MISC_OFF);
    F.wave = __builtin_amdgcn_readfirstlane((int)threadIdx.x >> 6);
    F.G = gridDim.x; { const int bx = blockIdx.x; F.vcu = (F.G % 8 == 0) ? (bx % 8) * (F.G / 8) + bx / 8 : bx; }
    unsigned char* ws = args.ws;
    gu32* ctl = (gu32*)(ws + WS_CTL);
    const int tid0 = F.wave * 64 + fresh_lane();
    for (int u = tid0; u < (LDS_BYTES - LDSCTL_OFF) / 4; u += NWAVES * 64) ((LAS unsigned*)(F.lds + LDSCTL_OFF))[u] = 0u;
    __syncthreads();
    XcdBarrier bar; bar.bar = (unsigned*)(ctl + CW_BAR); bar.x = 0; bar.st = nullptr;
    const int lo = args.ph_lo, hi = args.ph_hi;
    if (hi - lo > 1) bar = xcd_barrier_post((unsigned*)(ctl + CW_BAR), F.MISC + 8, tid0);
#ifdef ONLY_PHASE
#define IN(k) ((k) == ONLY_PHASE && lo <= (k) && (k) < hi)
#else
#define IN(k) (lo <= (k) && (k) < hi)
#endif
#define SEAM(k) do { if (IN(k) && IN((k) + 1)) xcd_barrier(bar, F.wave * 64 + fresh_lane()); } while (0)

    if (IN(0)) { p0_prologue(F, args); } SEAM(0);
    const int bxi = (int)blockIdx.x;
    if (IN(1)) {
        pg8::Gemm g{(const bf16*)(ws + WS_H1), (const bf16*)(ws + WS_WIN), NTOK, NIN, DM}; pg8::StaticOrder S; S.init(NTOK, NIN, F.G, bxi);
        pg8::EpiProj E{(bf16*)(ws + WS_PROJ), QSCALE};
        pg8::gemm_phase<pg8::EpiProj, pg8::StaticOrder, true, true>(F.lds + RING_OFF, g, S, E, F.wave);
    } SEAM(1);
    if (IN(2)) { p2_attention(F, args); } SEAM(2);
    if (IN(3)) {
        pg8::Gemm g{(const bf16*)(ws + WS_ATT), (const bf16*)(ws + WS_WOUT), NTOK, DM, DM}; pg8::StaticOrder S; S.init(NTOK, DM, F.G, (int)blockIdx.x);
        pg8::EpiResBf16 E{args.x, (bf16*)(ws + WS_X2)};
        pg8::gemm_phase<pg8::EpiResBf16, pg8::StaticOrder, true, true>(F.lds + RING_OFF, g, S, E, F.wave);
    } SEAM(3);
    if (IN(4)) { p4_router(F, args); } SEAM(4);
    if (IN(5)) { p5_topk(F, args); } SEAM(5);
    if (IN(6)) {
        pg8::Gemm g{(const bf16*)(ws + WS_XE), (const bf16*)(ws + WS_W1T), 0, 0, DM / 2}; pg8::MoeOrder S; S.init(5632, F.G, bxi);
        pg8::EpiSwiGLU8 E{ws + WS_HE};
#if MK_FP6
        pg8::gemm_phase6<pg8::EpiSwiGLU8, pg8::MoeOrder, true>(F.lds + RING_OFF, ws + WS_XE, ws + WS_W1T, S, E, F.wave);
#else
        pg8::gemm_phase<pg8::EpiSwiGLU8, pg8::MoeOrder, true, true, true>(F.lds + RING_OFF, g, S, E, F.wave);
#endif
    } SEAM(6);
    if (IN(7)) {
        pg8::Gemm g{(const bf16*)(ws + WS_HE), (const bf16*)(ws + WS_W2T), 0, 0, DFF / 2}; pg8::MoeOrder S; S.init(1024, F.G, (int)blockIdx.x);
        pg8::EpiDown8 E{(bf16*)(ws + WS_YE), (const float*)(ws + WS_GATE)};
        pg8::gemm_phase<pg8::EpiDown8, pg8::MoeOrder, true, true, true>(F.lds + RING_OFF, g, S, E, F.wave);
    } SEAM(7);
    if (IN(8)) { p8_combine(F, args); }
#undef IN
#undef SEAM
}


#if MK_NAIVE_ATTN
__global__ __launch_bounds__(256) void naive_diff_attn(Args a) {
    __shared__ float Ks[32][128]; __shared__ float Vs[32][128]; __shared__ float T[2048];
    const int bh = blockIdx.x >> 5, qb = blockIdx.x & 31, b = bh >> 2, h = bh & 3;
    const int t = threadIdx.x, qi = t >> 1, sub = t & 1;
    const bf16* proj = (const bf16*)(a.ws + WS_PROJ); bf16* att = (bf16*)(a.ws + WS_ATT);
    for (int i = t; i < 2048; i += 256) T[i] = a.relb[t5_bucket(i - 1024) * 12 + h] * LOG2E;
    float s1 = 0.f, s2 = 0.f;
    for (int i = 0; i < 64; ++i) { s1 += a.lq1[i] * a.lk1[i]; s2 += a.lq2[i] * a.lk2[i]; }
    const float lam = expf(s1) - expf(s2) + LAMBDA_INIT;
    const int qpos = qb * 128 + qi; const size_t qrow = (size_t)(b * SEQ + qpos) * NIN;
    float q[64];
#pragma unroll
    for (int j = 0; j < 64; ++j) q[j] = bf2f(proj[qrow + COL_QA + h * 128 + sub * 64 + j]);
    float o[128];
#pragma unroll
    for (int d = 0; d < 128; ++d) o[d] = 0.f;
    float m = -1e30f, l = 0.f;
    for (int kt = 0; kt < SEQ; kt += 32) {
        __syncthreads();
        for (int i = t; i < 4096; i += 256) { const int r = i >> 7, c = i & 127; const size_t row = (size_t)(b * SEQ + kt + r) * NIN;
            Ks[r][c] = bf2f(proj[row + COL_KA + h * 128 + c]); Vs[r][c] = bf2f(proj[row + COL_VA + h * 128 + c]); }
        __syncthreads();
        for (int kk = 0; kk < 32; ++kk) {
            float s = 0.f;
#pragma unroll
            for (int j = 0; j < 64; ++j) s += q[j] * Ks[kk][sub * 64 + j];
            int rel = kt + kk - qpos; rel = rel < -1024 ? -1024 : (rel > 1023 ? 1023 : rel);
            s += T[rel + 1024];
            if (s > m) { const float f = exp2f(m - s); l *= f;
#pragma unroll
                for (int d = 0; d < 128; ++d) o[d] *= f;
                m = s; }
            const float p = exp2f(s - m); l += p;
#pragma unroll
            for (int d = 0; d < 128; ++d) o[d] += p * Vs[kk][d];
        }
    }
    const float sc = (sub ? -lam : 1.f) / l; float ss = 0.f;
#pragma unroll
    for (int d = 0; d < 128; ++d) { float v = o[d] * sc; v += __shfl_xor(v, 1); o[d] = v; ss += v * v; }
    const float r = 1.f / sqrtf(ss * (1.f / 128.f) + SUBLN_EPS);
    if (sub == 0) {
#pragma unroll
        for (int d = 0; d < 128; ++d) att[(size_t)(b * SEQ + qpos) * DM + h * 128 + d] = (bf16)f2bf(o[d] * r * a.subln[d] * (1.f - LAMBDA_INIT));
    }
}
__global__ __launch_bounds__(256) void naive_dilated(Args a) {
    const int gid = blockIdx.x * 256 + threadIdx.x, h = gid & 7, tok = gid >> 3, b = tok >> 12, pos = tok & 4095;
    const bf16* proj = (const bf16*)(a.ws + WS_PROJ); bf16* att = (bf16*)(a.ws + WS_ATT);
    float q[64], o[64];
#pragma unroll
    for (int j = 0; j < 64; ++j) { q[j] = bf2f(proj[(size_t)tok * NIN + COL_QD + h * 64 + j]); o[j] = 0.f; }
    float m = -1e30f, l = 0.f;
    for (int p = 0; p < 3; ++p) { const int dil = p == 0 ? 1 : (p == 1 ? 4 : 16);
        for (int j = -64; j <= 64; ++j) { const int pk = pos + j * dil; if (pk < 0 || pk >= SEQ) continue;
            const size_t row = (size_t)(b * SEQ + pk) * NIN; float s = 0.f;
#pragma unroll
            for (int d = 0; d < 64; ++d) s += q[d] * bf2f(proj[row + COL_KD + h * 64 + d]);
            s += a.relb[t5_bucket(j * dil) * 12 + 4 + h] * LOG2E;
            if (s > m) { const float f = exp2f(m - s); l *= f;
#pragma unroll
                for (int d = 0; d < 64; ++d) o[d] *= f;
                m = s; }
            const float pw = exp2f(s - m); l += pw;
#pragma unroll
            for (int d = 0; d < 64; ++d) o[d] += pw * bf2f(proj[row + COL_VD + h * 64 + d]);
        } }
    const float il = 1.f / l;
#pragma unroll
    for (int d = 0; d < 64; ++d) att[(size_t)tok * DM + 512 + h * 64 + d] = (bf16)f2bf(o[d] * il);
}
static void launch_naive_attention(const Args& a, hipStream_t stream) {
    hipLaunchKernelGGL(naive_diff_attn, dim3(64 * 32), dim3(256), 0, stream, a);
    hipLaunchKernelGGL(naive_dilated, dim3(NTOK * 8 / 256), dim3(256), 0, stream, a);
}
#endif


extern "C" void kernel_launch(void* const* d_in, const int* in_sizes, int n_in, void* d_out, int out_size, void* d_ws, size_t ws_size, hipStream_t stream) {
    static int grid = 0;
    if (grid == 0) {
        if (n_in != 16 || in_sizes[0] != NTOK * DM || out_size != NTOK * DM || ws_size < WS_END) {
            fprintf(stderr, "kernel_launch: shape/workspace mismatch (n_in %d, in0 %d, out %d, ws %zu, need %zu); nothing launched\n", n_in, n_in > 0 ? in_sizes[0] : -1, out_size, ws_size, (size_t)WS_END); grid = -1; return; }
        int dev = 0, cus = 0, per_cu = 0;
        if (hipGetDevice(&dev) != hipSuccess || hipDeviceGetAttribute(&cus, hipDeviceAttributeMultiprocessorCount, dev) != hipSuccess) { grid = -1; return; }
        if (hipFuncSetAttribute((const void*)mega, hipFuncAttributeMaxDynamicSharedMemorySize, LDS_BYTES) != hipSuccess) { fprintf(stderr, "kernel_launch: hipFuncSetAttribute failed\n"); grid = -1; return; }
        if (hipOccupancyMaxActiveBlocksPerMultiprocessor(&per_cu, (const void*)mega, NWAVES * 64, LDS_BYTES) != hipSuccess || per_cu < 1) { fprintf(stderr, "kernel_launch: occupancy query says %d\n", per_cu); }
        (void)hipGetLastError();
        grid = cus;
    }
    if (grid < 0) return;
    (void)hipMemsetAsync((char*)d_ws + WS_CTL, 0, CTL_ZERO_BYTES, stream);
    Args a{};
    a.x = (const float*)d_in[0]; a.g1 = (const float*)d_in[1]; a.w_in = (const float*)d_in[2]; a.lq1 = (const float*)d_in[3]; a.lk1 = (const float*)d_in[4]; a.lq2 = (const float*)d_in[5]; a.lk2 = (const float*)d_in[6];
    a.subln = (const float*)d_in[7]; a.w_out = (const float*)d_in[8]; a.relb = (const float*)d_in[9]; a.g2 = (const float*)d_in[10]; a.w_router = (const float*)d_in[11];
    a.w_gate = (const float*)d_in[12]; a.w_up = (const float*)d_in[13]; a.w_down = (const float*)d_in[14]; a.gf = (const float*)d_in[15];
    a.out = (float*)d_out; a.ws = (unsigned char*)d_ws;
#if MK_MODE == 0
    a.ph_lo = 0; a.ph_hi = N_PHASES;
    hipLaunchKernelGGL(mega, dim3(grid), dim3(NWAVES * 64), LDS_BYTES, stream, a);
#else
    for (int p = 0; p < N_PHASES; ++p) {
#if MK_NAIVE_ATTN
        if (p == 2) { launch_naive_attention(a, stream); continue; }
#endif
        a.ph_lo = p; a.ph_hi = p + 1; a.variant = 0;
        hipLaunchKernelGGL(mega, dim3(grid), dim3(NWAVES * 64), LDS_BYTES, stream, a);
#ifdef MK_DUP
        if ((MK_DUP >> p) & 1) { a.variant = MK_DUPVAR; hipLaunchKernelGGL(mega, dim3(grid), dim3(NWAVES * 64), LDS_BYTES, stream, a); }
#endif
    }
#endif
    const hipError_t le = hipPeekAtLastError();
    if (le != hipSuccess) fprintf(stderr, "kernel_launch: launch failed: %s\n", hipGetErrorName(le));
}
```

```cpp
#include <hip/hip_runtime.h>
#include <cstdio>
#include <cstdint>

#ifndef MK_MODE
#define MK_MODE 0
#endif
#ifndef MK_NAIVE_ATTN
#define MK_NAIVE_ATTN 0
#endif

#ifndef MK_FP6
#define MK_FP6 1
#endif
#ifndef MK_DIFF2
#define MK_DIFF2 1
#endif

constexpr int BATCH = 16, SEQ = 4096, DM = 1024, NTOK = BATCH * SEQ, NIN = 3072, NE = 16, CAP = 512, DFF = 2816, EROWS = BATCH * CAP;
constexpr int NDH = 4, NLH = 8;
constexpr float LOG2E = 1.4426950408889634f, QSCALE = 0.125f * LOG2E;
constexpr float NORM_EPS = 1e-6f, SUBLN_EPS = 1e-5f, LAMBDA_INIT = 0.2f;
constexpr int COL_QA = 0, COL_KA = 512, COL_VA = 1024, COL_QD = 1536, COL_KD = 2048, COL_VD = 2560;

constexpr size_t MiB = 1u << 20;
constexpr size_t WS_CTL = 0, CTL_ZERO_BYTES = 1 * MiB;
constexpr size_t WS_WIN = 2 * MiB;
constexpr size_t WS_WOUT = 8 * MiB;
constexpr size_t WS_AFF = 10 * MiB;
constexpr size_t WS_IDX = 14 * MiB;
constexpr size_t WS_GATE = 14 * MiB + 512 * 1024;
constexpr size_t WS_INV = 15 * MiB;
constexpr size_t WS_W1T = 20 * MiB;
constexpr size_t WS_W2T = 108 * MiB;
constexpr size_t WS_H1 = 160 * MiB;
constexpr size_t WS_ATT = 160 * MiB;
constexpr size_t WS_PROJ = 288 * MiB;
constexpr size_t WS_DSCR = 672 * MiB;
constexpr size_t WS_H2 = 288 * MiB;
constexpr size_t WS_XE = 352 * MiB;
constexpr size_t WS_HE = 480 * MiB;
constexpr size_t WS_YE = 160 * MiB;
constexpr size_t WS_X2 = 896 * MiB;
constexpr size_t WS_END = 1024 * MiB;
static_assert(WS_W1T + (size_t)NE * 5632 * 1024 <= WS_W2T && WS_W2T + (size_t)NE * 1024 * 2816 <= WS_H1, "weights");
static_assert(WS_H1 + (size_t)NTOK * 1024 * 2 <= WS_PROJ && WS_PROJ + (size_t)NTOK * 3072 * 2 <= WS_DSCR && WS_DSCR + (size_t)224 * MiB <= WS_X2 && WS_X2 + (size_t)NTOK * 1024 * 2 <= WS_END, "dyn");
static_assert(WS_H2 + (size_t)NTOK * 1024 <= WS_XE && WS_XE + (size_t)NE * EROWS * 1024 <= WS_HE && WS_HE + (size_t)NE * EROWS * DFF <= WS_X2 && WS_YE + (size_t)NE * EROWS * 1024 * 2 <= WS_HE, "moe");
constexpr int CW_BAR = 4096;

constexpr int RING_OFF = 0, RING_BYTES = 131072;
constexpr int LDSCTL_OFF = RING_BYTES, MISC_OFF = LDSCTL_OFF + 320;
constexpr int LDS_BYTES = 147456;
constexpr int NWAVES = 8;

namespace pg8 {
#define PG8_LAS __attribute__((address_space(3)))
typedef unsigned short bf16_t;
typedef short bf16x8 __attribute__((ext_vector_type(8)));
typedef float f32x4 __attribute__((ext_vector_type(4)));
typedef unsigned u32x4 __attribute__((ext_vector_type(4)));
typedef int i32x4 __attribute__((ext_vector_type(4)));
typedef int i32x8 __attribute__((ext_vector_type(8)));
typedef unsigned u32x2 __attribute__((ext_vector_type(2)));
constexpr int BM = 256, BK = 64, HALF = 128, HTB = HALF * BK * 2  , STAGE_BYTES = 8 * HTB, NXCD = 8, WGM = 8;

__host__ __device__ __forceinline__ int lds_byte(int r, int c) { const int st = (r >> 4) * 2 + (c >> 5), rr = r & 15, cc = c & 31, ob = rr * 64 + cc * 2; return st * 1024 + (ob ^ (((ob >> 9) & 1) << 5)); }
__host__ __device__ __forceinline__ void stage_rc(int b, int& R, int& C) { const int st = b / 1024, sb = b % 1024, swz = sb ^ (((sb >> 9) & 1) << 5); R = (st >> 1) * 16 + swz / 64; C = (st & 1) * 32 + (swz % 64) / 2; }
__host__ __device__ __forceinline__ int perm32(int rho) { const int n = rho >> 4, i = rho & 15; return 8 * (i >> 2) + 4 * n + (i & 3); }

struct Unit { int pm, pn; };
struct Gemm { const bf16_t* A; const bf16_t* Bt; int M, N, K; };

struct StaticOrder {
    int nM, nN, nwg, G, c;
    __host__ __device__ void init(int M, int N, int G_, int c_) { nM = M / BM; nN = N / BM; nwg = nM * nN; G = G_; c = c_; }
    __host__ __device__ bool next(int i, Unit& u) const {
        const long L = (long)i * G + c; if (L >= nwg) return false;
        int wgid = (int)L; { const int q = nwg / NXCD, r = nwg % NXCD, xcd = wgid % NXCD, off = wgid / NXCD; wgid = (xcd < r ? xcd * (q + 1) : r * (q + 1) + (xcd - r) * q) + off; }
        const int nig = WGM * nN, gid = wgid / nig, fm = gid * WGM, gsz = (nM - fm) < WGM ? (nM - fm) : WGM;
        u.pm = fm + ((wgid % nig) % gsz); u.pn = (wgid % nig) / gsz; return true;
    }
    __device__ __forceinline__ void a_ready(const Unit&) const {}
    __device__ __forceinline__ void done(const Unit&) const {}
};

__device__ __forceinline__ unsigned cvt_pk_bf16(float lo, float hi) { unsigned r; asm volatile("v_cvt_pk_bf16_f32 %0, %1, %2" : "=v"(r) : "v"(lo), "v"(hi)); return r; }
typedef float f32x2 __attribute__((ext_vector_type(2)));
struct MoeOrder {
    StaticOrder so; int pn_per_e;
    __device__ void init(int N, int G_, int c_) { so.init(16 * 8192, N, G_, c_); pn_per_e = N / BM; }
    __device__ bool next(int i, Unit& u) const { Unit v; if (!so.next(i, v)) return false; u.pm = v.pm; u.pn = (v.pm >> 5) * pn_per_e + v.pn; return true; }
    __device__ __forceinline__ void a_ready(const Unit&) const {}
    __device__ __forceinline__ void done(const Unit&) const {}
};
__device__ __forceinline__ float clamp448(float v) { return __builtin_fminf(__builtin_fmaxf(v, -448.f), 448.f); }
struct EpiProj {
    static constexpr bool PERM = true, AFTER_DRAIN = false;
    bf16_t* O; float qscale;
    __device__ __forceinline__ void operator()(const f32x4 (&acc)[2][2][4][2], const Unit& u, int wr, int wc, int fr, int fq) const {
        const int row0 = u.pm * BM + wr * 64 + fr, col0 = u.pn * BM + wc * 32 + 8 * fq;
        const float sc = (u.pn < 2 || u.pn == 6 || u.pn == 7) ? qscale : 1.f;
#pragma unroll
        for (int ai = 0; ai < 2; ++ai)
#pragma unroll
            for (int m = 0; m < 4; ++m) { bf16_t* rowp = O + (size_t)(row0 + ai * HALF + m * 16) * 3072 + col0;
#pragma unroll
                for (int bj = 0; bj < 2; ++bj) { const f32x4 v0 = acc[ai][bj][m][0] * sc, v1 = acc[ai][bj][m][1] * sc;
                    u32x4 w; w.x = cvt_pk_bf16(v0[0], v0[1]); w.y = cvt_pk_bf16(v0[2], v0[3]); w.z = cvt_pk_bf16(v1[0], v1[1]); w.w = cvt_pk_bf16(v1[2], v1[3]);
                    *(u32x4*)(rowp + bj * HALF) = w; } }
    }
};
struct EpiResBf16 {
    static constexpr bool PERM = true, AFTER_DRAIN = false;
    const float* base; bf16_t* out;
    __device__ __forceinline__ void operator()(const f32x4 (&acc)[2][2][4][2], const Unit& u, int wr, int wc, int fr, int fq) const {
        const int col0 = u.pn * BM + wc * 32 + 8 * fq;
#pragma unroll
        for (int ai = 0; ai < 2; ++ai)
#pragma unroll
            for (int m = 0; m < 4; ++m) { const size_t off = (size_t)(u.pm * BM + ai * HALF + wr * 64 + m * 16 + fr) * 1024 + col0;
#pragma unroll
                for (int bj = 0; bj < 2; ++bj) { const f32x4 v0 = *(const f32x4*)(base + off + bj * HALF) + acc[ai][bj][m][0], v1 = *(const f32x4*)(base + off + bj * HALF + 4) + acc[ai][bj][m][1];
                    u32x4 w; w.x = cvt_pk_bf16(v0[0], v0[1]); w.y = cvt_pk_bf16(v0[2], v0[3]); w.z = cvt_pk_bf16(v1[0], v1[1]); w.w = cvt_pk_bf16(v1[2], v1[3]);
                    *(u32x4*)(out + off + bj * HALF) = w; } }
    }
};
#ifdef EMU6
constexpr float XS8 = X6, WS8 = W6, WS8D = W6D, HS8 = H6;
__device__ __forceinline__ float q6(float t) { const float a = __builtin_fminf(__builtin_fabsf(t), 7.5f); const float st = a < 2.f ? 8.f : (a < 4.f ? 4.f : 2.f); const float r = __builtin_rintf(a * st) / st; return __builtin_copysignf(r, t); }
#elif MK_FP6
constexpr float XS8 = 2.f, WS8 = 64.f, WS8D = 128.f, HS8 = 8.f;
__device__ __forceinline__ float q6(float t) { return t; }
#else
constexpr float XS8 = 8.f, WS8 = 128.f, WS8D = 128.f, HS8 = 8.f;
__device__ __forceinline__ float q6(float t) { return t; }
#endif
struct EpiSwiGLU8 {
    static constexpr bool PERM = true, AFTER_DRAIN = false;
    unsigned char* O;
    __device__ __forceinline__ void operator()(const f32x4 (&acc)[2][2][4][2], const Unit& u, int wr, int wc, int fr, int fq) const {
        const int pnl = u.pn % 22;
        const int row0 = u.pm * BM + wr * 64 + fr, col0 = pnl * 128 + wc * 32 + 8 * fq;
        constexpr float inv = 1.f / (XS8 * WS8);
#pragma unroll
        for (int ai = 0; ai < 2; ++ai)
#pragma unroll
            for (int m = 0; m < 4; ++m) { unsigned char* rowp = O + (size_t)(row0 + ai * HALF + m * 16) * 2816 + col0;
#ifdef EPI_DUP
              for (int rep = 0; rep < 2; ++rep) {
                float rsc = 1.f; asm volatile("" : "+v"(rsc));
#endif
                float h[8];
#pragma unroll
                for (int n = 0; n < 2; ++n)
#pragma unroll
                    for (int j = 0; j < 4; j += 2) {
#ifdef EPI_DUP
                        const f32x2 ag = {acc[ai][0][m][n][j] * rsc, acc[ai][0][m][n][j + 1] * rsc}, au = {acc[ai][1][m][n][j], acc[ai][1][m][n][j + 1]};
#else
                        const f32x2 ag = {acc[ai][0][m][n][j], acc[ai][0][m][n][j + 1]}, au = {acc[ai][1][m][n][j], acc[ai][1][m][n][j + 1]};
#endif

                        const f32x2 t = ag * (-inv * 1.4426950408889634f); f32x2 d; d.x = __builtin_amdgcn_exp2f(t.x); d.y = __builtin_amdgcn_exp2f(t.y); d = d + 1.0f;
                        f32x2 r; r.x = __builtin_amdgcn_rcpf(d.x); r.y = __builtin_amdgcn_rcpf(d.y);
                        const f32x2 hv = (ag * au) * (r * (inv * inv * HS8));
                        h[n * 4 + j] = q6(__builtin_amdgcn_fmed3f(hv.x, -448.f, 448.f)); h[n * 4 + j + 1] = q6(__builtin_amdgcn_fmed3f(hv.y, -448.f, 448.f)); }
                int w0 = 0, w1 = 0;
                w0 = __builtin_amdgcn_cvt_pk_fp8_f32(h[0], h[1], w0, false); w0 = __builtin_amdgcn_cvt_pk_fp8_f32(h[2], h[3], w0, true);
                w1 = __builtin_amdgcn_cvt_pk_fp8_f32(h[4], h[5], w1, false); w1 = __builtin_amdgcn_cvt_pk_fp8_f32(h[6], h[7], w1, true);
#ifdef EPI_DUP
                if (rep == 0) { asm volatile("" :: "v"(w0), "v"(w1)); continue; }
#endif
                u32x2 w; w.x = (unsigned)w0; w.y = (unsigned)w1; *(u32x2*)rowp = w;
#ifdef EPI_DUP
              }
#endif
            }
    }
};
struct EpiDown8 {
    static constexpr bool PERM = true, AFTER_DRAIN = false;
    bf16_t* O; const float* gate;
    __device__ __forceinline__ void operator()(const f32x4 (&acc)[2][2][4][2], const Unit& u, int wr, int wc, int fr, int fq) const {
        const int pnl = u.pn & 3;
        const int row0 = u.pm * BM + wr * 64 + fr, col0 = pnl * BM + wc * 32 + 8 * fq;
#pragma unroll
        for (int ai = 0; ai < 2; ++ai)
#pragma unroll
            for (int m = 0; m < 4; ++m) { const int row = row0 + ai * HALF + m * 16; const float gt = gate[row] * (1.f / (HS8 * WS8D)); bf16_t* rowp = O + (size_t)row * 1024 + col0;
#pragma unroll
                for (int bj = 0; bj < 2; ++bj) { const f32x4 v0 = acc[ai][bj][m][0] * gt, v1 = acc[ai][bj][m][1] * gt;
                    u32x4 w; w.x = cvt_pk_bf16(v0[0], v0[1]); w.y = cvt_pk_bf16(v0[2], v0[3]); w.z = cvt_pk_bf16(v1[0], v1[1]); w.w = cvt_pk_bf16(v1[2], v1[3]);
                    *(u32x4*)(rowp + bj * HALF) = w; } }
    }
};

struct FragBf { bf16x8 v[2]; };
struct FragF8 { i32x8 v; };
template <bool F8> struct FragSel { typedef FragBf type; };
template <> struct FragSel<true> { typedef FragF8 type; };
__device__ __forceinline__ void frag_ld(FragBf& f, const PG8_LAS unsigned char* p) { f.v[0] = *(const PG8_LAS bf16x8*)p; f.v[1] = *(const PG8_LAS bf16x8*)(p + 1024); }
__device__ __forceinline__ void frag_ld(FragF8& f, const PG8_LAS unsigned char* p) { const i32x4 lo = *(const PG8_LAS i32x4*)p, hi = *(const PG8_LAS i32x4*)(p + 1024); f.v = __builtin_shufflevector(lo, hi, 0, 1, 2, 3, 4, 5, 6, 7); }
__device__ __forceinline__ f32x4 frag_mma(const FragBf& b, const FragBf& a, f32x4 c) { c = __builtin_amdgcn_mfma_f32_16x16x32_bf16(b.v[0], a.v[0], c, 0, 0, 0); return __builtin_amdgcn_mfma_f32_16x16x32_bf16(b.v[1], a.v[1], c, 0, 0, 0); }
__device__ __forceinline__ f32x4 frag_mma(const FragF8& b, const FragF8& a, f32x4 c) { asm volatile("v_mfma_f32_16x16x128_f8f6f4 %0, %1, %2, %0" : "+v"(c) : "v"(b.v), "v"(a.v)); return c; }
template <class Epi, class Sched, bool ALIGN_EPI = false, bool SP2 = false, bool F8 = false>
__device__ __forceinline__ void gemm_phase(PG8_LAS unsigned char* lds, const Gemm g, const Sched& S, const Epi& E, const int wid  ) {
    int lane; asm volatile("v_mbcnt_lo_u32_b32 %0, -1, 0\n\tv_mbcnt_hi_u32_b32 %0, -1, %0" : "=v"(lane));
    const int tid = wid * 64 + lane, wr = wid >> 2, wc = wid & 3, fr = lane & 15, fq = lane >> 4;
    const int K = g.K, nt = K / BK;
    unsigned voffA[2], voffB[2];
#pragma unroll
    for (int i = 0; i < 2; ++i) { int R, C; stage_rc(tid * 16 + i * 8192, R, C); const int Rb = Epi::PERM ? ((R & ~31) + perm32(R & 31)) : R;
        voffA[i] = (unsigned)(R * K + C) * 2u; voffB[i] = (unsigned)(Rb * K + C) * 2u; }
    const size_t kstep = (size_t)(BK * 2);
    const size_t hstep = (size_t)HALF * K * 2;
    const size_t tstep = 2 * hstep;
    const unsigned ldsw = (unsigned)wid * 1024u;
    const int aoff = lds_byte(wr * 64 + fr, fq * 8), boff = lds_byte(wc * 32 + fr, fq * 8);
#define PG8_SA(b, h) (((b) * 2 + (h)) * HTB)
#define PG8_SB(b, h) ((4 + (b) * 2 + (h)) * HTB)
#define PG8_STAGE(bufoff, gbase, voff) do { _Pragma("unroll") for (int _i = 0; _i < 2; ++_i) \
        __builtin_amdgcn_global_load_lds((const unsigned*)((const char*)(gbase) + (voff)[_i]), (PG8_LAS unsigned*)(lds + (bufoff) + ldsw + _i * 8192), 16, 0, 0); } while (0)
#define PG8_LDA(dst, b, h) do { _Pragma("unroll") for (int m = 0; m < 4; ++m) frag_ld(dst[m], lds + PG8_SA(b, h) + aoff + m * 2048); } while (0)
#define PG8_LDB(dst, b, h) do { _Pragma("unroll") for (int n = 0; n < 2; ++n) frag_ld(dst[n], lds + PG8_SB(b, h) + boff + n * 2048); } while (0)
#define PG8_MMA(ai, bj, At, Bt) do { __builtin_amdgcn_s_setprio(1); _Pragma("unroll") for (int m = 0; m < 4; ++m) _Pragma("unroll") for (int n = 0; n < 2; ++n) \
        acc[ai][bj][m][n] = frag_mma(Bt[n], At[m], acc[ai][bj][m][n]); __builtin_amdgcn_s_setprio(0); } while (0)
#define PG8_WAIT_V(n) asm volatile("s_waitcnt vmcnt(" #n ")" ::: "memory")
#define PG8_WAIT_L(n) asm volatile("s_waitcnt lgkmcnt(" #n ")" ::: "memory")
#define PG8_BAR __builtin_amdgcn_s_barrier()
#define PG8_SCHED __builtin_amdgcn_sched_barrier(0)
    Unit cur, nxt; int ui = 0;
    if (!S.next(0, cur)) return;
    f32x4 acc[2][2][4][2];
#pragma unroll
    for (int a = 0; a < 2; ++a)
#pragma unroll
        for (int b = 0; b < 2; ++b)
#pragma unroll
            for (int m = 0; m < 4; ++m)
#pragma unroll
                for (int n = 0; n < 2; ++n) acc[a][b][m][n] = (f32x4){0.f, 0.f, 0.f, 0.f};
    typename FragSel<F8>::type At[4], B0[2], B1[2];
    const char* cA = (const char*)g.A + (size_t)cur.pm * tstep; const char* cB = (const char*)g.Bt + (size_t)cur.pn * tstep;
    S.a_ready(cur);
    if constexpr (SP2) {
        PG8_STAGE(PG8_SB(0, 0), cB, voffB); PG8_STAGE(PG8_SB(0, 1), cB + hstep, voffB); PG8_STAGE(PG8_SA(0, 0), cA, voffA); PG8_STAGE(PG8_SA(0, 1), cA + hstep, voffA);
        if (wr == 1) PG8_BAR;
        PG8_WAIT_V(2); PG8_BAR;
        PG8_STAGE(PG8_SB(1, 0), cB + kstep, voffB); PG8_STAGE(PG8_SA(1, 0), cA + kstep, voffA); PG8_STAGE(PG8_SB(1, 1), cB + hstep + kstep, voffB);
        PG8_WAIT_V(6); PG8_BAR;
    } else {
        PG8_STAGE(PG8_SB(0, 0), cB, voffB); PG8_STAGE(PG8_SA(0, 0), cA, voffA); PG8_STAGE(PG8_SB(0, 1), cB + hstep, voffB); PG8_STAGE(PG8_SA(0, 1), cA + hstep, voffA);
        if (wr == 1) PG8_BAR;
        PG8_WAIT_V(4); PG8_BAR;
        PG8_STAGE(PG8_SB(1, 0), cB + kstep, voffB); PG8_STAGE(PG8_SA(1, 0), cA + kstep, voffA); PG8_STAGE(PG8_SB(1, 1), cB + hstep + kstep, voffB);
        PG8_WAIT_V(6); PG8_BAR;
    }
    for (;;) {
        const bool has_next = S.next(ui + 1, nxt);
        const char* nA = has_next ? (const char*)g.A + (size_t)nxt.pm * tstep : cA; const char* nB = has_next ? (const char*)g.Bt + (size_t)nxt.pn * tstep : cB;
        for (int t = 0; t < nt; t += 2) {
            const bool last = (t == nt - 2);
            const char* a1 = cA + (size_t)(t + 1) * kstep;
            const char* a2 = last ? nA : cA + (size_t)(t + 2) * kstep; const char* b2 = last ? nB : cB + (size_t)(t + 2) * kstep;
            const char* a3 = a2 + kstep; const char* b3 = b2 + kstep;
            if (last && has_next) S.a_ready(nxt);
            if constexpr (SP2) {
            PG8_LDB(B0, 0, 0); PG8_LDB(B1, 0, 1); PG8_SCHED; PG8_LDA(At, 0, 0); PG8_STAGE(PG8_SA(1, 1), a1 + hstep, voffA);
            PG8_WAIT_V(8); PG8_WAIT_L(0); PG8_BAR; PG8_MMA(0, 0, At, B0); PG8_MMA(0, 1, At, B1); PG8_BAR; PG8_SCHED;
            PG8_LDA(At, 0, 1); PG8_STAGE(PG8_SB(0, 0), b2, voffB); PG8_STAGE(PG8_SB(0, 1), b2 + hstep, voffB); PG8_STAGE(PG8_SA(0, 0), a2, voffA);
            PG8_WAIT_V(8); PG8_WAIT_L(0); PG8_BAR; PG8_MMA(1, 0, At, B0); PG8_MMA(1, 1, At, B1); PG8_BAR; PG8_SCHED;
            PG8_LDB(B0, 1, 0); PG8_LDB(B1, 1, 1); PG8_SCHED; PG8_LDA(At, 1, 0); PG8_STAGE(PG8_SA(0, 1), a2 + hstep, voffA);
            PG8_WAIT_V(8); PG8_WAIT_L(0); PG8_BAR; PG8_MMA(0, 0, At, B0); PG8_MMA(0, 1, At, B1); PG8_BAR; PG8_SCHED;
            PG8_LDA(At, 1, 1); PG8_STAGE(PG8_SB(1, 0), b3, voffB); PG8_STAGE(PG8_SB(1, 1), b3 + hstep, voffB); PG8_STAGE(PG8_SA(1, 0), a3, voffA);
            PG8_WAIT_V(8); PG8_WAIT_L(0); PG8_BAR; PG8_MMA(1, 0, At, B0); PG8_MMA(1, 1, At, B1); PG8_BAR; PG8_SCHED;
            } else {
            PG8_LDB(B0, 0, 0); PG8_SCHED; PG8_LDA(At, 0, 0); PG8_STAGE(PG8_SA(1, 1), a1 + hstep, voffA);
            PG8_WAIT_L(8); PG8_BAR; PG8_WAIT_L(0); PG8_MMA(0, 0, At, B0); PG8_BAR; PG8_SCHED;
            PG8_LDB(B1, 0, 1); PG8_STAGE(PG8_SB(0, 0), b2, voffB);
            PG8_BAR; PG8_WAIT_L(0); PG8_MMA(0, 1, At, B1); PG8_BAR;
            PG8_LDA(At, 0, 1); PG8_STAGE(PG8_SA(0, 0), a2, voffA);
            PG8_BAR; PG8_WAIT_L(0); PG8_MMA(1, 0, At, B0); PG8_BAR; PG8_SCHED;
            PG8_STAGE(PG8_SB(0, 1), b2 + hstep, voffB);
            PG8_WAIT_V(6); PG8_BAR; PG8_MMA(1, 1, At, B1); PG8_BAR;
            PG8_LDB(B0, 1, 0); PG8_SCHED; PG8_LDA(At, 1, 0); PG8_STAGE(PG8_SA(0, 1), a2 + hstep, voffA);
            PG8_WAIT_L(8); PG8_BAR; PG8_WAIT_L(0); PG8_MMA(0, 0, At, B0); PG8_BAR; PG8_SCHED;
            PG8_LDB(B1, 1, 1); PG8_STAGE(PG8_SB(1, 0), b3, voffB);
            PG8_BAR; PG8_WAIT_L(0); PG8_MMA(0, 1, At, B1); PG8_BAR;
            PG8_LDA(At, 1, 1); PG8_STAGE(PG8_SA(1, 0), a3, voffA);
            PG8_BAR; PG8_WAIT_L(0); PG8_MMA(1, 0, At, B0); PG8_BAR; PG8_SCHED;
            PG8_STAGE(PG8_SB(1, 1), b3 + hstep, voffB);
            PG8_WAIT_V(6); PG8_BAR; PG8_MMA(1, 1, At, B1); PG8_BAR;
            }
        }
        if constexpr (F8) asm volatile("s_nop 15\n\ts_nop 7" ::: "memory");
        if constexpr (ALIGN_EPI) { if (wr == 0) PG8_BAR; }
        if constexpr (!Epi::AFTER_DRAIN) { E(acc, cur, wr, wc, fr, fq); S.done(cur); }
        if (!has_next) break;
#pragma unroll
        for (int a = 0; a < 2; ++a)
#pragma unroll
            for (int b = 0; b < 2; ++b)
#pragma unroll
                for (int m = 0; m < 4; ++m)
#pragma unroll
                    for (int n = 0; n < 2; ++n) acc[a][b][m][n] = (f32x4){0.f, 0.f, 0.f, 0.f};
        cur = nxt; cA = nA; cB = nB; ++ui;
        if constexpr (ALIGN_EPI) { if (wr == 1) PG8_BAR; }
    }
    PG8_WAIT_V(0);
    if constexpr (!ALIGN_EPI) { if (wr == 0) PG8_BAR; }
    PG8_BAR;
    if constexpr (Epi::AFTER_DRAIN) { E.fused(acc, cur, wr, wc, fr, fq, lds, wid, lane); S.done(cur); }
#undef PG8_SA
#undef PG8_SB
#undef PG8_STAGE
#undef PG8_LDA
#undef PG8_LDB
#undef PG8_MMA
#undef PG8_WAIT_V
#undef PG8_WAIT_L
#undef PG8_BAR
#undef PG8_SCHED
}

typedef unsigned u32x6 __attribute__((ext_vector_type(6)));
__device__ __forceinline__ f32x4 mma6(const u32x6& b, const u32x6& a, f32x4 c) { asm volatile("v_mfma_f32_16x16x128_f8f6f4 %0, %1, %2, %0 cbsz:2 blgp:2" : "+v"(c) : "v"(b), "v"(a)); return c; }
constexpr int F6_BLOCK = 24576, F6_KT = 8  , F6_BUF = 49152;
__host__ __device__ __forceinline__ int f6_p_off(int r, int fq) { return (r >> 4) * 1024 + (r & 15) * 64 + ((fq ^ (((r & 15) >> 3) << 1)) * 16); }
__host__ __device__ __forceinline__ int f6_q_off(int r, int fq) { return (r >> 4) * 512 + (r & 15) * 32 + ((fq ^ (((r & 15) >> 3) << 1)) * 8); }
template <class Epi, class Sched, bool ALIGN_EPI>
__device__ __forceinline__ void gemm_phase6(PG8_LAS unsigned char* lds, const unsigned char* Aimg, const unsigned char* Bimg, const Sched& S, const Epi& E, const int wid) {
    int lane; asm volatile("v_mbcnt_lo_u32_b32 %0, -1, 0\n\tv_mbcnt_hi_u32_b32 %0, -1, %0" : "=v"(lane));
    const int wr = wid >> 2, wc = wid & 3, fr = lane & 15, fq = lane >> 4;
    const unsigned goff = (unsigned)(wid * 1024 + lane * 16);
    const unsigned ldsw = (unsigned)wid * 1024u;
    const size_t kstep = F6_BLOCK, tstep = (size_t)F6_KT * F6_BLOCK;
    const int pa = f6_p_off(wr * 64 + fr, fq), qa = f6_q_off(wr * 64 + fr, fq), pb = f6_p_off(wc * 32 + fr, fq), qb = f6_q_off(wc * 32 + fr, fq);
#define F6_AP(b, h) ((b) * F6_BUF + (h) * 8192)
#define F6_BP(b, h) ((b) * F6_BUF + 16384 + (h) * 8192)
#define F6_AQ(b) ((b) * F6_BUF + 32768)
#define F6_BQ(b) ((b) * F6_BUF + 40960)
#define F6_ST(ldsoff, gptr) __builtin_amdgcn_global_load_lds((const unsigned*)((const char*)(gptr) + goff), (PG8_LAS unsigned*)(lds + (ldsoff) + ldsw), 16, 0, 0)
#define F6_STAGE_X(b, ga, gb) do { F6_ST(F6_BP(b, 0), (gb)); F6_ST(F6_BP(b, 1), (gb) + 8192); F6_ST(F6_BQ(b), (gb) + 16384); F6_ST(F6_AQ(b), (ga) + 16384); F6_ST(F6_AP(b, 0), (ga)); } while (0)
#define F6_STAGE_Y(b, ga) F6_ST(F6_AP(b, 1), (ga) + 8192)
#define F6_FRAG(dst, poff, qoff) do { const u32x4 _lo = *(const PG8_LAS u32x4*)(lds + (poff)); const u32x2 _hi = *(const volatile PG8_LAS u32x2*)(lds + (qoff));     dst = (u32x6){_lo.x, _lo.y, _lo.z, _lo.w, _hi.x, _hi.y}; } while (0)
#define F6_LDB(dst, b, h) do { _Pragma("unroll") for (int n = 0; n < 2; ++n) F6_FRAG(dst[n], F6_BP(b, h) + pb + n * 1024, F6_BQ(b) + (h) * 4096 + qb + n * 512); } while (0)
#define F6_LDA0(b) do { _Pragma("unroll") for (int m = 0; m < 4; ++m) F6_FRAG(At[m], F6_AP(b, 0) + pa + m * 1024, F6_AQ(b) + qa + m * 512); \
        _Pragma("unroll") for (int m = 0; m < 4; ++m) Aq[m] = *(const volatile PG8_LAS u32x2*)(lds + F6_AQ(b) + 4096 + qa + m * 512); } while (0)
#define F6_LDA1(b) do { _Pragma("unroll") for (int m = 0; m < 4; ++m) { const u32x4 _lo = *(const PG8_LAS u32x4*)(lds + F6_AP(b, 1) + pa + m * 1024); At[m] = (u32x6){_lo.x, _lo.y, _lo.z, _lo.w, Aq[m].x, Aq[m].y}; } } while (0)
#define F6_MMA(ai, bj, Bt) do { __builtin_amdgcn_s_setprio(1); _Pragma("unroll") for (int m = 0; m < 4; ++m) _Pragma("unroll") for (int n = 0; n < 2; ++n) \
        acc[ai][bj][m][n] = mma6(Bt[n], At[m], acc[ai][bj][m][n]); __builtin_amdgcn_s_setprio(0); } while (0)
#define F6_WAIT_V(n) asm volatile("s_waitcnt vmcnt(" #n ")" ::: "memory")
#define F6_WAIT_L(n) asm volatile("s_waitcnt lgkmcnt(" #n ")" ::: "memory")
#define F6_BAR __builtin_amdgcn_s_barrier()
#define F6_SCHED __builtin_amdgcn_sched_barrier(0)
    Unit cur, nxt; int ui = 0;
    if (!S.next(0, cur)) return;
    f32x4 acc[2][2][4][2];
#pragma unroll
    for (int a = 0; a < 2; ++a)
#pragma unroll
        for (int b = 0; b < 2; ++b)
#pragma unroll
            for (int m = 0; m < 4; ++m)
#pragma unroll
                for (int n = 0; n < 2; ++n) acc[a][b][m][n] = (f32x4){0.f, 0.f, 0.f, 0.f};
    u32x6 At[4], B0[2], B1[2]; u32x2 Aq[4];
    const char* cA = (const char*)Aimg + (size_t)cur.pm * tstep; const char* cB = (const char*)Bimg + (size_t)cur.pn * tstep;
    F6_STAGE_X(0, cA, cB); F6_STAGE_Y(0, cA);
    if (wr == 1) F6_BAR;
    F6_WAIT_V(1); F6_BAR;
    F6_STAGE_X(1, cA + kstep, cB + kstep);
    F6_WAIT_V(5); F6_BAR;
    for (;;) {
        const bool has_next = S.next(ui + 1, nxt);
        const char* nA = has_next ? (const char*)Aimg + (size_t)nxt.pm * tstep : cA; const char* nB = has_next ? (const char*)Bimg + (size_t)nxt.pn * tstep : cB;
        for (int t = 0; t < F6_KT; t += 2) {
            const bool last = (t == F6_KT - 2);
            const char* a1 = cA + (size_t)(t + 1) * kstep;
            const char* a2 = last ? nA : cA + (size_t)(t + 2) * kstep; const char* b2 = last ? nB : cB + (size_t)(t + 2) * kstep;
            const char* a3 = a2 + kstep; const char* b3 = b2 + kstep;
            F6_LDB(B0, 0, 0); F6_LDB(B1, 0, 1); F6_SCHED; F6_LDA0(0); F6_STAGE_Y(1, a1);
            F6_WAIT_V(6); F6_WAIT_L(0); F6_BAR; F6_MMA(0, 0, B0); F6_MMA(0, 1, B1); F6_BAR; F6_SCHED;
            F6_LDA1(0); F6_STAGE_X(0, a2, b2);
            F6_WAIT_V(6); F6_WAIT_L(0); F6_BAR; F6_MMA(1, 0, B0); F6_MMA(1, 1, B1); F6_BAR; F6_SCHED;
            F6_LDB(B0, 1, 0); F6_LDB(B1, 1, 1); F6_SCHED; F6_LDA0(1); F6_STAGE_Y(0, a2);
            F6_WAIT_V(6); F6_WAIT_L(0); F6_BAR; F6_MMA(0, 0, B0); F6_MMA(0, 1, B1); F6_BAR; F6_SCHED;
            F6_LDA1(1); F6_STAGE_X(1, a3, b3);
            F6_WAIT_V(6); F6_WAIT_L(0); F6_BAR; F6_MMA(1, 0, B0); F6_MMA(1, 1, B1); F6_BAR; F6_SCHED;
        }
        asm volatile("s_nop 15\n\ts_nop 7" ::: "memory");
        if constexpr (ALIGN_EPI) { if (wr == 0) F6_BAR; }
        E(acc, cur, wr, wc, fr, fq);
        if (!has_next) break;
#pragma unroll
        for (int a = 0; a < 2; ++a)
#pragma unroll
            for (int b = 0; b < 2; ++b)
#pragma unroll
                for (int m = 0; m < 4; ++m)
#pragma unroll
                    for (int n = 0; n < 2; ++n) acc[a][b][m][n] = (f32x4){0.f, 0.f, 0.f, 0.f};
        cur = nxt; cA = nA; cB = nB; ++ui;
        if constexpr (ALIGN_EPI) { if (wr == 1) F6_BAR; }
    }
    F6_WAIT_V(0);
    if constexpr (!ALIGN_EPI) { if (wr == 0) F6_BAR; }
    F6_BAR;
#undef F6_AP
#undef F6_BP
#undef F6_AQ
#undef F6_BQ
#undef F6_ST
#undef F6_STAGE_X
#undef F6_STAGE_Y
#undef F6_FRAG
#undef F6_LDB
#undef F6_LDA0
#undef F6_LDA1
#undef F6_MMA
#undef F6_WAIT_V
#undef F6_WAIT_L
#undef F6_BAR
#undef F6_SCHED
}
}

#define GAS __attribute__((address_space(1)))
#define LAS __attribute__((address_space(3)))
typedef unsigned short bf16;
typedef unsigned v4u __attribute__((ext_vector_type(4)));
typedef unsigned v2u __attribute__((ext_vector_type(2)));
typedef float f32x4 __attribute__((ext_vector_type(4)));
typedef float f32x16 __attribute__((ext_vector_type(16)));
typedef short bf16x8 __attribute__((ext_vector_type(8)));
typedef short s16x4 __attribute__((ext_vector_type(4)));
typedef GAS unsigned gu32;
#define RLX_AGENT __ATOMIC_RELAXED, __HIP_MEMORY_SCOPE_AGENT
#define LDS_WAIT() asm volatile("s_waitcnt lgkmcnt(0)" ::: "memory")
#define VM_WAIT() asm volatile("s_waitcnt vmcnt(0)" ::: "memory")
__device__ __forceinline__ unsigned f2bf(float f) { unsigned u = __builtin_bit_cast(unsigned, f); return (u + 0x7fffu + ((u >> 16) & 1u)) >> 16; }
__device__ __forceinline__ unsigned pk2(float lo, float hi) { return f2bf(lo) | (f2bf(hi) << 16); }
__device__ __forceinline__ float bf2f(unsigned short b) { return __builtin_bit_cast(float, (unsigned)b << 16); }
__device__ __forceinline__ float bflo(unsigned w) { return __builtin_bit_cast(float, w << 16); }
__device__ __forceinline__ float bfhi(unsigned w) { return __builtin_bit_cast(float, w & 0xffff0000u); }
__device__ __forceinline__ int fresh_lane() { int l; asm volatile("v_mbcnt_lo_u32_b32 %0, -1, 0\n\tv_mbcnt_hi_u32_b32 %0, -1, %0" : "=v"(l)); return l; }
__device__ __forceinline__ float wave_sum(float v) {
#pragma unroll
    for (int o = 1; o < 64; o <<= 1) v += __shfl_xor(v, o);
    return v;
}
__device__ __forceinline__ int t5_bucket(int rel) {
    const int n = rel < 0 ? -rel : rel;
    const int large = 8 + (n >= 15) + (n >= 27) + (n >= 50) + (n >= 91) + (n >= 166) + (n >= 305) + (n >= 559);
    return (rel > 0 ? 16 : 0) + (n < 8 ? n : large);
}

#define XB_TMO      128
#define XB_XCNT(j)  (256  + 64 * (j))
#define XB_XSUB(j)  (1280 + 64 * (j))
#define XB_XGEN(j)  (2304 + 64 * (j))
#define XB_TOP      3328
#define XB_TOPGEN   3392
#define XCD_BAR_WORDS 3456
#define XB_SPIN_CAP (1u << 18)

__device__ __forceinline__ unsigned xb_ld(unsigned* p)              { return __hip_atomic_load(p, __ATOMIC_RELAXED, __HIP_MEMORY_SCOPE_AGENT); }
__device__ __forceinline__ unsigned xb_add(unsigned* p, unsigned v) { return __hip_atomic_fetch_add(p, v, __ATOMIC_RELAXED, __HIP_MEMORY_SCOPE_AGENT); }
__device__ __forceinline__ unsigned xb_xcc_id() { return (unsigned)__builtin_amdgcn_s_getreg((3 << 11) | 20) & 0xFu; }
#define XB_SPIN(cond, bar) do { unsigned _sp = 0; while (cond) { __builtin_amdgcn_s_sleep(1); \
    if ((++_sp & 255u) == 0u) { if (xb_ld(&(bar)[XB_TMO])) break; if (_sp > XB_SPIN_CAP) { atomicAdd(&(bar)[XB_TMO], 1u); break; } } } } while (0)

struct XcdBarrier {
    unsigned* bar; unsigned x;
    volatile LAS unsigned* st;
};

__device__ __forceinline__ XcdBarrier xcd_barrier_post(unsigned* bar, volatile LAS unsigned* st, int tid) {
    XcdBarrier b; b.bar = bar; b.x = xb_xcc_id(); b.st = st;
    if (tid == 0) (void)xb_add(&bar[XB_XCNT(b.x)], 1u);
    return b;
}
__device__ __forceinline__ void xcd_barrier_complete(unsigned* bar, unsigned x, unsigned& nloc, unsigned& nx) {
    const unsigned G = gridDim.x * gridDim.y * gridDim.z;
    unsigned sum, cnt, mine, sp = 0u;
    for (;;) {
        sum = 0u; cnt = 0u; mine = 0u;
#pragma unroll
        for (unsigned j = 0; j < 16; ++j) { const unsigned c = xb_ld(&bar[XB_XCNT(j)]); sum += c; cnt += (c > 0u) ? 1u : 0u; mine = (j == x) ? c : mine; }
        if (sum == G) break;
        __builtin_amdgcn_s_sleep(1);
        if ((++sp & 255u) == 0u) { if (xb_ld(&bar[XB_TMO])) break; if (sp > XB_SPIN_CAP) { atomicAdd(&bar[XB_TMO], 1u); break; } }
    }
    nloc = mine > 0u ? mine : 1u; nx = cnt > 0u ? cnt : 1u;
}

__device__ __forceinline__ void xcd_barrier(const XcdBarrier& b, int tid) {
    asm volatile("s_waitcnt vmcnt(0)" ::: "memory");
    __syncthreads();
    if (tid == 0) {
        unsigned* bar = b.bar;
        __builtin_amdgcn_s_waitcnt(0);
        unsigned nloc = b.st[0], nx = b.st[1];
        if (nloc == 0u) { xcd_barrier_complete(bar, b.x, nloc, nx); b.st[0] = nloc; b.st[1] = nx; }
        const unsigned old = xb_add(&bar[XB_XSUB(b.x)], 1u);
        const unsigned gen = old / nloc;
        if (old + 1u == (gen + 1u) * nloc) {
            __builtin_amdgcn_fence(__ATOMIC_RELEASE, "agent");
            asm volatile("s_waitcnt vmcnt(0)" ::: "memory");
            const unsigned og = xb_add(&bar[XB_TOP], 1u);
            const unsigned tg = og / nx;
            if (og + 1u == (tg + 1u) * nx) xb_add(&bar[XB_TOPGEN], 1u);
            else XB_SPIN(xb_ld(&bar[XB_TOPGEN]) == tg, bar);
            __builtin_amdgcn_fence(__ATOMIC_ACQUIRE, "agent");
            xb_add(&bar[XB_XGEN(b.x)], 1u);
            asm volatile("s_waitcnt vmcnt(0)" ::: "memory");
        } else {
            XB_SPIN(xb_ld(&bar[XB_XGEN(b.x)]) == gen, bar);
            __builtin_amdgcn_fence(__ATOMIC_ACQUIRE, "agent");
            asm volatile("s_waitcnt vmcnt(0)" ::: "memory");
        }
    }
    __syncthreads();
}

struct Args {
    const float *x, *g1, *w_in, *lq1, *lk1, *lq2, *lk2, *subln, *w_out, *relb, *g2, *w_router, *w_gate, *w_up, *w_down, *gf;
    float* out; unsigned char* ws; int ph_lo, ph_hi, variant, pad;
};
struct Frame {
    LAS unsigned char* lds;
    volatile LAS unsigned* MISC;
    int wave, vcu, G;
};

__device__ __forceinline__ void transpose_item(const float* W, int N, bf16* WT, int KT, int k0, int n0, int orow0, LAS float* scr, int lane) {
#pragma unroll 32
    for (int i = 0; i < 32; ++i) { const int kk = 2 * i + (lane >> 5); scr[kk * 33 + (lane & 31)] = W[(size_t)(k0 + kk) * N + n0 + (lane & 31)]; }
    LDS_WAIT(); asm volatile("" ::: "memory");
    const int c = lane & 7;
#pragma unroll
    for (int j = 0; j < 4; ++j) { const int n = (lane >> 3) + 8 * j; const LAS float* s = scr + (8 * c) * 33 + n;
        v4u o; o.x = pk2(s[0 * 33], s[1 * 33]); o.y = pk2(s[2 * 33], s[3 * 33]); o.z = pk2(s[4 * 33], s[5 * 33]); o.w = pk2(s[6 * 33], s[7 * 33]);
        *(GAS v4u*)(WT + (size_t)(orow0 + n) * KT + k0 + 8 * c) = o; }
    LDS_WAIT(); asm volatile("" ::: "memory");
}
__device__ __forceinline__ int pk4_fp8(float a, float b, float c, float d) { a = pg8::q6(a); b = pg8::q6(b); c = pg8::q6(c); d = pg8::q6(d); int w = 0; w = __builtin_amdgcn_cvt_pk_fp8_f32(a, b, w, false); w = __builtin_amdgcn_cvt_pk_fp8_f32(c, d, w, true); return w; }
typedef float f32x4g __attribute__((ext_vector_type(4)));
__device__ __forceinline__ void t8_load(f32x4g (&wv)[16], const float* W, int N, int k0, int n0, int lane) {
    const float* src = W + (size_t)(k0 + 16 * (lane >> 4)) * N + n0 + 4 * (lane & 15);
#pragma unroll
    for (int j = 0; j < 16; ++j) wv[j] = __builtin_nontemporal_load((const GAS f32x4g*)(src + (size_t)j * N));
}
__device__ __forceinline__ void t8_store(const f32x4g (&wv)[16], unsigned char* WT, int KT, int k0, int orow0, int lane, float sc) {
    unsigned char* dst = WT + (size_t)(orow0 + 4 * (lane & 15)) * KT + k0 + 16 * (lane >> 4);
#pragma unroll
    for (int c = 0; c < 4; ++c) { v4u o;
#pragma unroll
        for (int q = 0; q < 4; ++q) o[q] = (unsigned)pk4_fp8(wv[4 * q][c] * sc, wv[4 * q + 1][c] * sc, wv[4 * q + 2][c] * sc, wv[4 * q + 3][c] * sc);
        __builtin_nontemporal_store(o, (GAS v4u*)(dst + (size_t)c * KT)); }
}
constexpr int CV_G1 = 16 * 44, CV_G = NE * CV_G1, CV_D1 = 44 * 16, CV_D = NE * CV_D1;
struct CvItem { const float* W; unsigned char* WT; int N, KT, k0, n0, orow0; float sc; };
__device__ __forceinline__ CvItem cv_decode(const Args& a, int r) {
    CvItem it;
    if (r < 2 * CV_G) { const int up = r >= CV_G; if (up) r -= CV_G; const int e = r / CV_G1, q = r % CV_G1, kb = q / 44, nb = q % 44, n0 = 64 * nb;
        it.W = (up ? a.w_up : a.w_gate) + (size_t)e * 1024 * DFF; it.N = DFF; it.WT = a.ws + WS_W1T + (size_t)e * 5632 * 1024; it.KT = 1024; it.k0 = 64 * kb; it.n0 = n0; it.orow0 = (n0 >> 7) * 256 + (n0 & 127) + (up ? 128 : 0); it.sc = pg8::WS8; }
    else { r -= 2 * CV_G; const int e = r / CV_D1, q = r % CV_D1, kb = q / 16, nb = q % 16;
        it.W = a.w_down + (size_t)e * DFF * 1024; it.N = 1024; it.WT = a.ws + WS_W2T + (size_t)e * 1024 * DFF; it.KT = DFF; it.k0 = 64 * kb; it.n0 = 64 * nb; it.orow0 = 64 * nb; it.sc = pg8::WS8D; }
    return it;
}
#if MK_FP6
typedef float f32x2g __attribute__((ext_vector_type(2)));
typedef float f32x16 __attribute__((ext_vector_type(16)));
typedef unsigned u32x6 __attribute__((ext_vector_type(6)));
__device__ __forceinline__ float clamp6(float v) { return __builtin_amdgcn_fmed3f(v, -7.5f, 7.5f); }
struct Cv6Item { const float* W; unsigned char* blk; int jb; };
__device__ __forceinline__ Cv6Item cv6_decode(const Args& a, int r) {
    Cv6Item it; const int up = r >= CV_G; if (up) r -= CV_G; const int e = r / CV_G1, q = r % CV_G1, kt = q / 88, nb = q % 88, n0 = 32 * nb;
    it.W = (up ? a.w_up : a.w_gate) + (size_t)e * 1024 * DFF + (size_t)(128 * kt) * DFF + n0;
    it.blk = a.ws + WS_W1T + (size_t)((e * 22 + (n0 >> 7)) * 8 + kt) * pg8::F6_BLOCK; it.jb = (up ? 128 : 0) + (n0 & 127);
    return it;
}
__device__ __forceinline__ void cv6_load(f32x2g (&wv)[32], const Cv6Item& it, int lane) {
    const float* src = it.W + (size_t)(32 * (lane >> 4)) * DFF + 2 * (lane & 15);
#pragma unroll
    for (int j = 0; j < 32; ++j) wv[j] = __builtin_nontemporal_load((const GAS f32x2g*)(src + (size_t)j * DFF));
}
__device__ __forceinline__ void cv6_store(const f32x2g (&wv)[32], const Cv6Item& it, int lane) {
    const int fq = lane >> 4;
#pragma unroll
    for (int i = 0; i < 2; ++i) { f32x16 lo, hi;
#pragma unroll
        for (int j = 0; j < 16; ++j) { lo[j] = clamp6(wv[j][i] * pg8::WS8); hi[j] = clamp6(wv[16 + j][i] * pg8::WS8); }
        const u32x6 pk = __builtin_amdgcn_cvt_scalef32_2xpk16_fp6_f32(lo, hi, 1.0f);
        const int x = 2 * (lane & 15) + i, rho = it.jb + ((x >> 2) & 1) * 16 + (x >> 3) * 4 + (x & 3), half = rho >> 7, rr = rho & 127;
        __builtin_nontemporal_store((v4u){pk[0], pk[1], pk[2], pk[3]}, (GAS v4u*)(it.blk + half * 8192 + pg8::f6_p_off(rr, fq)));
        __builtin_nontemporal_store((v2u){pk[4], pk[5]}, (GAS v2u*)(it.blk + 16384 + half * 4096 + pg8::f6_q_off(rr, fq))); }
}
__device__ __forceinline__ void cv6_run(const Args& a, int begin, int end, int cw, int CW) {
    const int lane = fresh_lane();
    int r = begin + cw; if (r >= end) return;
    f32x2g wa[32], wb[32];
    Cv6Item ia = cv6_decode(a, r), ib = ia;
    cv6_load(wa, ia, lane);
    for (;;) {
        const bool hb = r + CW < end;
        if (hb) { ib = cv6_decode(a, r + CW); cv6_load(wb, ib, lane); }
        cv6_store(wa, ia, lane);
        if (!hb) break;
        r += CW;
        const bool ha = r + CW < end;
        if (ha) { ia = cv6_decode(a, r + CW); cv6_load(wa, ia, lane); }
        cv6_store(wb, ib, lane);
        if (!ha) break;
        r += CW;
    }
}
#endif
__device__ __forceinline__ void cv_run(Frame& F, const Args& a, int begin, int end, int cw, int CW) {
    const int lane = fresh_lane();
    int r = begin + cw; if (r >= end) return;
    f32x4g wa[16], wb[16];
    CvItem ia = cv_decode(a, r), ib = ia;
    t8_load(wa, ia.W, ia.N, ia.k0, ia.n0, lane);
    for (;;) {
        const bool hb = r + CW < end;
        if (hb) { ib = cv_decode(a, r + CW); t8_load(wb, ib.W, ib.N, ib.k0, ib.n0, lane); }
        t8_store(wa, ia.WT, ia.KT, ia.k0, ia.orow0, lane, ia.sc);
        if (!hb) break;
        r += CW;
        const bool ha = r + CW < end;
        if (ha) { ia = cv_decode(a, r + CW); t8_load(wa, ia.W, ia.N, ia.k0, ia.n0, lane); }
        t8_store(wb, ib.WT, ib.KT, ib.k0, ib.orow0, lane, ib.sc);
        if (!ha) break;
        r += CW;
    }
}
__device__ __forceinline__ void rms_row_to_bf16(const float* xrow, const float* g, bf16* orow, int lane) {
    const GAS f32x4* xr = (const GAS f32x4*)xrow + lane; const GAS f32x4* gr = (const GAS f32x4*)g + lane;
    f32x4 v[4]; float s = 0.f;
#pragma unroll
    for (int j = 0; j < 4; ++j) { v[j] = xr[64 * j]; s += (v[j].x * v[j].x + v[j].y * v[j].y) + (v[j].z * v[j].z + v[j].w * v[j].w); }
    const float rstd = 1.f / sqrtf(wave_sum(s) * (1.f / DM) + NORM_EPS);
    GAS unsigned long long* o8 = (GAS unsigned long long*)orow + lane;
#pragma unroll
    for (int j = 0; j < 4; ++j) { const f32x4 gg = gr[64 * j]; const f32x4 y = v[j] * rstd * gg;
        o8[64 * j] = (unsigned long long)pk2(y.x, y.y) | ((unsigned long long)pk2(y.z, y.w) << 32); }
}
__device__ __forceinline__ void p0_prologue(Frame& F, const Args& a) {
    LAS float* scr = (LAS float*)(F.lds + RING_OFF + F.wave * 16384);
    const int gw = F.vcu * NWAVES + F.wave, NGW = F.G * NWAVES, lane0 = fresh_lane();
    bf16* win_t = (bf16*)(a.ws + WS_WIN); bf16* wout_t = (bf16*)(a.ws + WS_WOUT);
    constexpr int I_IN = 16 * 96, I_OUT = 16 * 32;
    for (int it = gw; it < I_IN + I_OUT; it += NGW) {
        int r = it;
        if (r < I_IN) { const int kb = r / 96, nb = r % 96; transpose_item(a.w_in, NIN, win_t, 1024, 64 * kb, 32 * nb, 32 * nb, scr, lane0); continue; } r -= I_IN;
        { const int kb = r / 32, nb = r % 32; transpose_item(a.w_out, 1024, wout_t, 1024, 64 * kb, 32 * nb, 32 * nb, scr, lane0); }
    }
    bf16* h1 = (bf16*)(a.ws + WS_H1);
    for (int m = gw; m < NTOK; m += NGW) rms_row_to_bf16(a.x + (size_t)m * DM, a.g1, h1 + (size_t)m * DM, lane0);
#if MK_FP6
    cv6_run(a, 0, 2 * CV_G, gw, NGW);
    cv_run(F, a, 2 * CV_G, 2 * CV_G + CV_D, gw, NGW);
#else
    cv_run(F, a, 0, 2 * CV_G + CV_D, gw, NGW);
#endif
}

__device__ __forceinline__ float xshfl(float v, int lane, int msk) { return __builtin_bit_cast(float, __builtin_amdgcn_ds_bpermute((lane ^ msk) << 2, __builtin_bit_cast(int, v))); }
__device__ __forceinline__ float reduce16(const float (&v)[16], int lane) {
    float w8[8], w4[4], w2[2];
    const bool b5 = lane & 32, b4 = lane & 16, b3 = lane & 8, b2 = lane & 4;
#pragma unroll
    for (int j = 0; j < 8; ++j) { const float keep = b5 ? v[j + 8] : v[j], send = b5 ? v[j] : v[j + 8]; w8[j] = keep + xshfl(send, lane, 32); }
#pragma unroll
    for (int j = 0; j < 4; ++j) { const float keep = b4 ? w8[j + 4] : w8[j], send = b4 ? w8[j] : w8[j + 4]; w4[j] = keep + xshfl(send, lane, 16); }
#pragma unroll
    for (int j = 0; j < 2; ++j) { const float keep = b3 ? w4[j + 2] : w4[j], send = b3 ? w4[j] : w4[j + 2]; w2[j] = keep + xshfl(send, lane, 8); }
    float w1 = (b2 ? w2[1] : w2[0]) + xshfl(b2 ? w2[0] : w2[1], lane, 4);
    w1 += xshfl(w1, lane, 2); w1 += xshfl(w1, lane, 1);
    return w1;
}
__device__ __forceinline__ void p4_router(Frame& F, const Args& a) {
    LAS float* wrT = (LAS float*)(F.lds + RING_OFF);
#if MK_FP6
    LAS float* tr = (LAS float*)(F.lds + RING_OFF + 65536 + F.wave * 8192);
#endif
    const int lane = fresh_lane();
    for (int i = F.wave * 64 + lane; i < 1024 * 16; i += NWAVES * 64) { const int k = i >> 4, e = i & 15; wrT[e * 1024 + k] = a.w_router[i]; }
    __syncthreads();
    const int gw = F.vcu * NWAVES + F.wave, NGW = F.G * NWAVES;
    const bf16* x2 = (const bf16*)(a.ws + WS_X2); unsigned char* h2 = a.ws + WS_H2; float* aff = (float*)(a.ws + WS_AFF); int* inv = (int*)(a.ws + WS_INV);
    f32x4 gg[4];
#pragma unroll
    for (int j = 0; j < 4; ++j) gg[j] = ((const GAS f32x4*)a.g2 + lane)[64 * j];
    v2u xn[2][4];
#pragma unroll
    for (int t = 0; t < 2; ++t) { const GAS v2u* xr = (const GAS v2u*)(x2 + (size_t)(gw + t * NGW) * DM) + lane;
#pragma unroll
        for (int j = 0; j < 4; ++j) xn[t][j] = xr[64 * j]; }
    for (int m = gw; m < NTOK; m += 2 * NGW) {
        f32x4 v[2][4]; float ss[2] = {0.f, 0.f};
#pragma unroll
        for (int t = 0; t < 2; ++t)
#pragma unroll
            for (int j = 0; j < 4; ++j) { const v2u xw = xn[t][j]; v[t][j] = (f32x4){bflo(xw.x), bfhi(xw.x), bflo(xw.y), bfhi(xw.y)}; ss[t] += (v[t][j].x * v[t][j].x + v[t][j].y * v[t][j].y) + (v[t][j].z * v[t][j].z + v[t][j].w * v[t][j].w); }
        if (m + 2 * NGW < NTOK) {
#pragma unroll
            for (int t = 0; t < 2; ++t) { const GAS v2u* xr = (const GAS v2u*)(x2 + (size_t)(m + (2 + t) * NGW) * DM) + lane;
#pragma unroll
                for (int j = 0; j < 4; ++j) xn[t][j] = xr[64 * j]; } }
#pragma unroll
        for (int t = 0; t < 2; ++t) { const float rstd = 1.f / sqrtf(wave_sum(ss[t]) * (1.f / DM) + NORM_EPS);
#if MK_FP6
#pragma unroll
            for (int j = 0; j < 4; ++j) { v[t][j] = v[t][j] * rstd * gg[j]; const int idx = t * 1024 + 256 * j + 4 * lane;
                *(LAS f32x4*)((LAS unsigned char*)tr + (idx >> 5) * 128 + ((((idx >> 2) ^ (idx >> 5)) & 7) * 16)) = v[t][j] * pg8::XS8; } }
        { LDS_WAIT(); f32x16 lo, hi;
#pragma unroll
          for (int i = 0; i < 4; ++i) { const f32x4 q0 = *(const LAS f32x4*)((const LAS unsigned char*)tr + lane * 128 + (((i ^ lane) & 7) * 16)), q1 = *(const LAS f32x4*)((const LAS unsigned char*)tr + lane * 128 + ((((4 + i) ^ lane) & 7) * 16));
              lo[4 * i] = clamp6(q0.x); lo[4 * i + 1] = clamp6(q0.y); lo[4 * i + 2] = clamp6(q0.z); lo[4 * i + 3] = clamp6(q0.w);
              hi[4 * i] = clamp6(q1.x); hi[4 * i + 1] = clamp6(q1.y); hi[4 * i + 2] = clamp6(q1.z); hi[4 * i + 3] = clamp6(q1.w); }
          const u32x6 pk = __builtin_amdgcn_cvt_scalef32_2xpk16_fp6_f32(lo, hi, 1.0f);
          unsigned char* hrow = h2 + (size_t)(m + (lane >> 5) * NGW) * 768;
          *(GAS v4u*)(hrow + (lane & 31) * 16) = (v4u){pk[0], pk[1], pk[2], pk[3]}; *(GAS v2u*)(hrow + 512 + (lane & 31) * 8) = (v2u){pk[4], pk[5]};
          asm volatile("" ::: "memory"); }
#else
            GAS int* o4 = (GAS int*)(h2 + (size_t)(m + t * NGW) * DM) + lane;
#pragma unroll
            for (int j = 0; j < 4; ++j) { v[t][j] = v[t][j] * rstd * gg[j]; const f32x4 q = v[t][j] * pg8::XS8; o4[64 * j] = pk4_fp8(pg8::clamp448(q.x), pg8::clamp448(q.y), pg8::clamp448(q.z), pg8::clamp448(q.w)); } }
#endif
        float lg[2][16];
        typedef float f32x2r __attribute__((ext_vector_type(2)));
        f32x2r vp[4][4];
#pragma unroll
        for (int j = 0; j < 4; ++j) { vp[j][0] = (f32x2r){v[0][j].x, v[1][j].x}; vp[j][1] = (f32x2r){v[0][j].y, v[1][j].y}; vp[j][2] = (f32x2r){v[0][j].z, v[1][j].z}; vp[j][3] = (f32x2r){v[0][j].w, v[1][j].w}; }
#pragma unroll
        for (int e = 0; e < 16; ++e) { f32x2r acc = {0.f, 0.f};
#pragma unroll
            for (int j = 0; j < 4; ++j) { const f32x4 w = *(const LAS f32x4*)(wrT + e * 1024 + 256 * j + 4 * lane);
                acc = __builtin_elementwise_fma(vp[j][0], (f32x2r){w.x, w.x}, acc); acc = __builtin_elementwise_fma(vp[j][1], (f32x2r){w.y, w.y}, acc);
                acc = __builtin_elementwise_fma(vp[j][2], (f32x2r){w.z, w.z}, acc); acc = __builtin_elementwise_fma(vp[j][3], (f32x2r){w.w, w.w}, acc); }
            asm volatile("" : "+v"(acc));
            lg[0][e] = acc.x; lg[1][e] = acc.y; __builtin_amdgcn_sched_barrier(0); }
#pragma unroll
        for (int t = 0; t < 2; ++t) {
            __builtin_amdgcn_sched_barrier(0);
            const float lgt = reduce16(lg[t], lane);
            float mx = lgt;
#pragma unroll
            for (int o = 4; o < 64; o <<= 1) mx = fmaxf(mx, xshfl(mx, lane, o));
            const float ex = __expf(lgt - mx); float sum = ex;
#pragma unroll
            for (int o = 4; o < 64; o <<= 1) sum += xshfl(sum, lane, o);
            const int row = m + t * NGW, b = row >> 12, spos = row & 4095;
            if ((lane & 3) == 0) aff[((size_t)(b * 16 + (lane >> 2))) * SEQ + spos] = ex / sum;
            if (lane < 16) inv[(size_t)row * 16 + lane] = -1;
            __builtin_amdgcn_sched_barrier(0); }
    }
}

__device__ __forceinline__ int block_excl_scan(int v, LAS int* tmp, int tid, int& total) {
    const int lane = tid & 63, w = tid >> 6; int x = v;
#pragma unroll
    for (int o = 1; o < 64; o <<= 1) { const int t = __shfl_up(x, o); if (lane >= o) x += t; }
    if (lane == 63) tmp[w] = x;
    __syncthreads();
    int off = 0, tot = 0;
#pragma unroll
    for (int j = 0; j < 8; ++j) { const int t = tmp[j]; tot += t; if (j < w) off += t; }
    __syncthreads();
    total = tot; return off + x - v;
}
__device__ __forceinline__ void p5_topk(Frame& F, const Args& a) {
    LAS unsigned* keys = (LAS unsigned*)(F.lds + RING_OFF);
    LAS unsigned* hist = keys + 4096;
    LAS int* tmp = (LAS int*)(hist + 256);
    LAS unsigned* bc = (LAS unsigned*)(tmp + 8);
    const float* aff = (const float*)(a.ws + WS_AFF); float* gate = (float*)(a.ws + WS_GATE); int* inv = (int*)(a.ws + WS_INV);
    const int tid = F.wave * 64 + fresh_lane();
    for (int pr = F.vcu; pr < BATCH * NE; pr += F.G) {
        const int b = pr >> 4, e = pr & 15;
        const float* src = aff + (size_t)pr * SEQ;
        unsigned k[8];
#pragma unroll
        for (int j = 0; j < 8; ++j) k[j] = __builtin_bit_cast(unsigned, src[tid * 8 + j]);
        unsigned prefix = 0u, need = CAP;
#pragma unroll 1
        for (int pass = 0; pass < 4; ++pass) {
            const int shift = 24 - 8 * pass;
            if (tid < 256) hist[tid] = 0u;
            __syncthreads();
#pragma unroll
            for (int j = 0; j < 8; ++j) { const bool in = (pass == 0) || ((k[j] >> (shift + 8)) == prefix);
                if (in) __hip_atomic_fetch_add(hist + ((k[j] >> shift) & 255u), 1u, __ATOMIC_RELAXED, __HIP_MEMORY_SCOPE_WORKGROUP); }
            __syncthreads();
            {
                const int hb = tid < 256 ? (int)hist[255 - tid] : 0; int tot; const int above = block_excl_scan(hb, tmp, tid, tot);
                if (tid < 256 && above < (int)need && above + hb >= (int)need) { bc[0] = (prefix << 8) | (unsigned)(255 - tid); bc[1] = need - (unsigned)above; } }
            __syncthreads();
            prefix = bc[0]; need = bc[1];
            __syncthreads();
        }
        const unsigned T = prefix;
        int ceq = 0;
#pragma unroll
        for (int j = 0; j < 8; ++j) ceq += (k[j] == T);
        int tot; int eqr = block_excl_scan(ceq, tmp, tid, tot);
        int csel = 0; bool sel[8];
#pragma unroll
        for (int j = 0; j < 8; ++j) { sel[j] = (k[j] > T) || (k[j] == T && eqr < (int)need); eqr += (k[j] == T); csel += sel[j]; }
        int slot = block_excl_scan(csel, tmp, tid, tot);
#pragma unroll
        for (int j = 0; j < 8; ++j) if (sel[j]) { const int s = tid * 8 + j; const size_t o = ((size_t)e * BATCH + b) * CAP + slot;
            gate[o] = __builtin_bit_cast(float, k[j]); inv[((size_t)b * SEQ + s) * 16 + e] = slot; ((LAS int*)keys)[slot] = s; ++slot; }
        __syncthreads();
#if MK_FP6
        { const int lane = tid & 63, G = lane & 31, kt = G >> 2, fq = G & 3; const unsigned char* h2 = a.ws + WS_H2;
          unsigned char* xe = a.ws + WS_XE + ((size_t)(e * BATCH + b) * 2 * 8 + kt) * pg8::F6_BLOCK;
#pragma unroll 4
          for (int c = (tid >> 6) * 2 + (lane >> 5); c < CAP; c += 2 * NWAVES) { const int tok = b * SEQ + ((LAS int*)keys)[c];
              const unsigned char* src = h2 + (size_t)tok * 768; const v4u pv = *(const GAS v4u*)(src + G * 16); const v2u qv = *(const GAS v2u*)(src + 512 + G * 8);
              unsigned char* blk = xe + (size_t)(c >> 8) * 8 * pg8::F6_BLOCK; const int half = (c >> 7) & 1, rr = c & 127;
              *(GAS v4u*)(blk + half * 8192 + pg8::f6_p_off(rr, fq)) = pv; *(GAS v2u*)(blk + 16384 + half * 4096 + pg8::f6_q_off(rr, fq)) = qv; } }
#else
        { const int lane = tid & 63; const unsigned char* h2 = a.ws + WS_H2; unsigned char* xe = a.ws + WS_XE + ((size_t)e * BATCH + b) * CAP * DM;
#pragma unroll 4
          for (int c = tid >> 6; c < CAP; c += NWAVES) { const int tok = b * SEQ + ((LAS int*)keys)[c];
              ((GAS v4u*)(xe + (size_t)c * DM))[lane] = ((const GAS v4u*)(h2 + (size_t)tok * DM))[lane]; } }
#endif
        __syncthreads();
    }
}

__device__ __forceinline__ void p8_combine(Frame& F, const Args& a) {
    const int gw = F.vcu * NWAVES + F.wave, NGW = F.G * NWAVES, lane = fresh_lane();
    const bf16* ye = (const bf16*)(a.ws + WS_YE); const int* inv = (const int*)(a.ws + WS_INV); const bf16* x2 = (const bf16*)(a.ws + WS_X2);
    f32x4 gg[4];
#pragma unroll
    for (int j = 0; j < 4; ++j) gg[j] = ((const GAS f32x4*)a.gf + lane)[64 * j];
    v2u xn[4]; int slotn = -1;
    if (gw < NTOK) { const GAS v2u* xs = (const GAS v2u*)(x2 + (size_t)gw * DM) + lane;
#pragma unroll
        for (int j = 0; j < 4; ++j) xn[j] = xs[64 * j];
        slotn = (lane < 16) ? inv[(size_t)gw * 16 + lane] : -1; }
    for (int m = gw; m < NTOK; m += NGW) {
        f32x4 v[4];
#pragma unroll
        for (int j = 0; j < 4; ++j) v[j] = (f32x4){bflo(xn[j].x), bfhi(xn[j].x), bflo(xn[j].y), bfhi(xn[j].y)};
        const int myslot = slotn;
        if (m + NGW < NTOK) { const GAS v2u* xs = (const GAS v2u*)(x2 + (size_t)(m + NGW) * DM) + lane;
#pragma unroll
            for (int j = 0; j < 4; ++j) xn[j] = xs[64 * j];
            slotn = (lane < 16) ? inv[(size_t)(m + NGW) * 16 + lane] : -1; }
        const int b = m >> 12;
        unsigned mask = (unsigned)__ballot(myslot >= 0) & 0xFFFFu;
        while (mask) {
            const int e0 = __builtin_ctz(mask); mask &= mask - 1; const bool two = mask != 0u; const int e1 = two ? __builtin_ctz(mask) : e0; if (two) mask &= mask - 1;
            const int c0 = __builtin_amdgcn_readlane(myslot, e0), c1 = __builtin_amdgcn_readlane(myslot, e1);
            const GAS v2u* y0 = (const GAS v2u*)(ye + ((size_t)(e0 * BATCH + b) * CAP + c0) * DM) + lane; const GAS v2u* y1 = (const GAS v2u*)(ye + ((size_t)(e1 * BATCH + b) * CAP + c1) * DM) + lane;
            v2u w0[4], w1[4];
#pragma unroll
            for (int j = 0; j < 4; ++j) { w0[j] = __builtin_nontemporal_load(y0 + 64 * j); w1[j] = __builtin_nontemporal_load(y1 + 64 * j); }
#pragma unroll
            for (int j = 0; j < 4; ++j) { v[j].x += bflo(w0[j].x); v[j].y += bfhi(w0[j].x); v[j].z += bflo(w0[j].y); v[j].w += bfhi(w0[j].y); }
            if (two) {
#pragma unroll
                for (int j = 0; j < 4; ++j) { v[j].x += bflo(w1[j].x); v[j].y += bfhi(w1[j].x); v[j].z += bflo(w1[j].y); v[j].w += bfhi(w1[j].y); } }
        }
        float s = 0.f;
#pragma unroll
        for (int j = 0; j < 4; ++j) s += (v[j].x * v[j].x + v[j].y * v[j].y) + (v[j].z * v[j].z + v[j].w * v[j].w);
        const float rstd = 1.f / sqrtf(wave_sum(s) * (1.f / DM) + NORM_EPS);
        GAS f32x4* xr = (GAS f32x4*)(a.out + (size_t)m * DM) + lane;
#pragma unroll
        for (int j = 0; j < 4; ++j) __builtin_nontemporal_store(v[j] * rstd * gg[j], xr + 64 * j);
    }
}

namespace att {
#define KSWZ(row, colB) ((row) * 256 + ((colB) ^ (((row) & 7) << 4)))
#define KSWZ16(row, colB) ((row) * 256 + ((colB) ^ (((row) & 15) << 4)))
#define SBAR() __builtin_amdgcn_sched_barrier(0)
constexpr int SHM_V = 16384, SHM_K = 16384;
constexpr int L_V = 0, L_K = 2 * SHM_V, L_WS = 2 * SHM_V + 2 * SHM_K, L_T = L_WS + NWAVES * 256, TOFF = 704, TLEN = 1408;
constexpr int L_X = 0;
constexpr float THR = 8.f;
__device__ __forceinline__ int crow(int r, int hi) { return (r & 3) + 8 * (r >> 2) + 4 * hi; }
typedef float f32x2_t __attribute__((ext_vector_type(2))); typedef __bf16 bf16x2_t __attribute__((ext_vector_type(2)));
__device__ __forceinline__ unsigned cvtpk(float lo, float hi) { const f32x2_t v = {lo, hi}; return __builtin_bit_cast(unsigned, __builtin_convertvector(v, bf16x2_t)); }
__device__ __forceinline__ float fadd_s(float a, float b) { float r; asm("v_add_f32_e32 %0, %1, %2" : "=v"(r) : "v"(a), "v"(b)); return r; }
__device__ __forceinline__ bf16x8 ld8(const bf16* p) { return *reinterpret_cast<const bf16x8*>(p); }

__device__ __forceinline__ void partialSM(f32x16& p0, f32x16& p1, float& m_reg, float& alpha) {
    float mx4[4] = {p0[0], p0[1], p0[2], p0[3]};
#pragma unroll
    for (int r = 4; r < 16; ++r) mx4[r & 3] = fmaxf(mx4[r & 3], p0[r]);
#pragma unroll
    for (int r = 0; r < 16; ++r) mx4[r & 3] = fmaxf(mx4[r & 3], p1[r]);
    float pmax = fmaxf(fmaxf(mx4[0], mx4[1]), fmaxf(mx4[2], mx4[3]));
    { auto rr = __builtin_amdgcn_permlane32_swap(__float_as_uint(pmax), __float_as_uint(pmax), false, false); pmax = fmaxf(__uint_as_float(rr[0]), __uint_as_float(rr[1])); }
    float mn;
    if (__builtin_expect(__all(pmax - m_reg <= THR), 1)) { mn = m_reg; alpha = 1.f; }
    else { mn = fmaxf(m_reg, pmax); alpha = __builtin_amdgcn_exp2f(m_reg - mn); m_reg = mn; }
#pragma unroll
    for (int r = 0; r < 16; ++r) { p0[r] -= mn; p1[r] -= mn; }
#pragma unroll
    for (int r = 0; r < 16; ++r) p0[r] = __builtin_amdgcn_exp2f(p0[r]);
}
__device__ __forceinline__ void finishSM(f32x16& p0, f32x16& p1, float alpha, float& l_reg, bf16x8& pa0, bf16x8& pa1, bf16x8& pa2, bf16x8& pa3) {
#pragma unroll
    for (int r = 0; r < 16; ++r) p1[r] = __builtin_amdgcn_exp2f(p1[r]);
    float ps4[4] = {p0[0], p0[1], p0[2], p0[3]};
#pragma unroll
    for (int r = 4; r < 16; ++r) ps4[r & 3] += p0[r];
#pragma unroll
    for (int r = 0; r < 16; ++r) ps4[r & 3] += p1[r];
    float ps = (ps4[0] + ps4[1]) + (ps4[2] + ps4[3]);
    { auto rr = __builtin_amdgcn_permlane32_swap(__float_as_uint(ps), __float_as_uint(ps), false, false); ps = __uint_as_float(rr[0]) + __uint_as_float(rr[1]); }
    l_reg = l_reg * alpha + ps;
#define PK4(P, BASE, OUT) do { unsigned a0 = cvtpk(P[BASE + 0], P[BASE + 1]), a1 = cvtpk(P[BASE + 2], P[BASE + 3]);   \
    unsigned b0 = cvtpk(P[BASE + 4], P[BASE + 5]), b1 = cvtpk(P[BASE + 6], P[BASE + 7]);                              \
    auto r0 = __builtin_amdgcn_permlane32_swap(a0, b0, false, false); auto r1 = __builtin_amdgcn_permlane32_swap(a1, b1, false, false); \
    v4u w = {r0[0], r1[0], r0[1], r1[1]}; OUT = __builtin_bit_cast(bf16x8, w); } while (0)
    PK4(p0, 0, pa0); PK4(p0, 8, pa1); PK4(p1, 0, pa2); PK4(p1, 8, pa3);
#undef PK4
}
template <int NC4> __device__ __forceinline__ int v_st(int k, int c) { const int kk = (k & ~0xC) | ((k & 4) << 1) | ((k & 8) >> 1); return ((kk >> 3) * NC4 + (c >> 5)) * 512 + ((kk & 7) * 32 + (c & 31)) * 2; }
__device__ __forceinline__ int v_rd_base(int lane) { return ((lane & 3) << 3) | (((lane >> 2) & 3) << 6) | (((lane >> 4) & 1) << 5) | (((lane >> 5) & 1) << 8); }
template <int NC4> constexpr int v_rd_off(int d0, int ks, int half) { return d0 * 512 + ks * (NC4 * 1024) + half * (NC4 * 512); }
template <int OFF> __device__ __forceinline__ s16x4 tr_read(int vb) { s16x4 r; asm volatile("ds_read_b64_tr_b16 %0, %1 offset:%2" : "=&v"(r) : "v"(vb), "i"(OFF) : "memory"); return r; }
template <int NC4, int ND0, int KS> __device__ __forceinline__ void pv_step(f32x16 (&o)[ND0], int vb, bf16x8 pa) {
    s16x4 lo[ND0], hh[ND0];
#pragma unroll
    for (int d0 = 0; d0 < ND0; ++d0) {
        if (d0 == 0) { lo[0] = tr_read<v_rd_off<NC4>(0, KS, 0)>(vb); hh[0] = tr_read<v_rd_off<NC4>(0, KS, 1)>(vb); }
        if (d0 == 1) { lo[1] = tr_read<v_rd_off<NC4>(1, KS, 0)>(vb); hh[1] = tr_read<v_rd_off<NC4>(1, KS, 1)>(vb); }
        if (d0 == 2) { lo[2] = tr_read<v_rd_off<NC4>(2, KS, 0)>(vb); hh[2] = tr_read<v_rd_off<NC4>(2, KS, 1)>(vb); }
        if (d0 == 3) { lo[3] = tr_read<v_rd_off<NC4>(3, KS, 0)>(vb); hh[3] = tr_read<v_rd_off<NC4>(3, KS, 1)>(vb); } }
    asm volatile("s_waitcnt lgkmcnt(0)" ::: "memory"); SBAR();
#pragma unroll
    for (int d0 = 0; d0 < ND0; ++d0) { const bf16x8 vf = (bf16x8){lo[d0][0], lo[d0][1], lo[d0][2], lo[d0][3], hh[d0][0], hh[d0][1], hh[d0][2], hh[d0][3]};
        o[d0] = __builtin_amdgcn_mfma_f32_32x32x16_bf16(pa, vf, o[d0], 0, 0, 0); }
}
template <int NC4, int ND0> __device__ __forceinline__ void pv_all(f32x16 (&o)[ND0], int vb, bf16x8 pa0, bf16x8 pa1, bf16x8 pa2, bf16x8 pa3) {
    pv_step<NC4, ND0, 0>(o, vb, pa0); pv_step<NC4, ND0, 1>(o, vb, pa1); pv_step<NC4, ND0, 2>(o, vb, pa2); pv_step<NC4, ND0, 3>(o, vb, pa3);
}

__device__ __forceinline__ void diff_unit(const bf16* __restrict__ proj, bf16* __restrict__ attn, const float* relb, const float* subln, float lam, int b, int h, int qb,
                                          LAS unsigned char* lds, int tid) {
    const int wid = __builtin_amdgcn_readfirstlane(tid >> 6), lane = tid & 63, r32 = lane & 31, hi = lane >> 5, sub = wid >> 2, wq = wid & 3;
    LAS unsigned char* V_lds = lds + L_V; LAS unsigned char* K_lds = lds + L_K;
    LAS float* wsf = (LAS float*)(lds + L_WS) + wid * 64; LAS float* li_l = wsf; LAS float* al_l = wsf + 32;
    LAS float* T = (LAS float*)(lds + L_T);
    for (int i = tid; i < TLEN; i += NWAVES * 64) T[i] = relb[(unsigned)(t5_bucket(i - TOFF) * 12 + h)] * LOG2E;
    const float cneg = relb[15 * 12 + h] * LOG2E, cpos = relb[31 * 12 + h] * LOG2E;
    const size_t rowb = (size_t)b * SEQ;
    const int q0w = qb * 128 + wq * 32;
    const bf16* Kh = proj + rowb * NIN + COL_KA + h * 128; const bf16* Vh = proj + rowb * NIN + COL_VA + h * 128;
    float m_reg = -1e30f, l_reg = 0.f; f32x16 o[4]; bf16x8 qr[4];
#pragma unroll
    for (int d = 0; d < 4; ++d) o[d] = f32x16{};
    { const bf16* Qw = proj + (rowb + q0w + r32) * NIN + COL_QA + h * 128 + sub * 64 + hi * 8;
#pragma unroll
      for (int d0 = 0; d0 < 4; ++d0) qr[d0] = ld8(Qw + d0 * 16); }
    const int sr = tid >> 4, sc = (tid & 15) * 8, vst0 = v_st<4>(sr, sc), vst1 = v_st<4>(32 + sr, sc);
    const int vb0 = (int)(unsigned)(uintptr_t)V_lds + v_rd_base(lane);
    struct { bf16x8 vs0, vs1, ks0, ks1; } sr_[2];
#define SLOAD(i, k0) do { sr_[i].vs0 = ld8(&Vh[(size_t)((k0) + sr) * NIN + sc]); sr_[i].vs1 = ld8(&Vh[(size_t)((k0) + 32 + sr) * NIN + sc]); \
    sr_[i].ks0 = ld8(&Kh[(size_t)((k0) + sr) * NIN + sc]); sr_[i].ks1 = ld8(&Kh[(size_t)((k0) + 32 + sr) * NIN + sc]); } while (0)
#define SWRITE(bb, i) do { *(LAS bf16x8*)(V_lds + (bb) * SHM_V + vst0) = sr_[i].vs0; *(LAS bf16x8*)(V_lds + (bb) * SHM_V + vst1) = sr_[i].vs1; const int kc = sc * 2; \
    *(LAS bf16x8*)(K_lds + (bb) * SHM_K + KSWZ(sr, kc)) = sr_[i].ks0; *(LAS bf16x8*)(K_lds + (bb) * SHM_K + KSWZ(32 + sr, kc)) = sr_[i].ks1; } while (0)
#define SWAIT() asm volatile("s_waitcnt vmcnt(4)" ::: "memory")
#define RESC(a_) do { if (__any((a_) < 1.f)) { if (hi == 0) al_l[r32] = (a_); asm volatile("s_waitcnt lgkmcnt(0)" ::: "memory"); \
    _Pragma("unroll") for (int d = 0; d < 4; ++d) _Pragma("unroll") for (int r = 0; r < 16; ++r) o[d][r] *= al_l[crow(r, hi)]; } } while (0)
#define BINIT(P0, P1, kv0) do { const int d_ = (kv0) - q0w; \
    if (d_ > -622 && d_ < 590) { const LAS float* tp = T + (d_ - r32 + 4 * hi + TOFF); \
        _Pragma("unroll") for (int r = 0; r < 16; ++r) { P0[r] = tp[(r & 3) + 8 * (r >> 2)]; P1[r] = tp[32 + (r & 3) + 8 * (r >> 2)]; } } \
    else { const float c_ = d_ < 0 ? cneg : cpos; _Pragma("unroll") for (int r = 0; r < 16; ++r) { P0[r] = c_; P1[r] = c_; } } } while (0)
#define QKT(P0, P1, Ks) do { _Pragma("unroll") for (int d0 = 0; d0 < 4; ++d0) { const int cb = (sub * 64 + d0 * 16 + hi * 8) * 2; \
    const bf16x8 b0 = *(const LAS bf16x8*)((Ks) + KSWZ(r32, cb)); const bf16x8 b1 = *(const LAS bf16x8*)((Ks) + KSWZ(32 + r32, cb)); \
    P0 = __builtin_amdgcn_mfma_f32_32x32x16_bf16(b0, qr[d0], P0, 0, 0, 0); P1 = __builtin_amdgcn_mfma_f32_32x32x16_bf16(b1, qr[d0], P1, 0, 0, 0); } } while (0)
#define PVD0(vb) pv_all<4, 4>(o, vb, pa0, pa1, pa2, pa3)
    f32x16 pA0, pA1, pB0, pB1; float alA, alB; bf16x8 pa0, pa1, pa2, pa3; constexpr int NT = SEQ / 64;
    SLOAD(0, 0); asm volatile("s_waitcnt vmcnt(0)" ::: "memory"); SWRITE(0, 0); __syncthreads();
    BINIT(pA0, pA1, 0); QKT(pA0, pA1, K_lds); partialSM(pA0, pA1, m_reg, alA);
    SLOAD(1, 64); SLOAD(0, 128);
    SWAIT(); SWRITE(1, 1); __syncthreads();
#pragma unroll 1
    for (int j = 1; j + 1 < NT; j += 2) {
        SBAR(); BINIT(pB0, pB1, j * 64); QKT(pB0, pB1, K_lds + SHM_K);
        finishSM(pA0, pA1, alA, l_reg, pa0, pa1, pa2, pa3); SBAR();
        SLOAD(1, (j + 2) * 64); SBAR();
        PVD0(vb0); partialSM(pB0, pB1, m_reg, alB);
        __syncthreads(); SWAIT(); SWRITE(0, 0);
        RESC(alB); __syncthreads();
        SBAR(); BINIT(pA0, pA1, (j + 1) * 64); QKT(pA0, pA1, K_lds);
        finishSM(pB0, pB1, alB, l_reg, pa0, pa1, pa2, pa3); SBAR();
        if (j + 3 < NT) SLOAD(0, (j + 3) * 64); SBAR();
        PVD0(vb0 + SHM_V); partialSM(pA0, pA1, m_reg, alA);
        __syncthreads(); SWAIT(); SWRITE(1, 1);
        RESC(alA); __syncthreads();
    }
    SBAR(); BINIT(pB0, pB1, (NT - 1) * 64); QKT(pB0, pB1, K_lds + SHM_K);
    finishSM(pA0, pA1, alA, l_reg, pa0, pa1, pa2, pa3); SBAR();
    PVD0(vb0); partialSM(pB0, pB1, m_reg, alB);
    __syncthreads(); RESC(alB);
    finishSM(pB0, pB1, alB, l_reg, pa0, pa1, pa2, pa3); SBAR();
    PVD0(vb0 + SHM_V);
    if (hi == 0) li_l[r32] = l_reg; asm volatile("s_waitcnt lgkmcnt(0)" ::: "memory");
    float rli[16];
#pragma unroll
    for (int r = 0; r < 16; ++r) rli[r] = __builtin_amdgcn_rcpf(li_l[crow(r, hi)]);
    __syncthreads();
    LAS float* X = (LAS float*)(lds + L_X) + (size_t)wq * 4096 + lane;
    if (sub == 1) {
#pragma unroll
        for (int d0 = 0; d0 < 4; ++d0)
#pragma unroll
            for (int r = 0; r < 16; ++r) X[(d0 * 16 + r) * 64] = o[d0][r] * rli[r] * (-lam);
    }
    __syncthreads();
    if (sub == 0) {
        float ss[16];
#pragma unroll
        for (int r = 0; r < 16; ++r) ss[r] = 0.f;
#pragma unroll
        for (int d0 = 0; d0 < 4; ++d0)
#pragma unroll
            for (int r = 0; r < 16; ++r) { const float v = o[d0][r] * rli[r] + X[(d0 * 16 + r) * 64]; o[d0][r] = v; ss[r] += v * v; }
#pragma unroll
        for (int r = 0; r < 16; ++r) {
#pragma unroll
            for (int msk = 1; msk < 32; msk <<= 1) ss[r] += __shfl_xor(ss[r], msk);
            ss[r] = (1.f - LAMBDA_INIT) / sqrtf(ss[r] * (1.f / 128.f) + SUBLN_EPS); }
        float gsub[4];
#pragma unroll
        for (int d0 = 0; d0 < 4; ++d0) gsub[d0] = subln[d0 * 32 + r32];
        bf16* Ow = attn + (rowb + q0w) * DM + h * 128 + r32;
#pragma unroll
        for (int r = 0; r < 16; ++r) { const int orow = crow(r, hi);
#pragma unroll
            for (int d0 = 0; d0 < 4; ++d0) Ow[(size_t)orow * DM + d0 * 32] = (bf16)f2bf(o[d0][r] * ss[r] * gsub[d0]); }
    }
    __syncthreads();
#undef SLOAD
#undef SWRITE
#undef SWAIT
#undef RESC
#undef BINIT
#undef QKT
#undef PVD0
}

constexpr int D2_SLOT = 16384, D2_K = 0, D2_V = 3 * D2_SLOT, D2_WS = 6 * D2_SLOT, D2_T = D2_WS + NWAVES * 256;
static_assert(D2_T + TLEN * 4 <= RING_BYTES, "diff v2 LDS map");
#define D2_WAIT_BAR(N) asm volatile("s_waitcnt vmcnt(" #N ") lgkmcnt(0)\n\ts_barrier" ::: "memory")
__device__ __forceinline__ void softmax2(f32x16& p0, f32x16& p1, float& m_run, float& l_reg, bool first, float& alpha, bf16x8& pa0, bf16x8& pa1, bf16x8& pa2, bf16x8& pa3) {
    float mx4[4] = {p0[0], p0[1], p0[2], p0[3]};
#pragma unroll
    for (int r = 4; r < 16; ++r) mx4[r & 3] = fmaxf(mx4[r & 3], p0[r]);
#pragma unroll
    for (int r = 0; r < 16; ++r) mx4[r & 3] = fmaxf(mx4[r & 3], p1[r]);
    float pmax = fmaxf(fmaxf(mx4[0], mx4[1]), fmaxf(mx4[2], mx4[3]));
    { auto rr = __builtin_amdgcn_permlane32_swap(__float_as_uint(pmax), __float_as_uint(pmax), false, false); pmax = fmaxf(__uint_as_float(rr[0]), __uint_as_float(rr[1])); }
    alpha = 1.f;
    if (__builtin_expect(first || !__all(pmax <= THR), 0)) {
        const float delta = first ? pmax : fmaxf(pmax, 0.f);
        m_run += delta; alpha = first ? 1.f : __builtin_amdgcn_exp2f(-delta);
#pragma unroll
        for (int r = 0; r < 16; ++r) { p0[r] -= delta; p1[r] -= delta; }
    }
#pragma unroll
    for (int r = 0; r < 16; ++r) { p0[r] = __builtin_amdgcn_exp2f(p0[r]); p1[r] = __builtin_amdgcn_exp2f(p1[r]); }
    float ps4[4];
#pragma unroll
    for (int c = 0; c < 4; ++c) { float a_ = p0[4 * c] + p0[4 * c + 1]; a_ += p0[4 * c + 2]; a_ += p0[4 * c + 3]; a_ += p1[4 * c]; a_ += p1[4 * c + 1]; a_ += p1[4 * c + 2]; a_ += p1[4 * c + 3]; ps4[c] = a_; }
    float ps = (ps4[0] + ps4[1]) + (ps4[2] + ps4[3]);
    { auto rr = __builtin_amdgcn_permlane32_swap(__float_as_uint(ps), __float_as_uint(ps), false, false); ps = __uint_as_float(rr[0]) + __uint_as_float(rr[1]); }
    l_reg = l_reg * alpha + ps;
#define PK4(P, BASE, OUT) do { unsigned a0 = cvtpk(P[BASE + 0], P[BASE + 1]), a1 = cvtpk(P[BASE + 2], P[BASE + 3]);   \
    unsigned b0 = cvtpk(P[BASE + 4], P[BASE + 5]), b1 = cvtpk(P[BASE + 6], P[BASE + 7]);                              \
    auto r0 = __builtin_amdgcn_permlane32_swap(a0, b0, false, false); auto r1 = __builtin_amdgcn_permlane32_swap(a1, b1, false, false); \
    v4u w = {r0[0], r1[0], r0[1], r1[1]}; OUT = __builtin_bit_cast(bf16x8, w); } while (0)
    PK4(p0, 0, pa0); PK4(p0, 8, pa1); PK4(p1, 0, pa2); PK4(p1, 8, pa3);
#undef PK4
}
struct VFrag { s16x4 l0, h0, l1, h1; };
template <int KS, int DP> __device__ __forceinline__ void pv2_read(VFrag& f, int vb) {
    f.l0 = tr_read<v_rd_off<4>(2 * DP, KS, 0)>(vb); f.h0 = tr_read<v_rd_off<4>(2 * DP, KS, 1)>(vb); f.l1 = tr_read<v_rd_off<4>(2 * DP + 1, KS, 0)>(vb); f.h1 = tr_read<v_rd_off<4>(2 * DP + 1, KS, 1)>(vb);
}
template <int DP> __device__ __forceinline__ void pv2_mma(f32x16 (&o1)[4], f32x16 (&o2)[4], const VFrag& f, bf16x8 pa, bf16x8 pb) {
#define PK(L, H) (bf16x8){L[0], L[1], L[2], L[3], H[0], H[1], H[2], H[3]}
    const bf16x8 v0 = PK(f.l0, f.h0), v1 = PK(f.l1, f.h1);
#undef PK
    o1[2 * DP] = __builtin_amdgcn_mfma_f32_32x32x16_bf16(pa, v0, o1[2 * DP], 0, 0, 0); o1[2 * DP + 1] = __builtin_amdgcn_mfma_f32_32x32x16_bf16(pa, v1, o1[2 * DP + 1], 0, 0, 0);
    o2[2 * DP] = __builtin_amdgcn_mfma_f32_32x32x16_bf16(pb, v0, o2[2 * DP], 0, 0, 0); o2[2 * DP + 1] = __builtin_amdgcn_mfma_f32_32x32x16_bf16(pb, v1, o2[2 * DP + 1], 0, 0, 0);
}
#define PV2_W4() do { asm volatile("s_waitcnt lgkmcnt(4)" ::: "memory"); SBAR(); } while (0)
__device__ __forceinline__ void pv2_all(f32x16 (&o1)[4], f32x16 (&o2)[4], int vb, const bf16x8 (&pa)[4], const bf16x8 (&pb)[4]) {
    VFrag fa, fb;
    pv2_read<0, 0>(fa, vb);
    pv2_read<0, 1>(fb, vb); PV2_W4(); pv2_mma<0>(o1, o2, fa, pa[0], pb[0]); SBAR();
    pv2_read<1, 0>(fa, vb); PV2_W4(); pv2_mma<1>(o1, o2, fb, pa[0], pb[0]); SBAR();
    pv2_read<1, 1>(fb, vb); PV2_W4(); pv2_mma<0>(o1, o2, fa, pa[1], pb[1]); SBAR();
    pv2_read<2, 0>(fa, vb); PV2_W4(); pv2_mma<1>(o1, o2, fb, pa[1], pb[1]); SBAR();
    pv2_read<2, 1>(fb, vb); PV2_W4(); pv2_mma<0>(o1, o2, fa, pa[2], pb[2]); SBAR();
    pv2_read<3, 0>(fa, vb); PV2_W4(); pv2_mma<1>(o1, o2, fb, pa[2], pb[2]); SBAR();
    pv2_read<3, 1>(fb, vb); PV2_W4(); pv2_mma<0>(o1, o2, fa, pa[3], pb[3]); SBAR();
    asm volatile("s_waitcnt lgkmcnt(0)" ::: "memory"); SBAR(); pv2_mma<1>(o1, o2, fb, pa[3], pb[3]);
}
#undef PV2_W4
__device__ __forceinline__ void diff_unit2(const bf16* __restrict__ proj, bf16* __restrict__ attn, const float* relb, const float* subln, float lam, int b, int h, int qb,
                                           LAS unsigned char* lds, int tid_in) {
    int tid = tid_in; asm volatile("" : "+v"(tid));
    const int wid = __builtin_amdgcn_readfirstlane(tid >> 6), lane = tid & 63, r32 = lane & 31, hi = lane >> 5;
    LAS float* wsf = (LAS float*)(lds + D2_WS) + wid * 64; LAS float* T = (LAS float*)(lds + D2_T);
    for (int i = tid; i < TLEN; i += NWAVES * 64) T[i] = relb[(unsigned)(t5_bucket(i - TOFF) * 12 + h)] * LOG2E;
    const float cneg = __builtin_bit_cast(float, __builtin_amdgcn_readfirstlane(__builtin_bit_cast(int, relb[15 * 12 + h] * LOG2E))), cpos = __builtin_bit_cast(float, __builtin_amdgcn_readfirstlane(__builtin_bit_cast(int, relb[31 * 12 + h] * LOG2E)));
    const size_t rowb = (size_t)b * SEQ;
    const int q0w = qb * 256 + wid * 32;
    const bf16* Kh = proj + rowb * NIN + COL_KA + h * 128; const bf16* Vh = proj + rowb * NIN + COL_VA + h * 128;
    unsigned kofs, vofs;
    { const int pc = 2 * wid;
        const int rK = 4 * pc + (lane >> 4), cK = (lane & 15) ^ (rK & 15); kofs = (unsigned)(rK * NIN + cK * 8);
        const int sV = 2 * pc + (lane >> 5), kk = (sV >> 2) * 8 + ((lane & 31) >> 2), kV = (kk & ~0xC) | ((kk & 4) << 1) | ((kk & 8) >> 1), cV = (sV & 3) * 32 + (lane & 3) * 8;
        vofs = (unsigned)(kV * NIN + cV); }
#define D2_DMA(t, slot) do { const bf16* kt_ = Kh + (size_t)(t) * 64 * NIN; const bf16* vt_ = Vh + (size_t)(t) * 64 * NIN; \
    __builtin_amdgcn_global_load_lds((const unsigned*)(kt_ + kofs), (LAS unsigned*)(lds + D2_K + (slot) + (2 * wid) * 1024), 16, 0, 0); \
    __builtin_amdgcn_global_load_lds((const unsigned*)(kt_ + ((kofs ^ 32u) + 4u * NIN)), (LAS unsigned*)(lds + D2_K + (slot) + (2 * wid + 1) * 1024), 16, 0, 0); \
    __builtin_amdgcn_global_load_lds((const unsigned*)(vt_ + vofs), (LAS unsigned*)(lds + D2_V + (slot) + (2 * wid) * 1024), 16, 0, 0); \
    __builtin_amdgcn_global_load_lds((const unsigned*)(vt_ + (vofs + 64u)), (LAS unsigned*)(lds + D2_V + (slot) + (2 * wid + 1) * 1024), 16, 0, 0); } while (0)
    bf16x8 qr[8];
    { const bf16* Qu = proj + (rowb + q0w) * NIN + COL_QA + h * 128; const unsigned qo = (unsigned)(r32 * NIN + hi * 8);
#pragma unroll
      for (int d0 = 0; d0 < 8; ++d0) qr[d0] = ld8(Qu + (qo + d0 * 16)); }
    D2_DMA(0, 0); D2_DMA(1, D2_SLOT);
    f32x16 o1[4], o2[4];
#pragma unroll
    for (int d = 0; d < 4; ++d) { o1[d] = f32x16{}; o2[d] = f32x16{}; }
    float m_run[2] = {0.f, 0.f}, l_reg[2] = {0.f, 0.f};
    const int vbase = (int)(unsigned)(uintptr_t)(lds + D2_V) + v_rd_base(lane);
    constexpr int NT = SEQ / 64;
    int sl_cur = 0, sl_nxt2 = 2 * D2_SLOT;
#pragma unroll 1
    for (int j = 0; j < NT; ++j) {
        if (j + 1 < NT) D2_WAIT_BAR(4); else D2_WAIT_BAR(0);
        if (j + 2 < NT) D2_DMA(j + 2, sl_nxt2);
        const LAS unsigned char* Ks = lds + D2_K + sl_cur;
        const int d_ = j * 64 - q0w; const bool near = d_ > -622 && d_ < 590; const float cfar = d_ < 0 ? cneg : cpos; const bool first = (j == 0);
        const LAS float* tp = T + (d_ - r32 + 4 * hi + TOFF);
        bf16x8 pa[2][4]; float alpha[2];
#pragma unroll
        for (int s2 = 0; s2 < 2; ++s2) {
            f32x16 p0, p1;
            if (near) {
#pragma unroll
                for (int r = 0; r < 16; ++r) { p0[r] = tp[(r & 3) + 8 * (r >> 2)] - m_run[s2]; p1[r] = tp[32 + (r & 3) + 8 * (r >> 2)] - m_run[s2]; } }
            else { const float c_ = cfar - m_run[s2];
#pragma unroll
                for (int r = 0; r < 16; ++r) { p0[r] = c_; p1[r] = c_; } }
#pragma unroll
            for (int d0 = 0; d0 < 4; ++d0) { const int cb = ((4 * s2 + d0) * 16 + hi * 8) * 2;
                const bf16x8 b0 = *(const LAS bf16x8*)(Ks + KSWZ16(r32, cb)); const bf16x8 b1 = *(const LAS bf16x8*)(Ks + KSWZ16(32 + r32, cb));
                p0 = __builtin_amdgcn_mfma_f32_32x32x16_bf16(b0, qr[4 * s2 + d0], p0, 0, 0, 0); p1 = __builtin_amdgcn_mfma_f32_32x32x16_bf16(b1, qr[4 * s2 + d0], p1, 0, 0, 0); }
            softmax2(p0, p1, m_run[s2], l_reg[s2], first, alpha[s2], pa[s2][0], pa[s2][1], pa[s2][2], pa[s2][3]);
            SBAR();
        }
        if (__any(alpha[0] < 1.f)) { if (hi == 0) wsf[r32] = alpha[0]; asm volatile("s_waitcnt lgkmcnt(0)" ::: "memory");
#pragma unroll
            for (int d = 0; d < 4; ++d)
#pragma unroll
                for (int r = 0; r < 16; ++r) o1[d][r] *= wsf[crow(r, hi)]; }
        if (__any(alpha[1] < 1.f)) { if (hi == 0) wsf[32 + r32] = alpha[1]; asm volatile("s_waitcnt lgkmcnt(0)" ::: "memory");
#pragma unroll
            for (int d = 0; d < 4; ++d)
#pragma unroll
                for (int r = 0; r < 16; ++r) o2[d][r] *= wsf[32 + crow(r, hi)]; }
        const int vb = vbase + sl_cur;
        asm volatile("s_waitcnt lgkmcnt(0)" ::: "memory"); SBAR();
        pv2_all(o1, o2, vb, pa[0], pa[1]);
        sl_cur = (sl_cur == 2 * D2_SLOT) ? 0 : sl_cur + D2_SLOT; sl_nxt2 = (sl_nxt2 == 2 * D2_SLOT) ? 0 : sl_nxt2 + D2_SLOT;
    }
    asm volatile("s_waitcnt lgkmcnt(0)\n\ts_barrier" ::: "memory");
    int lane2; asm volatile("v_mbcnt_lo_u32_b32 %0, -1, 0\n\tv_mbcnt_hi_u32_b32 %0, -1, %0" : "=v"(lane2));
    const int r32e = lane2 & 31, hie = lane2 >> 5;
    LAS float* wse = (LAS float*)(lds + D2_WS) + wid * 64;
    if (hie == 0) { wse[r32e] = l_reg[0]; wse[32 + r32e] = l_reg[1]; }
    asm volatile("s_waitcnt lgkmcnt(0)" ::: "memory");
    float ss[16];
    int nlb = __builtin_amdgcn_readfirstlane(__builtin_bit_cast(int, lam)) ^ (int)0x80000000u; asm volatile("" : "+s"(nlb)); const float nlam = __builtin_bit_cast(float, nlb);
#pragma unroll
    for (int r = 0; r < 16; ++r) { const float ra = __builtin_amdgcn_rcpf(wse[crow(r, hie)]), rb = nlam * __builtin_amdgcn_rcpf(wse[32 + crow(r, hie)]); float acc = 0.f;
#pragma unroll
        for (int d0 = 0; d0 < 4; ++d0) { const float v = o1[d0][r] * ra + o2[d0][r] * rb; o1[d0][r] = v; acc += v * v; }
        ss[r] = acc; }
#pragma unroll
    for (int r = 0; r < 16; ++r) {
#pragma unroll
        for (int msk = 1; msk < 32; msk <<= 1) ss[r] += __builtin_bit_cast(float, __builtin_amdgcn_ds_bpermute((lane2 ^ msk) << 2, __builtin_bit_cast(int, ss[r])));
        ss[r] = (1.f - LAMBDA_INIT) * __builtin_amdgcn_rsqf(ss[r] * (1.f / 128.f) + SUBLN_EPS); }
    float gsub[4];
#pragma unroll
    for (int d0 = 0; d0 < 4; ++d0) gsub[d0] = subln[d0 * 32 + r32e];
    bf16* Ou = attn + (rowb + q0w) * DM + h * 128;
#pragma unroll
    for (int r = 0; r < 16; ++r) { const unsigned oo = (unsigned)(crow(r, hie) * DM + r32e);
#pragma unroll
        for (int d0 = 0; d0 < 4; d0 += 2) { const unsigned pk = cvtpk(o1[d0][r] * ss[r] * gsub[d0], o1[d0 + 1][r] * ss[r] * gsub[d0 + 1]); Ou[oo + d0 * 32] = (bf16)(pk & 0xffffu); Ou[oo + d0 * 32 + 32] = (bf16)(pk >> 16); } }
#undef D2_DMA
}

constexpr int D3_K = 0, D3_V = 4 * D2_SLOT, D3_WS = RING_BYTES + 1024, D3_T = D3_WS + NWAVES * 256, D3_FLAG = D3_T + TLEN * 4;
static_assert(D3_V + 4 * D2_SLOT <= RING_BYTES && D3_FLAG + 4 <= LDS_BYTES, "diff v3 LDS map");
__device__ __forceinline__ void softmax3(f32x16& p0, f32x16& p1, float& l_reg, bf16x8& pa0, bf16x8& pa1, bf16x8& pa2, bf16x8& pa3) {
#pragma unroll
    for (int r = 0; r < 16; ++r) { p0[r] = __builtin_amdgcn_exp2f(p0[r]); p1[r] = __builtin_amdgcn_exp2f(p1[r]); }
    float ps4[4];
#pragma unroll
    for (int c = 0; c < 4; ++c) { float a_ = p0[4 * c] + p0[4 * c + 1]; a_ += p0[4 * c + 2]; a_ += p0[4 * c + 3]; a_ += p1[4 * c]; a_ += p1[4 * c + 1]; a_ += p1[4 * c + 2]; a_ += p1[4 * c + 3]; ps4[c] = a_; }
    float ps = (ps4[0] + ps4[1]) + (ps4[2] + ps4[3]);
    { auto rr = __builtin_amdgcn_permlane32_swap(__float_as_uint(ps), __float_as_uint(ps), false, false); ps = __uint_as_float(rr[0]) + __uint_as_float(rr[1]); }
    l_reg += ps;
#define PK4(P, BASE, OUT) do { unsigned a0 = cvtpk(P[BASE + 0], P[BASE + 1]), a1 = cvtpk(P[BASE + 2], P[BASE + 3]);   \
    unsigned b0 = cvtpk(P[BASE + 4], P[BASE + 5]), b1 = cvtpk(P[BASE + 6], P[BASE + 7]);                              \
    auto r0 = __builtin_amdgcn_permlane32_swap(a0, b0, false, false); auto r1 = __builtin_amdgcn_permlane32_swap(a1, b1, false, false); \
    v4u w = {r0[0], r1[0], r0[1], r1[1]}; OUT = __builtin_bit_cast(bf16x8, w); } while (0)
    PK4(p0, 0, pa0); PK4(p0, 8, pa1); PK4(p1, 0, pa2); PK4(p1, 8, pa3);
#undef PK4
}
__device__ __forceinline__ bool diff_unit3(const bf16* __restrict__ proj, bf16* __restrict__ attn, const float* relb, const float* subln, float lam, int b, int h, int qb,
                                           LAS unsigned char* lds, int tid_in) {
    int tid = tid_in; asm volatile("" : "+v"(tid));
    const int wid = __builtin_amdgcn_readfirstlane(tid >> 6), lane = tid & 63, r32 = lane & 31, hi = lane >> 5;
    LAS float* wsf = (LAS float*)(lds + D3_WS) + wid * 64; LAS float* T = (LAS float*)(lds + D3_T);
    const float cneg = __builtin_bit_cast(float, __builtin_amdgcn_readfirstlane(__builtin_bit_cast(int, relb[15 * 12 + h] * LOG2E))), cpos = __builtin_bit_cast(float, __builtin_amdgcn_readfirstlane(__builtin_bit_cast(int, relb[31 * 12 + h] * LOG2E)));
    const size_t rowb = (size_t)b * SEQ;
    const int q0w = qb * 256 + wid * 32;
    const bool refneg = (qb >= 8);
    const float cref = refneg ? cneg : cpos, cother = (refneg ? cpos : cneg) - cref;
    for (int i = tid; i < TLEN; i += NWAVES * 64) T[i] = relb[(unsigned)(t5_bucket(i - TOFF) * 12 + h)] * LOG2E - cref;
    if (tid == 0) *(LAS unsigned*)(lds + D3_FLAG) = 0u;
    const bf16* Kh = proj + rowb * NIN + COL_KA + h * 128; const bf16* Vh = proj + rowb * NIN + COL_VA + h * 128;
    unsigned kofs, vofs;
    { const int pc = 2 * wid;
        const int rK = 4 * pc + (lane >> 4), cK = (lane & 15) ^ (rK & 15); kofs = (unsigned)(rK * NIN + cK * 8);
        const int sV = 2 * pc + (lane >> 5), kk = (sV >> 2) * 8 + ((lane & 31) >> 2), kV = (kk & ~0xC) | ((kk & 4) << 1) | ((kk & 8) >> 1), cV = (sV & 3) * 32 + (lane & 3) * 8;
        vofs = (unsigned)(kV * NIN + cV); }
#define D2_DMA(t, slot) do { const bf16* kt_ = Kh + (size_t)(t) * 64 * NIN; const bf16* vt_ = Vh + (size_t)(t) * 64 * NIN; \
    __builtin_amdgcn_global_load_lds((const unsigned*)(kt_ + kofs), (LAS unsigned*)(lds + D3_K + (slot) + (2 * wid) * 1024), 16, 0, 0); \
    __builtin_amdgcn_global_load_lds((const unsigned*)(kt_ + ((kofs ^ 32u) + 4u * NIN)), (LAS unsigned*)(lds + D3_K + (slot) + (2 * wid + 1) * 1024), 16, 0, 0); \
    __builtin_amdgcn_global_load_lds((const unsigned*)(vt_ + vofs), (LAS unsigned*)(lds + D3_V + (slot) + (2 * wid) * 1024), 16, 0, 0); \
    __builtin_amdgcn_global_load_lds((const unsigned*)(vt_ + (vofs + 64u)), (LAS unsigned*)(lds + D3_V + (slot) + (2 * wid + 1) * 1024), 16, 0, 0); } while (0)
    bf16x8 qr[8];
    { const bf16* Qu = proj + (rowb + q0w) * NIN + COL_QA + h * 128; const unsigned qo = (unsigned)(r32 * NIN + hi * 8);
#pragma unroll
      for (int d0 = 0; d0 < 8; ++d0) qr[d0] = ld8(Qu + (qo + d0 * 16)); }
    D2_DMA(0, 0); D2_DMA(1, D2_SLOT);
    f32x16 o1[4], o2[4];
#pragma unroll
    for (int d = 0; d < 4; ++d) { o1[d] = f32x16{}; o2[d] = f32x16{}; }
    float l_reg[2] = {0.f, 0.f};
    const int vbase = (int)(unsigned)(uintptr_t)(lds + D3_V) + v_rd_base(lane);
    constexpr int NT = SEQ / 64;
    bf16x8 pa[2][4];
#define D3_SM(jj, slk) do { const LAS unsigned char* Ks = lds + D3_K + (slk); \
        const int d_ = (jj) * 64 - q0w; const bool near = d_ > -622 && d_ < 590; const bool zero_init = !near && ((d_ < 0) == refneg); \
        const LAS float* tp = T + (d_ - r32 + 4 * hi + TOFF); \
        _Pragma("unroll") for (int s2 = 0; s2 < 2; ++s2) { \
            f32x16 p0, p1; \
            if (zero_init) { p0 = f32x16{}; p1 = f32x16{}; } \
            else if (near) { _Pragma("unroll") for (int r = 0; r < 16; ++r) { p0[r] = tp[(r & 3) + 8 * (r >> 2)]; p1[r] = tp[32 + (r & 3) + 8 * (r >> 2)]; } } \
            else { _Pragma("unroll") for (int r = 0; r < 16; ++r) { p0[r] = cother; p1[r] = cother; } } \
            _Pragma("unroll") for (int d0 = 0; d0 < 4; ++d0) { const int cb = ((4 * s2 + d0) * 16 + hi * 8) * 2; \
                const bf16x8 b0 = *(const LAS bf16x8*)(Ks + KSWZ16(r32, cb)); const bf16x8 b1 = *(const LAS bf16x8*)(Ks + KSWZ16(32 + r32, cb)); \
                p0 = __builtin_amdgcn_mfma_f32_32x32x16_bf16(b0, qr[4 * s2 + d0], p0, 0, 0, 0); p1 = __builtin_amdgcn_mfma_f32_32x32x16_bf16(b1, qr[4 * s2 + d0], p1, 0, 0, 0); } \
            softmax3(p0, p1, l_reg[s2], pa[s2][0], pa[s2][1], pa[s2][2], pa[s2][3]); \
            SBAR(); } } while (0)
#define D3_PV(slv) do { asm volatile("s_waitcnt lgkmcnt(0)" ::: "memory"); SBAR(); pv2_all(o1, o2, vbase + (slv), pa[0], pa[1]); SBAR(); } while (0)
#define D3_NEXT(x) ((x) == 3 * D2_SLOT ? 0 : (x) + D2_SLOT)
    int sl_prev = 3 * D2_SLOT, sl_cur = 0, sl_nxt2 = 2 * D2_SLOT;
    if (wid < 4) {
#pragma unroll 1
        for (int j = 0; j < NT; ++j) {
            if (j + 1 < NT) D2_WAIT_BAR(4); else D2_WAIT_BAR(0);
            if (j + 2 < NT) D2_DMA(j + 2, sl_nxt2);
            D3_SM(j, sl_cur);
            D3_PV(sl_cur);
            sl_cur = D3_NEXT(sl_cur); sl_nxt2 = D3_NEXT(sl_nxt2);
        }
    } else {
#pragma unroll 1
        for (int j = 0; j < NT; ++j) {
            if (j + 1 < NT) D2_WAIT_BAR(4); else D2_WAIT_BAR(0);
            if (j + 2 < NT) D2_DMA(j + 2, sl_nxt2);
            if (j >= 1) D3_PV(sl_prev);
            D3_SM(j, sl_cur);
            sl_prev = sl_cur; sl_cur = D3_NEXT(sl_cur); sl_nxt2 = D3_NEXT(sl_nxt2);
        }
        D3_PV(sl_prev);
    }
#undef D3_SM
#undef D3_PV
#undef D3_NEXT
    if (!((l_reg[0] > 1e-30f) && (l_reg[0] < 1e30f) && (l_reg[1] > 1e-30f) && (l_reg[1] < 1e30f))) *(LAS unsigned*)(lds + D3_FLAG) = 1u;
    asm volatile("s_waitcnt lgkmcnt(0)\n\ts_barrier" ::: "memory");
    const bool good = (*(const LAS unsigned*)(lds + D3_FLAG) == 0u);
    int lane2; asm volatile("v_mbcnt_lo_u32_b32 %0, -1, 0\n\tv_mbcnt_hi_u32_b32 %0, -1, %0" : "=v"(lane2));
    const int r32e = lane2 & 31, hie = lane2 >> 5;
    LAS float* wse = (LAS float*)(lds + D3_WS) + wid * 64;
    if (hie == 0) { wse[r32e] = l_reg[0]; wse[32 + r32e] = l_reg[1]; }
    asm volatile("s_waitcnt lgkmcnt(0)" ::: "memory");
    float ss[16];
    int nlb = __builtin_amdgcn_readfirstlane(__builtin_bit_cast(int, lam)) ^ (int)0x80000000u; asm volatile("" : "+s"(nlb)); const float nlam = __builtin_bit_cast(float, nlb);
#pragma unroll
    for (int r = 0; r < 16; ++r) { const float ra = __builtin_amdgcn_rcpf(wse[crow(r, hie)]), rb = nlam * __builtin_amdgcn_rcpf(wse[32 + crow(r, hie)]); float acc = 0.f;
#pragma unroll
        for (int d0 = 0; d0 < 4; ++d0) { const float v = o1[d0][r] * ra + o2[d0][r] * rb; o1[d0][r] = v; acc += v * v; }
        ss[r] = acc; }
#pragma unroll
    for (int r = 0; r < 16; ++r) {
#pragma unroll
        for (int msk = 1; msk < 32; msk <<= 1) ss[r] += __builtin_bit_cast(float, __builtin_amdgcn_ds_bpermute((lane2 ^ msk) << 2, __builtin_bit_cast(int, ss[r])));
        ss[r] = (1.f - LAMBDA_INIT) * __builtin_amdgcn_rsqf(ss[r] * (1.f / 128.f) + SUBLN_EPS); }
    float gsub[4];
#pragma unroll
    for (int d0 = 0; d0 < 4; ++d0) gsub[d0] = subln[d0 * 32 + r32e];
    { LAS unsigned char* stb = lds + wid * 8192; LAS unsigned* stg = (LAS unsigned*)stb; const bool odd = r32e & 1;
#pragma unroll
      for (int r = 0; r < 16; ++r) { const int row = crow(r, hie);
          const float v0 = o1[0][r] * ss[r] * gsub[0], v1 = o1[1][r] * ss[r] * gsub[1], v2 = o1[2][r] * ss[r] * gsub[2], v3 = o1[3][r] * ss[r] * gsub[3];
          const float ga = __builtin_bit_cast(float, __builtin_amdgcn_update_dpp(0, __builtin_bit_cast(int, odd ? v0 : v1), 0xB1, 0xF, 0xF, false));
          const float gb = __builtin_bit_cast(float, __builtin_amdgcn_update_dpp(0, __builtin_bit_cast(int, odd ? v2 : v3), 0xB1, 0xF, 0xF, false));
          const unsigned pa_ = odd ? cvtpk(ga, v1) : cvtpk(v0, ga), pb_ = odd ? cvtpk(gb, v3) : cvtpk(v2, gb);
          const int dw = odd ? 16 + (r32e >> 1) : (r32e >> 1);
          stg[row * 64 + dw] = pa_; stg[row * 64 + 32 + dw] = pb_; }
      asm volatile("s_waitcnt lgkmcnt(0)" ::: "memory");
      bf16* Ou = attn + (rowb + q0w) * DM + h * 128;
#pragma unroll
      for (int g = 0; g < 8; ++g) { const int row = g * 4 + (lane2 >> 4), ch = lane2 & 15;
          const v4u wv = *(const LAS v4u*)(stb + row * 256 + ch * 16);
          *(v4u*)(Ou + (unsigned)(row * DM + ch * 8)) = wv; } }
    asm volatile("s_waitcnt lgkmcnt(0)\n\ts_barrier" ::: "memory");
    return good;
#undef D2_DMA
}
#undef D2_WAIT_BAR

constexpr int DL_K = 0, DL_V = 65536;
constexpr int DL_T = RING_BYTES + 1024, DT_OFF = 128, DT_LEN = 256;
constexpr int DL_WS = DL_T + 3 * DT_LEN * 4;
static_assert(DL_WS + NWAVES * 256 <= LDS_BYTES, "dilated LDS map");
constexpr size_t DSCR_O = 0, DSCR_L = (size_t)3 * 1024 * 64 * 2, DSCR_BYTES = DSCR_L + 3 * 1024 * 4;
#define KSWZ64(row, colB) ((row) * 128 + ((colB) ^ (((row) & 7) << 4)))
__device__ __forceinline__ void dil_load(bf16x8 (&buf)[8], const bf16* __restrict__ tile0, size_t gstride, unsigned voff) {
#pragma unroll
    for (int g = 0; g < 8; ++g) buf[g] = ld8(tile0 + g * gstride + voff);
}
template <int HALF> __device__ __forceinline__ void dil_softmax(f32x16& p0, f32x16& p1, float& m_reg, float& l_reg, float& alpha, bf16x8& pa0, bf16x8& pa1, bf16x8& pa2, bf16x8& pa3) {
    float mx4[4];
    if constexpr (HALF != 2) { mx4[0] = p0[0]; mx4[1] = p0[1]; mx4[2] = p0[2]; mx4[3] = p0[3];
#pragma unroll
        for (int r = 4; r < 16; ++r) mx4[r & 3] = fmaxf(mx4[r & 3], p0[r]); }
    else { mx4[0] = p1[0]; mx4[1] = p1[1]; mx4[2] = p1[2]; mx4[3] = p1[3]; }
    if constexpr (HALF != 1) {
#pragma unroll
        for (int r = (HALF == 2 ? 4 : 0); r < 16; ++r) mx4[r & 3] = fmaxf(mx4[r & 3], p1[r]); }
    float pmax = fmaxf(fmaxf(mx4[0], mx4[1]), fmaxf(mx4[2], mx4[3]));
    { auto rr = __builtin_amdgcn_permlane32_swap(__float_as_uint(pmax), __float_as_uint(pmax), false, false); pmax = fmaxf(__uint_as_float(rr[0]), __uint_as_float(rr[1])); }
    float mn;
    if (__builtin_expect(__all(pmax - m_reg <= THR), 1)) { mn = m_reg; alpha = 1.f; }
    else { mn = fmaxf(m_reg, pmax); alpha = __builtin_amdgcn_exp2f(m_reg - mn); m_reg = mn; }
    if constexpr (HALF != 2) {
#pragma unroll
        for (int r = 0; r < 16; ++r) p0[r] = __builtin_amdgcn_exp2f(p0[r] - mn); }
    if constexpr (HALF != 1) {
#pragma unroll
        for (int r = 0; r < 16; ++r) p1[r] = __builtin_amdgcn_exp2f(p1[r] - mn); }
    float ps4[4];
#pragma unroll
    for (int c = 0; c < 4; ++c) { float a_ = 0.f;
        if constexpr (HALF != 2) { a_ = p0[4 * c] + p0[4 * c + 1]; a_ += p0[4 * c + 2]; a_ += p0[4 * c + 3]; }
        if constexpr (HALF != 1) { a_ += p1[4 * c]; a_ += p1[4 * c + 1]; a_ += p1[4 * c + 2]; a_ += p1[4 * c + 3]; }
        ps4[c] = a_; }
    float ps = (ps4[0] + ps4[1]) + (ps4[2] + ps4[3]);
    { auto rr = __builtin_amdgcn_permlane32_swap(__float_as_uint(ps), __float_as_uint(ps), false, false); ps = __uint_as_float(rr[0]) + __uint_as_float(rr[1]); }
    l_reg = l_reg * alpha + ps;
#define PK4(P, BASE, OUT) do { unsigned a0 = cvtpk(P[BASE + 0], P[BASE + 1]), a1 = cvtpk(P[BASE + 2], P[BASE + 3]);   \
    unsigned b0 = cvtpk(P[BASE + 4], P[BASE + 5]), b1 = cvtpk(P[BASE + 6], P[BASE + 7]);                              \
    auto r0 = __builtin_amdgcn_permlane32_swap(a0, b0, false, false); auto r1 = __builtin_amdgcn_permlane32_swap(a1, b1, false, false); \
    v4u w = {r0[0], r1[0], r0[1], r1[1]}; OUT = __builtin_bit_cast(bf16x8, w); } while (0)
    if constexpr (HALF != 2) { PK4(p0, 0, pa0); PK4(p0, 8, pa1); }
    if constexpr (HALF != 1) { PK4(p1, 0, pa2); PK4(p1, 8, pa3); }
#undef PK4
}
template <int T, int QH> __device__ __forceinline__ void dil_step_sm(f32x16 (&o)[2], const bf16x8 (&qr)[4], float& m_reg, float& l_reg, const LAS float* Tb, const LAS unsigned char* Kt, LAS float* wsf,
                                                                      int r32, int hi, bf16x8& pa0, bf16x8& pa1, bf16x8& pa2, bf16x8& pa3) {
    constexpr int HALF = (T == 0 && QH == 1) ? 2 : ((T == 2 && QH == 0) ? 1 : 0);
    f32x16 p0, p1;
    { const LAS float* tp = Tb + (64 * T - 64 - 32 * QH - r32 + 4 * hi + DT_OFF);
      if constexpr (HALF != 2) {
#pragma unroll
        for (int r = 0; r < 16; ++r) p0[r] = tp[(r & 3) + 8 * (r >> 2)]; }
      if constexpr (HALF != 1) {
#pragma unroll
        for (int r = 0; r < 16; ++r) p1[r] = tp[32 + (r & 3) + 8 * (r >> 2)]; } }
#pragma unroll
    for (int d0 = 0; d0 < 4; ++d0) { const int cb = (d0 * 16 + hi * 8) * 2;
        if constexpr (HALF != 2) { const bf16x8 k0 = *(const LAS bf16x8*)(Kt + KSWZ64(r32, cb)); p0 = __builtin_amdgcn_mfma_f32_32x32x16_bf16(k0, qr[d0], p0, 0, 0, 0); }
        if constexpr (HALF != 1) { const bf16x8 k1 = *(const LAS bf16x8*)(Kt + KSWZ64(32 + r32, cb)); p1 = __builtin_amdgcn_mfma_f32_32x32x16_bf16(k1, qr[d0], p1, 0, 0, 0); } }
    float alpha;
    dil_softmax<HALF>(p0, p1, m_reg, l_reg, alpha, pa0, pa1, pa2, pa3);
    if (__any(alpha < 1.f)) { if (hi == 0) wsf[r32] = alpha; asm volatile("s_waitcnt lgkmcnt(0)" ::: "memory");
#pragma unroll
        for (int d = 0; d < 2; ++d)
#pragma unroll
            for (int r = 0; r < 16; ++r) o[d][r] *= wsf[crow(r, hi)]; }
}
template <int T, int QH> __device__ __forceinline__ void dil_step_pv(f32x16 (&o)[2], int vb, bf16x8 pa0, bf16x8 pa1, bf16x8 pa2, bf16x8 pa3) {
    constexpr int HALF = (T == 0 && QH == 1) ? 2 : ((T == 2 && QH == 0) ? 1 : 0);
    asm volatile("s_waitcnt lgkmcnt(0)" ::: "memory"); SBAR();
    if constexpr (HALF != 2) { pv_step<2, 2, 0>(o, vb, pa0); pv_step<2, 2, 1>(o, vb, pa1); }
    if constexpr (HALF != 1) { pv_step<2, 2, 2>(o, vb, pa2); pv_step<2, 2, 3>(o, vb, pa3); }
    SBAR();
}
struct DilState { bf16x8 buf[8]; bf16x8 qr[2][4]; };
__device__ __forceinline__ void dil_prefetch(DilState& st, const bf16* __restrict__ proj, int b, int h, int sb, int it, int lane) {
    const int r32 = lane & 31, hi = lane >> 5;
    const int p = it >> 4, w = it & 15, dsh = 2 * p;
    const int per = 16 >> dsh, res = w / per, mq0 = sb * (1024 >> dsh) + (w % per) * 64;
    const size_t rowb = (size_t)b * SEQ; const int t_lo = (mq0 - 64 < 0) ? 1 : 0;
    const size_t gstride = ((size_t)8 << dsh) * NIN; const unsigned voff = (unsigned)(((lane >> 3) << dsh) * NIN + (lane & 7) * 8);
    const bf16* colK = proj + (rowb + res) * NIN + COL_KD + h * 64;
    dil_load(st.buf, colK + ((size_t)(mq0 - 64 + 64 * t_lo) << dsh) * NIN, gstride, voff);
#pragma unroll
    for (int qh = 0; qh < 2; ++qh) { const bf16* Qw = proj + (rowb + ((size_t)(mq0 + 32 * qh + r32) << dsh) + res) * NIN + COL_QD + h * 64 + hi * 8;
#pragma unroll
      for (int d0 = 0; d0 < 4; ++d0) st.qr[qh][d0] = ld8(Qw + d0 * 16); }
}
__device__ __forceinline__ void dil_item(DilState& st, const bf16* __restrict__ proj, bf16* scrO, float* scrL, int b, int h, int sb, int it, int it_next, LAS unsigned char* lds, int wid, int lane_in) {
    int lane = lane_in; asm volatile("" : "+v"(lane));
    const int r32 = lane & 31, hi = lane >> 5;
    const int p = it >> 4, w = it & 15, dsh = 2 * p;
    const int per = 16 >> dsh, res = w / per, mq0 = sb * (1024 >> dsh) + (w % per) * 64, m_len = SEQ >> dsh;
    const LAS float* Tb = (const LAS float*)(lds + DL_T) + p * DT_LEN; LAS float* wsf = (LAS float*)(lds + DL_WS) + wid * 64;
    LAS unsigned char* Kt = lds + DL_K + wid * 8192; LAS unsigned char* Vt = lds + DL_V + wid * 8192;
    const int vb = (int)(unsigned)(uintptr_t)Vt + v_rd_base(lane);
    const size_t rowb = (size_t)b * SEQ;
    const int t_lo = (mq0 - 64 < 0) ? 1 : 0, t_hi = (mq0 + 64 >= m_len) ? 1 : 2;
    bf16x8 (&buf)[8] = st.buf; bf16x8 (&qr)[2][4] = st.qr;
    const size_t gstride = ((size_t)8 << dsh) * NIN; const unsigned voff = (unsigned)(((lane >> 3) << dsh) * NIN + (lane & 7) * 8);
    const bf16* colK = proj + (rowb + res) * NIN + COL_KD + h * 64; const bf16* colV = proj + (rowb + res) * NIN + COL_VD + h * 64;
    f32x16 o[2][2];
#pragma unroll
    for (int qh = 0; qh < 2; ++qh) { o[qh][0] = f32x16{}; o[qh][1] = f32x16{}; }
    float m_reg[2] = {-1e4f, -1e4f}, l_reg[2] = {0.f, 0.f};
#define DIL_TILE(T) do { if ((T) >= t_lo && (T) <= t_hi) { const int kbase = mq0 - 64 + 64 * (T); bf16x8 pa0, pa1, pa2, pa3; \
        _Pragma("unroll") for (int g = 0; g < 8; ++g) *(LAS bf16x8*)(Kt + KSWZ64(g * 8 + (lane >> 3), (lane & 7) * 16)) = buf[g];        \
        dil_load(buf, colV + ((size_t)kbase << dsh) * NIN, gstride, voff);                                                                \
        dil_step_sm<T, 0>(o[0], qr[0], m_reg[0], l_reg[0], Tb, Kt, wsf, r32, hi, pa0, pa1, pa2, pa3); \
        _Pragma("unroll") for (int g = 0; g < 8; ++g) *(LAS bf16x8*)(Vt + v_st<2>(g * 8 + (lane >> 3), (lane & 7) * 8)) = buf[g];          \
        if ((T) < t_hi) dil_load(buf, colK + ((size_t)(kbase + 64) << dsh) * NIN, gstride, voff);                                         \
        dil_step_pv<T, 0>(o[0], vb, pa0, pa1, pa2, pa3); \
        dil_step_sm<T, 1>(o[1], qr[1], m_reg[1], l_reg[1], Tb, Kt, wsf, r32, hi, pa0, pa1, pa2, pa3); \
        dil_step_pv<T, 1>(o[1], vb, pa0, pa1, pa2, pa3); } } while (0)
    DIL_TILE(0); DIL_TILE(1); DIL_TILE(2);
#undef DIL_TILE
    if (it_next >= 0) dil_prefetch(st, proj, b, h, sb, it_next, lane);
    LAS unsigned* stg = (LAS unsigned*)Kt;
#pragma unroll
    for (int qh = 0; qh < 2; ++qh) {
        if (hi == 0) { wsf[32 + r32] = l_reg[qh]; const int tl = (((mq0 + 32 * qh + r32) << dsh) + res) & 1023; scrL[p * 1024 + tl] = m_reg[qh] + __builtin_amdgcn_logf(l_reg[qh]); }
        asm volatile("s_waitcnt lgkmcnt(0)" ::: "memory");
        const bool odd = r32 & 1;
#pragma unroll
        for (int r = 0; r < 16; ++r) { const int i = 32 * qh + crow(r, hi); const float rl = __builtin_amdgcn_rcpf(wsf[32 + crow(r, hi)]);
            const float v0 = o[qh][0][r] * rl, v1 = o[qh][1][r] * rl;
            const float got = __builtin_bit_cast(float, __builtin_amdgcn_update_dpp(0, __builtin_bit_cast(int, odd ? v0 : v1), 0xB1, 0xF, 0xF, false));
            const unsigned pk = odd ? cvtpk(got, v1) : cvtpk(v0, got);
            stg[i * 32 + (odd ? 16 + (r32 >> 1) : (r32 >> 1))] = pk; }
        asm volatile("s_waitcnt lgkmcnt(0)" ::: "memory");
    }
#pragma unroll
    for (int g = 0; g < 8; ++g) { const int i = g * 8 + (lane >> 3), ch = lane & 7; const int tl = (((mq0 + i) << dsh) + res) & 1023;
        const v4u wv = *(const LAS v4u*)(Kt + i * 128 + ch * 16);
        *(v4u*)(scrO + ((size_t)p * 1024 + tl) * 64 + ch * 8) = wv; }
}
__device__ __forceinline__ void dil_unit(const bf16* __restrict__ proj, bf16* __restrict__ attn, const float* relb, float* scr, int b, int h, int sb, LAS unsigned char* lds, int tid) {
    const int wid = __builtin_amdgcn_readfirstlane(tid >> 6), lane = tid & 63;
    LAS float* T = (LAS float*)(lds + DL_T);
    for (int i = tid; i < 3 * DT_LEN; i += NWAVES * 64) { const int p = i / DT_LEN, off = i % DT_LEN - DT_OFF; const int dil = 1 << (2 * p);
        T[i] = (off >= -64 && off <= 64) ? relb[(unsigned)(t5_bucket(off * dil) * 12 + 4 + h)] * LOG2E : -1e30f; }
    __syncthreads();
    bf16* scrO = (bf16*)((unsigned char*)scr + DSCR_O); float* scrL = (float*)((unsigned char*)scr + DSCR_L);
    DilState st; dil_prefetch(st, proj, b, h, sb, wid, lane);
#pragma unroll 1
    for (int k = 0; k < 6; ++k) dil_item(st, proj, scrO, scrL, b, h, sb, k * 8 + wid, k < 5 ? (k + 1) * 8 + wid : -1, lds, wid, lane);
    asm volatile("s_waitcnt vmcnt(0)" ::: "memory");
    __syncthreads();
    __builtin_amdgcn_fence(__ATOMIC_ACQUIRE, "agent");
    asm volatile("s_waitcnt vmcnt(0)" ::: "memory");
#pragma unroll 1
    for (int n = 0; n < 16; ++n) { const int i = tid + 512 * n, tl = i >> 3, ch = i & 7;
        const float l0 = scrL[tl], l1 = scrL[1024 + tl], l2 = scrL[2048 + tl]; const float mx = fmaxf(l0, fmaxf(l1, l2));
        float w0 = __builtin_amdgcn_exp2f(l0 - mx), w1 = __builtin_amdgcn_exp2f(l1 - mx), w2 = __builtin_amdgcn_exp2f(l2 - mx); const float rs = 1.f / (w0 + w1 + w2); w0 *= rs; w1 *= rs; w2 *= rs;
        const v4u s0 = *(const v4u*)(scrO + (size_t)tl * 64 + ch * 8), s1 = *(const v4u*)(scrO + ((size_t)1024 + tl) * 64 + ch * 8), s2 = *(const v4u*)(scrO + ((size_t)2048 + tl) * 64 + ch * 8);
        f32x4 a0, a1;
        a0.x = bflo(s0.x) * w0 + bflo(s1.x) * w1 + bflo(s2.x) * w2; a0.y = bfhi(s0.x) * w0 + bfhi(s1.x) * w1 + bfhi(s2.x) * w2;
        a0.z = bflo(s0.y) * w0 + bflo(s1.y) * w1 + bflo(s2.y) * w2; a0.w = bfhi(s0.y) * w0 + bfhi(s1.y) * w1 + bfhi(s2.y) * w2;
        a1.x = bflo(s0.z) * w0 + bflo(s1.z) * w1 + bflo(s2.z) * w2; a1.y = bfhi(s0.z) * w0 + bfhi(s1.z) * w1 + bfhi(s2.z) * w2;
        a1.z = bflo(s0.w) * w0 + bflo(s1.w) * w1 + bflo(s2.w) * w2; a1.w = bfhi(s0.w) * w0 + bfhi(s1.w) * w1 + bfhi(s2.w) * w2;
        v4u wv; wv.x = pk2(a0.x, a0.y); wv.y = pk2(a0.z, a0.w); wv.z = pk2(a1.x, a1.y); wv.w = pk2(a1.z, a1.w);
        *(v4u*)(attn + ((size_t)b * SEQ + sb * 1024 + tl) * DM + 512 + h * 64 + ch * 8) = wv; }
    asm volatile("s_waitcnt vmcnt(0)" ::: "memory");
    __syncthreads();
}
#undef KSWZ
#undef KSWZ16
#undef KSWZ64
#undef SBAR
}

__device__ __forceinline__ void p2_attention(Frame& F, const Args& a) {
    const bf16* proj = (const bf16*)(a.ws + WS_PROJ); bf16* attn = (bf16*)(a.ws + WS_ATT);
    float s1 = 0.f, s2 = 0.f;
    for (int i = 0; i < 64; ++i) { s1 += a.lq1[i] * a.lk1[i]; s2 += a.lq2[i] * a.lk2[i]; }
    float lam_v = expf(s1) - expf(s2) + LAMBDA_INIT; asm volatile("" : "+v"(lam_v));
    const int lam_bits = __builtin_amdgcn_readfirstlane(__builtin_bit_cast(int, lam_v));
    const float lam = __builtin_bit_cast(float, lam_bits);
    const int bx = (int)blockIdx.x, G = F.G;
#ifndef NO_DIFF
#if MK_DIFF2
    if (a.variant != 2) for (int L = bx; L < 64 * 16; L += G) {
        int bh, qb; if (G == 256) { const int slot = (L & 255) >> 3; bh = (L >> 8) * 16 + (L & 7) * 2 + (slot >> 4); qb = slot & 15; } else { bh = L >> 4; qb = L & 15; }
        if (!att::diff_unit3(proj, attn, a.relb, a.subln, lam, bh >> 2, bh & 3, qb, F.lds + RING_OFF, F.wave * 64 + fresh_lane()))
            att::diff_unit2(proj, attn, a.relb, a.subln, lam, bh >> 2, bh & 3, qb, F.lds + RING_OFF, F.wave * 64 + fresh_lane());
    }
#else
    if (a.variant != 2) for (int L = bx; L < 64 * 32; L += G) {
        int bh, qb; if (G == 256) { bh = (L >> 8) * 8 + (L & 7); qb = (L & 255) >> 3; } else { bh = L >> 5; qb = L & 31; }
        att::diff_unit(proj, attn, a.relb, a.subln, lam, bh >> 2, bh & 3, qb, F.lds + RING_OFF, F.wave * 64 + fresh_lane());
    }
#endif
#endif
#ifndef NO_DIL
    float* scr = (float*)(a.ws + WS_DSCR + (size_t)bx * att::DSCR_BYTES);
    if (a.variant != 1) for (int L = bx; L < 128 * 4; L += G) {
        int bh, sb; if (G == 256) { bh = (L >> 8) * 64 + (L & 7) * 8 + ((L & 255) >> 5); sb = ((L & 255) >> 3) & 3; } else { bh = L >> 2; sb = L & 3; }
        att::dil_unit(proj, attn, a.relb, scr, bh >> 3, bh & 7, sb, F.lds + RING_OFF, F.wave * 64 + fresh_lane());
    }
#endif
}


constexpr int N_PHASES = 9;
__global__ void __launch_bounds__(NWAVES * 64, 2) mega(Args args) {
    extern __shared__ __attribute__((aligned(16))) unsigned char lds[];
    Frame F;
    F.lds = (LAS unsigned char*)lds;
    F.MISC = (volatile LAS unsigned*)(F.lds + MISC_OFF);
    F.wave = __builtin_amdgcn_readfirstlane((int)threadIdx.x >> 6);
    F.G = gridDim.x; { const int bx = blockIdx.x; F.vcu = (F.G % 8 == 0) ? (bx % 8) * (F.G / 8) + bx / 8 : bx; }
    unsigned char* ws = args.ws;
    gu32* ctl = (gu32*)(ws + WS_CTL);
    const int tid0 = F.wave * 64 + fresh_lane();
    for (int u = tid0; u < (LDS_BYTES - LDSCTL_OFF) / 4; u += NWAVES * 64) ((LAS unsigned*)(F.lds + LDSCTL_OFF))[u] = 0u;
    __syncthreads();
    XcdBarrier bar; bar.bar = (unsigned*)(ctl + CW_BAR); bar.x = 0; bar.st = nullptr;
    const int lo = args.ph_lo, hi = args.ph_hi;
    if (hi - lo > 1) bar = xcd_barrier_post((unsigned*)(ctl + CW_BAR), F.MISC + 8, tid0);
#ifdef ONLY_PHASE
#define IN(k) ((k) == ONLY_PHASE && lo <= (k) && (k) < hi)
#else
#define IN(k) (lo <= (k) && (k) < hi)
#endif
#define SEAM(k) do { if (IN(k) && IN((k) + 1)) xcd_barrier(bar, F.wave * 64 + fresh_lane()); } while (0)
#ifdef FDUP
#define AGAIN(k) (((FDUP >> (k)) & 1) && hi - lo > 1)
#else
#define AGAIN(k) false
#endif

    if (IN(0)) { p0_prologue(F, args); if (AGAIN(0)) { xcd_barrier(bar, F.wave * 64 + fresh_lane()); p0_prologue(F, args); } } SEAM(0);
    const int bxi = (int)blockIdx.x;
    if (IN(1)) {
        pg8::Gemm g{(const bf16*)(ws + WS_H1), (const bf16*)(ws + WS_WIN), NTOK, NIN, DM}; pg8::StaticOrder S; S.init(NTOK, NIN, F.G, bxi);
        pg8::EpiProj E{(bf16*)(ws + WS_PROJ), QSCALE};
        pg8::gemm_phase<pg8::EpiProj, pg8::StaticOrder, true, true>(F.lds + RING_OFF, g, S, E, F.wave);
    } SEAM(1);
    if (IN(2)) { p2_attention(F, args); } SEAM(2);
    if (IN(3)) {
        pg8::Gemm g{(const bf16*)(ws + WS_ATT), (const bf16*)(ws + WS_WOUT), NTOK, DM, DM}; pg8::StaticOrder S; S.init(NTOK, DM, F.G, (int)blockIdx.x);
        pg8::EpiResBf16 E{args.x, (bf16*)(ws + WS_X2)};
        pg8::gemm_phase<pg8::EpiResBf16, pg8::StaticOrder, true, true>(F.lds + RING_OFF, g, S, E, F.wave);
    } SEAM(3);
    if (IN(4)) { p4_router(F, args); if (AGAIN(4)) { xcd_barrier(bar, F.wave * 64 + fresh_lane()); p4_router(F, args); } } SEAM(4);
    if (IN(5)) { p5_topk(F, args); if (AGAIN(5)) { xcd_barrier(bar, F.wave * 64 + fresh_lane()); p5_topk(F, args); } } SEAM(5);
    if (IN(6)) {
        pg8::Gemm g{(const bf16*)(ws + WS_XE), (const bf16*)(ws + WS_W1T), 0, 0, DM / 2}; pg8::MoeOrder S; S.init(5632, F.G, bxi);
        pg8::EpiSwiGLU8 E{ws + WS_HE};
      for (int rep = 0; rep < (AGAIN(6) ? 2 : 1); ++rep) {
        if (rep) xcd_barrier(bar, F.wave * 64 + fresh_lane());
#if MK_FP6
        pg8::gemm_phase6<pg8::EpiSwiGLU8, pg8::MoeOrder, true>(F.lds + RING_OFF, ws + WS_XE, ws + WS_W1T, S, E, F.wave);
#else
        pg8::gemm_phase<pg8::EpiSwiGLU8, pg8::MoeOrder, true, true, true>(F.lds + RING_OFF, g, S, E, F.wave);
#endif
      }
    } SEAM(6);
    if (IN(7)) {
        pg8::Gemm g{(const bf16*)(ws + WS_HE), (const bf16*)(ws + WS_W2T), 0, 0, DFF / 2}; pg8::MoeOrder S; S.init(1024, F.G, (int)blockIdx.x);
        pg8::EpiDown8 E{(bf16*)(ws + WS_YE), (const float*)(ws + WS_GATE)};
      for (int rep = 0; rep < (AGAIN(7) ? 2 : 1); ++rep) {
        if (rep) xcd_barrier(bar, F.wave * 64 + fresh_lane());
        pg8::gemm_phase<pg8::EpiDown8, pg8::MoeOrder, true, true, true>(F.lds + RING_OFF, g, S, E, F.wave);
      }
    } SEAM(7);
    if (IN(8)) { p8_combine(F, args); }
#undef IN
#undef SEAM
#undef AGAIN
}


#if MK_NAIVE_ATTN
__global__ __launch_bounds__(256) void naive_diff_attn(Args a) {
    __shared__ float Ks[32][128]; __shared__ float Vs[32][128]; __shared__ float T[2048];
    const int bh = blockIdx.x >> 5, qb = blockIdx.x & 31, b = bh >> 2, h = bh & 3;
    const int t = threadIdx.x, qi = t >> 1, sub = t & 1;
    const bf16* proj = (const bf16*)(a.ws + WS_PROJ); bf16* att = (bf16*)(a.ws + WS_ATT);
    for (int i = t; i < 2048; i += 256) T[i] = a.relb[t5_bucket(i - 1024) * 12 + h] * LOG2E;
    float s1 = 0.f, s2 = 0.f;
    for (int i = 0; i < 64; ++i) { s1 += a.lq1[i] * a.lk1[i]; s2 += a.lq2[i] * a.lk2[i]; }
    const float lam = expf(s1) - expf(s2) + LAMBDA_INIT;
    const int qpos = qb * 128 + qi; const size_t qrow = (size_t)(b * SEQ + qpos) * NIN;
    float q[64];
#pragma unroll
    for (int j = 0; j < 64; ++j) q[j] = bf2f(proj[qrow + COL_QA + h * 128 + sub * 64 + j]);
    float o[128];
#pragma unroll
    for (int d = 0; d < 128; ++d) o[d] = 0.f;
    float m = -1e30f, l = 0.f;
    for (int kt = 0; kt < SEQ; kt += 32) {
        __syncthreads();
        for (int i = t; i < 4096; i += 256) { const int r = i >> 7, c = i & 127; const size_t row = (size_t)(b * SEQ + kt + r) * NIN;
            Ks[r][c] = bf2f(proj[row + COL_KA + h * 128 + c]); Vs[r][c] = bf2f(proj[row + COL_VA + h * 128 + c]); }
        __syncthreads();
        for (int kk = 0; kk < 32; ++kk) {
            float s = 0.f;
#pragma unroll
            for (int j = 0; j < 64; ++j) s += q[j] * Ks[kk][sub * 64 + j];
            int rel = kt + kk - qpos; rel = rel < -1024 ? -1024 : (rel > 1023 ? 1023 : rel);
            s += T[rel + 1024];
            if (s > m) { const float f = exp2f(m - s); l *= f;
#pragma unroll
                for (int d = 0; d < 128; ++d) o[d] *= f;
                m = s; }
            const float p = exp2f(s - m); l += p;
#pragma unroll
            for (int d = 0; d < 128; ++d) o[d] += p * Vs[kk][d];
        }
    }
    const float sc = (sub ? -lam : 1.f) / l; float ss = 0.f;
#pragma unroll
    for (int d = 0; d < 128; ++d) { float v = o[d] * sc; v += __shfl_xor(v, 1); o[d] = v; ss += v * v; }
    const float r = 1.f / sqrtf(ss * (1.f / 128.f) + SUBLN_EPS);
    if (sub == 0) {
#pragma unroll
        for (int d = 0; d < 128; ++d) att[(size_t)(b * SEQ + qpos) * DM + h * 128 + d] = (bf16)f2bf(o[d] * r * a.subln[d] * (1.f - LAMBDA_INIT));
    }
}
__global__ __launch_bounds__(256) void naive_dilated(Args a) {
    const int gid = blockIdx.x * 256 + threadIdx.x, h = gid & 7, tok = gid >> 3, b = tok >> 12, pos = tok & 4095;
    const bf16* proj = (const bf16*)(a.ws + WS_PROJ); bf16* att = (bf16*)(a.ws + WS_ATT);
    float q[64], o[64];
#pragma unroll
    for (int j = 0; j < 64; ++j) { q[j] = bf2f(proj[(size_t)tok * NIN + COL_QD + h * 64 + j]); o[j] = 0.f; }
    float m = -1e30f, l = 0.f;
    for (int p = 0; p < 3; ++p) { const int dil = p == 0 ? 1 : (p == 1 ? 4 : 16);
        for (int j = -64; j <= 64; ++j) { const int pk = pos + j * dil; if (pk < 0 || pk >= SEQ) continue;
            const size_t row = (size_t)(b * SEQ + pk) * NIN; float s = 0.f;
#pragma unroll
            for (int d = 0; d < 64; ++d) s += q[d] * bf2f(proj[row + COL_KD + h * 64 + d]);
            s += a.relb[t5_bucket(j * dil) * 12 + 4 + h] * LOG2E;
            if (s > m) { const float f = exp2f(m - s); l *= f;
#pragma unroll
                for (int d = 0; d < 64; ++d) o[d] *= f;
                m = s; }
            const float pw = exp2f(s - m); l += pw;
#pragma unroll
            for (int d = 0; d < 64; ++d) o[d] += pw * bf2f(proj[row + COL_VD + h * 64 + d]);
        } }
    const float il = 1.f / l;
#pragma unroll
    for (int d = 0; d < 64; ++d) att[(size_t)tok * DM + 512 + h * 64 + d] = (bf16)f2bf(o[d] * il);
}
static void launch_naive_attention(const Args& a, hipStream_t stream) {
    hipLaunchKernelGGL(naive_diff_attn, dim3(64 * 32), dim3(256), 0, stream, a);
    hipLaunchKernelGGL(naive_dilated, dim3(NTOK * 8 / 256), dim3(256), 0, stream, a);
}
#endif


extern "C" void kernel_launch(void* const* d_in, const int* in_sizes, int n_in, void* d_out, int out_size, void* d_ws, size_t ws_size, hipStream_t stream) {
    static int grid = 0;
    if (grid == 0) {
        if (n_in != 16 || in_sizes[0] != NTOK * DM || out_size != NTOK * DM || ws_size < WS_END) {
            fprintf(stderr, "kernel_launch: shape/workspace mismatch (n_in %d, in0 %d, out %d, ws %zu, need %zu); nothing launched\n", n_in, n_in > 0 ? in_sizes[0] : -1, out_size, ws_size, (size_t)WS_END); grid = -1; return; }
        int dev = 0, cus = 0, per_cu = 0;
        if (hipGetDevice(&dev) != hipSuccess || hipDeviceGetAttribute(&cus, hipDeviceAttributeMultiprocessorCount, dev) != hipSuccess) { grid = -1; return; }
        if (hipFuncSetAttribute((const void*)mega, hipFuncAttributeMaxDynamicSharedMemorySize, LDS_BYTES) != hipSuccess) { fprintf(stderr, "kernel_launch: hipFuncSetAttribute failed\n"); grid = -1; return; }
        if (hipOccupancyMaxActiveBlocksPerMultiprocessor(&per_cu, (const void*)mega, NWAVES * 64, LDS_BYTES) != hipSuccess || per_cu < 1) { fprintf(stderr, "kernel_launch: occupancy query says %d\n", per_cu); }
        (void)hipGetLastError();
        grid = cus;
    }
    if (grid < 0) return;
    (void)hipMemsetAsync((char*)d_ws + WS_CTL, 0, CTL_ZERO_BYTES, stream);
    Args a{};
    a.x = (const float*)d_in[0]; a.g1 = (const float*)d_in[1]; a.w_in = (const float*)d_in[2]; a.lq1 = (const float*)d_in[3]; a.lk1 = (const float*)d_in[4]; a.lq2 = (const float*)d_in[5]; a.lk2 = (const float*)d_in[6];
    a.subln = (const float*)d_in[7]; a.w_out = (const float*)d_in[8]; a.relb = (const float*)d_in[9]; a.g2 = (const float*)d_in[10]; a.w_router = (const float*)d_in[11];
    a.w_gate = (const float*)d_in[12]; a.w_up = (const float*)d_in[13]; a.w_down = (const float*)d_in[14]; a.gf = (const float*)d_in[15];
    a.out = (float*)d_out; a.ws = (unsigned char*)d_ws;
#if MK_MODE == 0
    a.ph_lo = 0; a.ph_hi = N_PHASES;
    hipLaunchKernelGGL(mega, dim3(grid), dim3(NWAVES * 64), LDS_BYTES, stream, a);
#else
    for (int p = 0; p < N_PHASES; ++p) {
#if MK_NAIVE_ATTN
        if (p == 2) { launch_naive_attention(a, stream); continue; }
#endif
        a.ph_lo = p; a.ph_hi = p + 1; a.variant = 0;
#ifdef MK_FUSE_LO
        if (p == MK_FUSE_LO) { a.ph_hi = MK_FUSE_HI; hipLaunchKernelGGL(mega, dim3(grid), dim3(NWAVES * 64), LDS_BYTES, stream, a); p = MK_FUSE_HI - 1; continue; }
#endif
        hipLaunchKernelGGL(mega, dim3(grid), dim3(NWAVES * 64), LDS_BYTES, stream, a);
#ifdef MK_DUP
        if ((MK_DUP >> p) & 1) { a.variant = MK_DUPVAR; hipLaunchKernelGGL(mega, dim3(grid), dim3(NWAVES * 64), LDS_BYTES, stream, a); }
#endif
    }
#endif
    const hipError_t le = hipPeekAtLastError();
    if (le != hipSuccess) fprintf(stderr, "kernel_launch: launch failed: %s\n", hipGetErrorName(le));
}
```

```cpp
#define MK_FP6 2
#include <hip/hip_runtime.h>
#include <cstdio>
#include <cstdint>

#ifndef MK_MODE
#define MK_MODE 0
#endif
#ifndef MK_NAIVE_ATTN
#define MK_NAIVE_ATTN 0
#endif

#ifndef MK_FP6
#define MK_FP6 1
#endif
#ifndef MK_DIFF2
#define MK_DIFF2 1
#endif

constexpr int BATCH = 16, SEQ = 4096, DM = 1024, NTOK = BATCH * SEQ, NIN = 3072, NE = 16, CAP = 512, DFF = 2816, EROWS = BATCH * CAP;
constexpr int NDH = 4, NLH = 8;
constexpr float LOG2E = 1.4426950408889634f, QSCALE = 0.125f * LOG2E;
constexpr float NORM_EPS = 1e-6f, SUBLN_EPS = 1e-5f, LAMBDA_INIT = 0.2f;
constexpr int COL_QA = 0, COL_KA = 512, COL_VA = 1024, COL_QD = 1536, COL_KD = 2048, COL_VD = 2560;

constexpr size_t MiB = 1u << 20;
constexpr size_t WS_CTL = 0, CTL_ZERO_BYTES = 1 * MiB;
constexpr size_t WS_WIN = 2 * MiB;
constexpr size_t WS_WOUT = 8 * MiB;
constexpr size_t WS_AFF = 10 * MiB;
constexpr size_t WS_IDX = 14 * MiB;
constexpr size_t WS_GATE = 14 * MiB + 512 * 1024;
constexpr size_t WS_INV = 15 * MiB;
constexpr size_t WS_W1T = 20 * MiB;
constexpr size_t WS_W2T = 108 * MiB;
constexpr size_t WS_H1 = 160 * MiB;
constexpr size_t WS_ATT = 160 * MiB;
constexpr size_t WS_PROJ = 288 * MiB;
constexpr size_t WS_DSCR = 672 * MiB;
constexpr size_t WS_H2 = 288 * MiB;
constexpr size_t WS_XE = 352 * MiB;
constexpr size_t WS_HE = 480 * MiB;
constexpr size_t WS_YE = 160 * MiB;
constexpr size_t WS_X2 = 896 * MiB;
constexpr size_t WS_END = 1024 * MiB;
static_assert(WS_W1T + (size_t)NE * 5632 * 1024 <= WS_W2T && WS_W2T + (size_t)NE * 1024 * 2816 <= WS_H1, "weights");
static_assert(WS_H1 + (size_t)NTOK * 1024 * 2 <= WS_PROJ && WS_PROJ + (size_t)NTOK * 3072 * 2 <= WS_DSCR && WS_DSCR + (size_t)224 * MiB <= WS_X2 && WS_X2 + (size_t)NTOK * 1024 * 2 <= WS_END, "dyn");
static_assert(WS_H2 + (size_t)NTOK * 1024 <= WS_XE && WS_XE + (size_t)NE * EROWS * 1024 <= WS_HE && WS_HE + (size_t)NE * EROWS * DFF <= WS_X2 && WS_YE + (size_t)NE * EROWS * 1024 * 2 <= WS_HE, "moe");
constexpr int CW_BAR = 4096;

constexpr int RING_OFF = 0, RING_BYTES = 131072;
constexpr int LDSCTL_OFF = RING_BYTES, MISC_OFF = LDSCTL_OFF + 320;
constexpr int LDS_BYTES = 147456;
constexpr int NWAVES = 8;

namespace pg8 {
#define PG8_LAS __attribute__((address_space(3)))
typedef unsigned short bf16_t;
typedef short bf16x8 __attribute__((ext_vector_type(8)));
typedef float f32x4 __attribute__((ext_vector_type(4)));
typedef unsigned u32x4 __attribute__((ext_vector_type(4)));
typedef int i32x4 __attribute__((ext_vector_type(4)));
typedef int i32x8 __attribute__((ext_vector_type(8)));
typedef unsigned u32x2 __attribute__((ext_vector_type(2)));
constexpr int BM = 256, BK = 64, HALF = 128, HTB = HALF * BK * 2  , STAGE_BYTES = 8 * HTB, NXCD = 8, WGM = 8;

__host__ __device__ __forceinline__ int lds_byte(int r, int c) { const int st = (r >> 4) * 2 + (c >> 5), rr = r & 15, cc = c & 31, ob = rr * 64 + cc * 2; return st * 1024 + (ob ^ (((ob >> 9) & 1) << 5)); }
__host__ __device__ __forceinline__ void stage_rc(int b, int& R, int& C) { const int st = b / 1024, sb = b % 1024, swz = sb ^ (((sb >> 9) & 1) << 5); R = (st >> 1) * 16 + swz / 64; C = (st & 1) * 32 + (swz % 64) / 2; }
__host__ __device__ __forceinline__ int perm32(int rho) { const int n = rho >> 4, i = rho & 15; return 8 * (i >> 2) + 4 * n + (i & 3); }

struct Unit { int pm, pn; };
struct Gemm { const bf16_t* A; const bf16_t* Bt; int M, N, K; };

struct StaticOrder {
    int nM, nN, nwg, G, c;
    __host__ __device__ void init(int M, int N, int G_, int c_) { nM = M / BM; nN = N / BM; nwg = nM * nN; G = G_; c = c_; }
    __host__ __device__ bool next(int i, Unit& u) const {
        const long L = (long)i * G + c; if (L >= nwg) return false;
        int wgid = (int)L; { const int q = nwg / NXCD, r = nwg % NXCD, xcd = wgid % NXCD, off = wgid / NXCD; wgid = (xcd < r ? xcd * (q + 1) : r * (q + 1) + (xcd - r) * q) + off; }
        const int nig = WGM * nN, gid = wgid / nig, fm = gid * WGM, gsz = (nM - fm) < WGM ? (nM - fm) : WGM;
        u.pm = fm + ((wgid % nig) % gsz); u.pn = (wgid % nig) / gsz; return true;
    }
    __device__ __forceinline__ void a_ready(const Unit&) const {}
    __device__ __forceinline__ void done(const Unit&) const {}
};

__device__ __forceinline__ unsigned cvt_pk_bf16(float lo, float hi) { unsigned r; asm volatile("v_cvt_pk_bf16_f32 %0, %1, %2" : "=v"(r) : "v"(lo), "v"(hi)); return r; }
typedef float f32x2 __attribute__((ext_vector_type(2)));
struct MoeOrder {
    StaticOrder so; int pn_per_e;
    __device__ void init(int N, int G_, int c_) { so.init(16 * 8192, N, G_, c_); pn_per_e = N / BM; }
    __device__ bool next(int i, Unit& u) const { Unit v; if (!so.next(i, v)) return false; u.pm = v.pm; u.pn = (v.pm >> 5) * pn_per_e + v.pn; return true; }
    __device__ __forceinline__ void a_ready(const Unit&) const {}
    __device__ __forceinline__ void done(const Unit&) const {}
};
__device__ __forceinline__ float clamp448(float v) { return __builtin_fminf(__builtin_fmaxf(v, -448.f), 448.f); }
struct EpiProj {
    static constexpr bool PERM = true, AFTER_DRAIN = false;
    bf16_t* O; float qscale;
    __device__ __forceinline__ void operator()(const f32x4 (&acc)[2][2][4][2], const Unit& u, int wr, int wc, int fr, int fq) const {
        const int row0 = u.pm * BM + wr * 64 + fr, col0 = u.pn * BM + wc * 32 + 8 * fq;
        const float sc = (u.pn < 2 || u.pn == 6 || u.pn == 7) ? qscale : 1.f;
#pragma unroll
        for (int ai = 0; ai < 2; ++ai)
#pragma unroll
            for (int m = 0; m < 4; ++m) { bf16_t* rowp = O + (size_t)(row0 + ai * HALF + m * 16) * 3072 + col0;
#pragma unroll
                for (int bj = 0; bj < 2; ++bj) { const f32x4 v0 = acc[ai][bj][m][0] * sc, v1 = acc[ai][bj][m][1] * sc;
                    u32x4 w; w.x = cvt_pk_bf16(v0[0], v0[1]); w.y = cvt_pk_bf16(v0[2], v0[3]); w.z = cvt_pk_bf16(v1[0], v1[1]); w.w = cvt_pk_bf16(v1[2], v1[3]);
                    *(u32x4*)(rowp + bj * HALF) = w; } }
    }
};
struct EpiResBf16 {
    static constexpr bool PERM = true, AFTER_DRAIN = false;
    const float* base; bf16_t* out;
    __device__ __forceinline__ void operator()(const f32x4 (&acc)[2][2][4][2], const Unit& u, int wr, int wc, int fr, int fq) const {
        const int col0 = u.pn * BM + wc * 32 + 8 * fq;
#pragma unroll
        for (int ai = 0; ai < 2; ++ai)
#pragma unroll
            for (int m = 0; m < 4; ++m) { const size_t off = (size_t)(u.pm * BM + ai * HALF + wr * 64 + m * 16 + fr) * 1024 + col0;
#pragma unroll
                for (int bj = 0; bj < 2; ++bj) { const f32x4 v0 = *(const f32x4*)(base + off + bj * HALF) + acc[ai][bj][m][0], v1 = *(const f32x4*)(base + off + bj * HALF + 4) + acc[ai][bj][m][1];
                    u32x4 w; w.x = cvt_pk_bf16(v0[0], v0[1]); w.y = cvt_pk_bf16(v0[2], v0[3]); w.z = cvt_pk_bf16(v1[0], v1[1]); w.w = cvt_pk_bf16(v1[2], v1[3]);
                    *(u32x4*)(out + off + bj * HALF) = w; } }
    }
};
constexpr int F6_BLOCK = 24576;
__host__ __device__ __forceinline__ int f6_p_off(int r, int fq) { return (r >> 4) * 1024 + (r & 15) * 64 + ((fq ^ (((r & 15) >> 3) << 1)) * 16); }
__host__ __device__ __forceinline__ int f6_q_off(int r, int fq) { return (r >> 4) * 512 + (r & 15) * 32 + ((fq ^ (((r & 15) >> 3) << 1)) * 8); }
typedef float f32x16e __attribute__((ext_vector_type(16)));
typedef unsigned u32x6e __attribute__((ext_vector_type(6)));
#ifdef EMU6
constexpr float XS8 = X6, WS8 = W6, WS8D = W6D, HS8 = H6;
__device__ __forceinline__ float q6(float t) { const float a = __builtin_fminf(__builtin_fabsf(t), 7.5f); const float st = a < 2.f ? 8.f : (a < 4.f ? 4.f : 2.f); const float r = __builtin_rintf(a * st) / st; return __builtin_copysignf(r, t); }
#elif MK_FP6
#if MK_FP6 == 2
constexpr float XS8 = 2.f, WS8 = 64.f, WS8D = 106.f, HS8 = 1.f;
#else
constexpr float XS8 = 2.f, WS8 = 64.f, WS8D = 128.f, HS8 = 8.f;
#endif
__device__ __forceinline__ float q6(float t) { return t; }
#else
constexpr float XS8 = 8.f, WS8 = 128.f, WS8D = 128.f, HS8 = 8.f;
__device__ __forceinline__ float q6(float t) { return t; }
#endif
struct EpiSwiGLU8 {
    static constexpr bool PERM = true, AFTER_DRAIN = false;
    unsigned char* O;
    __device__ __forceinline__ void operator()(const f32x4 (&acc)[2][2][4][2], const Unit& u, int wr, int wc, int fr, int fq) const {
        const int pnl = u.pn % 22;
        const int row0 = u.pm * BM + wr * 64 + fr, col0 = pnl * 128 + wc * 32 + 8 * fq;
        constexpr float inv = 1.f / (XS8 * WS8);
#pragma unroll
        for (int ai = 0; ai < 2; ++ai)
#pragma unroll
            for (int m = 0; m < 4; ++m) { unsigned char* rowp = O + (size_t)(row0 + ai * HALF + m * 16) * 2816 + col0;
#ifdef EPI_DUP
              for (int rep = 0; rep < 2; ++rep) {
                float rsc = 1.f; asm volatile("" : "+v"(rsc));
#endif
                float h[8];
#pragma unroll
                for (int n = 0; n < 2; ++n)
#pragma unroll
                    for (int j = 0; j < 4; j += 2) {
#ifdef EPI_DUP
                        const f32x2 ag = {acc[ai][0][m][n][j] * rsc, acc[ai][0][m][n][j + 1] * rsc}, au = {acc[ai][1][m][n][j], acc[ai][1][m][n][j + 1]};
#else
                        const f32x2 ag = {acc[ai][0][m][n][j], acc[ai][0][m][n][j + 1]}, au = {acc[ai][1][m][n][j], acc[ai][1][m][n][j + 1]};
#endif

                        const f32x2 t = ag * (-inv * 1.4426950408889634f); f32x2 d; d.x = __builtin_amdgcn_exp2f(t.x); d.y = __builtin_amdgcn_exp2f(t.y); d = d + 1.0f;
                        f32x2 r; r.x = __builtin_amdgcn_rcpf(d.x); r.y = __builtin_amdgcn_rcpf(d.y);
                        const f32x2 hv = (ag * au) * (r * (inv * inv * HS8));
                        h[n * 4 + j] = q6(__builtin_amdgcn_fmed3f(hv.x, -448.f, 448.f)); h[n * 4 + j + 1] = q6(__builtin_amdgcn_fmed3f(hv.y, -448.f, 448.f)); }
                int w0 = 0, w1 = 0;
                w0 = __builtin_amdgcn_cvt_pk_fp8_f32(h[0], h[1], w0, false); w0 = __builtin_amdgcn_cvt_pk_fp8_f32(h[2], h[3], w0, true);
                w1 = __builtin_amdgcn_cvt_pk_fp8_f32(h[4], h[5], w1, false); w1 = __builtin_amdgcn_cvt_pk_fp8_f32(h[6], h[7], w1, true);
#ifdef EPI_DUP
                if (rep == 0) { asm volatile("" :: "v"(w0), "v"(w1)); continue; }
#endif
                u32x2 w; w.x = (unsigned)w0; w.y = (unsigned)w1; *(u32x2*)rowp = w;
#ifdef EPI_DUP
              }
#endif
            }
    }
};
struct EpiSwiGLU6 {
    static constexpr bool PERM = true, AFTER_DRAIN = false;
    unsigned char* O;
    __device__ __forceinline__ void operator()(const f32x4 (&acc)[2][2][4][2], const Unit& u, int wr, int wc, int fr, int fq) const {
        const int pnl = u.pn % 22;
        unsigned char* blk = O + ((size_t)u.pm * 22 + pnl) * F6_BLOCK;
        const int r = wr * 64 + fq * 16 + fr;
        constexpr float inv = 1.f / (XS8 * WS8);
#pragma unroll
        for (int ai = 0; ai < 2; ++ai) {
            unsigned h[4][8];
#pragma unroll
            for (int m = 0; m < 4; ++m)
#pragma unroll
                for (int n = 0; n < 2; ++n)
#pragma unroll
                    for (int j = 0; j < 4; j += 2) { const f32x2 ag = {acc[ai][0][m][n][j], acc[ai][0][m][n][j + 1]}, au = {acc[ai][1][m][n][j], acc[ai][1][m][n][j + 1]};
                        const f32x2 t = ag * (-inv * 1.4426950408889634f); f32x2 d; d.x = __builtin_amdgcn_exp2f(t.x); d.y = __builtin_amdgcn_exp2f(t.y); d = d + 1.0f;
                        f32x2 rr; rr.x = __builtin_amdgcn_rcpf(d.x); rr.y = __builtin_amdgcn_rcpf(d.y);
                        const f32x2 hv = (ag * au) * (rr * (inv * inv * HS8));
                        h[m][n * 4 + j] = __builtin_bit_cast(unsigned, __builtin_amdgcn_fmed3f(hv.x, -7.5f, 7.5f)); h[m][n * 4 + j + 1] = __builtin_bit_cast(unsigned, __builtin_amdgcn_fmed3f(hv.y, -7.5f, 7.5f)); }
#pragma unroll
            for (int k = 0; k < 8; ++k) { auto s0 = __builtin_amdgcn_permlane32_swap(h[0][k], h[2][k], false, false); h[0][k] = s0[0]; h[2][k] = s0[1];
                                          auto s1 = __builtin_amdgcn_permlane32_swap(h[1][k], h[3][k], false, false); h[1][k] = s1[0]; h[3][k] = s1[1]; }
#pragma unroll
            for (int k = 0; k < 8; ++k) { auto s0 = __builtin_amdgcn_permlane16_swap(h[0][k], h[1][k], false, false); h[0][k] = s0[0]; h[1][k] = s0[1];
                                          auto s1 = __builtin_amdgcn_permlane16_swap(h[2][k], h[3][k], false, false); h[2][k] = s1[0]; h[3][k] = s1[1]; }
            f32x16e lo, hi;
#pragma unroll
            for (int k = 0; k < 8; ++k) { lo[k] = __builtin_bit_cast(float, h[0][k]); lo[8 + k] = __builtin_bit_cast(float, h[1][k]); hi[k] = __builtin_bit_cast(float, h[2][k]); hi[8 + k] = __builtin_bit_cast(float, h[3][k]); }
            const u32x6e pk = __builtin_amdgcn_cvt_scalef32_2xpk16_fp6_f32(lo, hi, 1.0f);
            *(u32x4*)(blk + ai * 8192 + f6_p_off(r, wc)) = (u32x4){pk[0], pk[1], pk[2], pk[3]};
            *(u32x2*)(blk + 16384 + ai * 4096 + f6_q_off(r, wc)) = (u32x2){pk[4], pk[5]};
        }
    }
};
struct EpiDown8 {
    static constexpr bool PERM = true, AFTER_DRAIN = false;
    bf16_t* O; const float* gate;
    __device__ __forceinline__ void operator()(const f32x4 (&acc)[2][2][4][2], const Unit& u, int wr, int wc, int fr, int fq) const {
        const int pnl = u.pn & 3;
        const int row0 = u.pm * BM + wr * 64 + fr, col0 = pnl * BM + wc * 32 + 8 * fq;
#pragma unroll
        for (int ai = 0; ai < 2; ++ai)
#pragma unroll
            for (int m = 0; m < 4; ++m) { const int row = row0 + ai * HALF + m * 16; const float gt = gate[row] * (1.f / (HS8 * WS8D)); bf16_t* rowp = O + (size_t)row * 1024 + col0;
#pragma unroll
                for (int bj = 0; bj < 2; ++bj) { const f32x4 v0 = acc[ai][bj][m][0] * gt, v1 = acc[ai][bj][m][1] * gt;
                    u32x4 w; w.x = cvt_pk_bf16(v0[0], v0[1]); w.y = cvt_pk_bf16(v0[2], v0[3]); w.z = cvt_pk_bf16(v1[0], v1[1]); w.w = cvt_pk_bf16(v1[2], v1[3]);
                    *(u32x4*)(rowp + bj * HALF) = w; } }
    }
};

struct FragBf { bf16x8 v[2]; };
struct FragF8 { i32x8 v; };
template <bool F8> struct FragSel { typedef FragBf type; };
template <> struct FragSel<true> { typedef FragF8 type; };
__device__ __forceinline__ void frag_ld(FragBf& f, const PG8_LAS unsigned char* p) { f.v[0] = *(const PG8_LAS bf16x8*)p; f.v[1] = *(const PG8_LAS bf16x8*)(p + 1024); }
__device__ __forceinline__ void frag_ld(FragF8& f, const PG8_LAS unsigned char* p) { const i32x4 lo = *(const PG8_LAS i32x4*)p, hi = *(const PG8_LAS i32x4*)(p + 1024); f.v = __builtin_shufflevector(lo, hi, 0, 1, 2, 3, 4, 5, 6, 7); }
__device__ __forceinline__ f32x4 frag_mma(const FragBf& b, const FragBf& a, f32x4 c) { c = __builtin_amdgcn_mfma_f32_16x16x32_bf16(b.v[0], a.v[0], c, 0, 0, 0); return __builtin_amdgcn_mfma_f32_16x16x32_bf16(b.v[1], a.v[1], c, 0, 0, 0); }
__device__ __forceinline__ f32x4 frag_mma(const FragF8& b, const FragF8& a, f32x4 c) { asm volatile("v_mfma_f32_16x16x128_f8f6f4 %0, %1, %2, %0" : "+v"(c) : "v"(b.v), "v"(a.v)); return c; }
template <class Epi, class Sched, bool ALIGN_EPI = false, bool SP2 = false, bool F8 = false>
__device__ __forceinline__ void gemm_phase(PG8_LAS unsigned char* lds, const Gemm g, const Sched& S, const Epi& E, const int wid  ) {
    int lane; asm volatile("v_mbcnt_lo_u32_b32 %0, -1, 0\n\tv_mbcnt_hi_u32_b32 %0, -1, %0" : "=v"(lane));
    const int tid = wid * 64 + lane, wr = wid >> 2, wc = wid & 3, fr = lane & 15, fq = lane >> 4;
    const int K = g.K, nt = K / BK;
    unsigned voffA[2], voffB[2];
#pragma unroll
    for (int i = 0; i < 2; ++i) { int R, C; stage_rc(tid * 16 + i * 8192, R, C); const int Rb = Epi::PERM ? ((R & ~31) + perm32(R & 31)) : R;
        voffA[i] = (unsigned)(R * K + C) * 2u; voffB[i] = (unsigned)(Rb * K + C) * 2u; }
    const size_t kstep = (size_t)(BK * 2);
    const size_t hstep = (size_t)HALF * K * 2;
    const size_t tstep = 2 * hstep;
    const unsigned ldsw = (unsigned)wid * 1024u;
    const int aoff = lds_byte(wr * 64 + fr, fq * 8), boff = lds_byte(wc * 32 + fr, fq * 8);
#define PG8_SA(b, h) (((b) * 2 + (h)) * HTB)
#define PG8_SB(b, h) ((4 + (b) * 2 + (h)) * HTB)
#define PG8_STAGE(bufoff, gbase, voff) do { _Pragma("unroll") for (int _i = 0; _i < 2; ++_i) \
        __builtin_amdgcn_global_load_lds((const unsigned*)((const char*)(gbase) + (voff)[_i]), (PG8_LAS unsigned*)(lds + (bufoff) + ldsw + _i * 8192), 16, 0, 0); } while (0)
#define PG8_LDA(dst, b, h) do { _Pragma("unroll") for (int m = 0; m < 4; ++m) frag_ld(dst[m], lds + PG8_SA(b, h) + aoff + m * 2048); } while (0)
#define PG8_LDB(dst, b, h) do { _Pragma("unroll") for (int n = 0; n < 2; ++n) frag_ld(dst[n], lds + PG8_SB(b, h) + boff + n * 2048); } while (0)
#define PG8_MMA(ai, bj, At, Bt) do { __builtin_amdgcn_s_setprio(1); _Pragma("unroll") for (int m = 0; m < 4; ++m) _Pragma("unroll") for (int n = 0; n < 2; ++n) \
        acc[ai][bj][m][n] = frag_mma(Bt[n], At[m], acc[ai][bj][m][n]); __builtin_amdgcn_s_setprio(0); } while (0)
#define PG8_WAIT_V(n) asm volatile("s_waitcnt vmcnt(" #n ")" ::: "memory")
#define PG8_WAIT_L(n) asm volatile("s_waitcnt lgkmcnt(" #n ")" ::: "memory")
#define PG8_BAR __builtin_amdgcn_s_barrier()
#define PG8_SCHED __builtin_amdgcn_sched_barrier(0)
    Unit cur, nxt; int ui = 0;
    if (!S.next(0, cur)) return;
    f32x4 acc[2][2][4][2];
#pragma unroll
    for (int a = 0; a < 2; ++a)
#pragma unroll
        for (int b = 0; b < 2; ++b)
#pragma unroll
            for (int m = 0; m < 4; ++m)
#pragma unroll
                for (int n = 0; n < 2; ++n) acc[a][b][m][n] = (f32x4){0.f, 0.f, 0.f, 0.f};
    typename FragSel<F8>::type At[4], B0[2], B1[2];
    const char* cA = (const char*)g.A + (size_t)cur.pm * tstep; const char* cB = (const char*)g.Bt + (size_t)cur.pn * tstep;
    S.a_ready(cur);
    if constexpr (SP2) {
        PG8_STAGE(PG8_SB(0, 0), cB, voffB); PG8_STAGE(PG8_SB(0, 1), cB + hstep, voffB); PG8_STAGE(PG8_SA(0, 0), cA, voffA); PG8_STAGE(PG8_SA(0, 1), cA + hstep, voffA);
        if (wr == 1) PG8_BAR;
        PG8_WAIT_V(2); PG8_BAR;
        PG8_STAGE(PG8_SB(1, 0), cB + kstep, voffB); PG8_STAGE(PG8_SA(1, 0), cA + kstep, voffA); PG8_STAGE(PG8_SB(1, 1), cB + hstep + kstep, voffB);
        PG8_WAIT_V(6); PG8_BAR;
    } else {
        PG8_STAGE(PG8_SB(0, 0), cB, voffB); PG8_STAGE(PG8_SA(0, 0), cA, voffA); PG8_STAGE(PG8_SB(0, 1), cB + hstep, voffB); PG8_STAGE(PG8_SA(0, 1), cA + hstep, voffA);
        if (wr == 1) PG8_BAR;
        PG8_WAIT_V(4); PG8_BAR;
        PG8_STAGE(PG8_SB(1, 0), cB + kstep, voffB); PG8_STAGE(PG8_SA(1, 0), cA + kstep, voffA); PG8_STAGE(PG8_SB(1, 1), cB + hstep + kstep, voffB);
        PG8_WAIT_V(6); PG8_BAR;
    }
    for (;;) {
        const bool has_next = S.next(ui + 1, nxt);
        const char* nA = has_next ? (const char*)g.A + (size_t)nxt.pm * tstep : cA; const char* nB = has_next ? (const char*)g.Bt + (size_t)nxt.pn * tstep : cB;
        for (int t = 0; t < nt; t += 2) {
            const bool last = (t == nt - 2);
            const char* a1 = cA + (size_t)(t + 1) * kstep;
            const char* a2 = last ? nA : cA + (size_t)(t + 2) * kstep; const char* b2 = last ? nB : cB + (size_t)(t + 2) * kstep;
            const char* a3 = a2 + kstep; const char* b3 = b2 + kstep;
            if (last && has_next) S.a_ready(nxt);
            if constexpr (SP2) {
            PG8_LDB(B0, 0, 0); PG8_LDB(B1, 0, 1); PG8_SCHED; PG8_LDA(At, 0, 0); PG8_STAGE(PG8_SA(1, 1), a1 + hstep, voffA);
            PG8_WAIT_V(8); PG8_WAIT_L(0); PG8_BAR; PG8_MMA(0, 0, At, B0); PG8_MMA(0, 1, At, B1); PG8_BAR; PG8_SCHED;
            PG8_LDA(At, 0, 1); PG8_STAGE(PG8_SB(0, 0), b2, voffB); PG8_STAGE(PG8_SB(0, 1), b2 + hstep, voffB); PG8_STAGE(PG8_SA(0, 0), a2, voffA);
            PG8_WAIT_V(8); PG8_WAIT_L(0); PG8_BAR; PG8_MMA(1, 0, At, B0); PG8_MMA(1, 1, At, B1); PG8_BAR; PG8_SCHED;
            PG8_LDB(B0, 1, 0); PG8_LDB(B1, 1, 1); PG8_SCHED; PG8_LDA(At, 1, 0); PG8_STAGE(PG8_SA(0, 1), a2 + hstep, voffA);
            PG8_WAIT_V(8); PG8_WAIT_L(0); PG8_BAR; PG8_MMA(0, 0, At, B0); PG8_MMA(0, 1, At, B1); PG8_BAR; PG8_SCHED;
            PG8_LDA(At, 1, 1); PG8_STAGE(PG8_SB(1, 0), b3, voffB); PG8_STAGE(PG8_SB(1, 1), b3 + hstep, voffB); PG8_STAGE(PG8_SA(1, 0), a3, voffA);
            PG8_WAIT_V(8); PG8_WAIT_L(0); PG8_BAR; PG8_MMA(1, 0, At, B0); PG8_MMA(1, 1, At, B1); PG8_BAR; PG8_SCHED;
            } else {
            PG8_LDB(B0, 0, 0); PG8_SCHED; PG8_LDA(At, 0, 0); PG8_STAGE(PG8_SA(1, 1), a1 + hstep, voffA);
            PG8_WAIT_L(8); PG8_BAR; PG8_WAIT_L(0); PG8_MMA(0, 0, At, B0); PG8_BAR; PG8_SCHED;
            PG8_LDB(B1, 0, 1); PG8_STAGE(PG8_SB(0, 0), b2, voffB);
            PG8_BAR; PG8_WAIT_L(0); PG8_MMA(0, 1, At, B1); PG8_BAR;
            PG8_LDA(At, 0, 1); PG8_STAGE(PG8_SA(0, 0), a2, voffA);
            PG8_BAR; PG8_WAIT_L(0); PG8_MMA(1, 0, At, B0); PG8_BAR; PG8_SCHED;
            PG8_STAGE(PG8_SB(0, 1), b2 + hstep, voffB);
            PG8_WAIT_V(6); PG8_BAR; PG8_MMA(1, 1, At, B1); PG8_BAR;
            PG8_LDB(B0, 1, 0); PG8_SCHED; PG8_LDA(At, 1, 0); PG8_STAGE(PG8_SA(0, 1), a2 + hstep, voffA);
            PG8_WAIT_L(8); PG8_BAR; PG8_WAIT_L(0); PG8_MMA(0, 0, At, B0); PG8_BAR; PG8_SCHED;
            PG8_LDB(B1, 1, 1); PG8_STAGE(PG8_SB(1, 0), b3, voffB);
            PG8_BAR; PG8_WAIT_L(0); PG8_MMA(0, 1, At, B1); PG8_BAR;
            PG8_LDA(At, 1, 1); PG8_STAGE(PG8_SA(1, 0), a3, voffA);
            PG8_BAR; PG8_WAIT_L(0); PG8_MMA(1, 0, At, B0); PG8_BAR; PG8_SCHED;
            PG8_STAGE(PG8_SB(1, 1), b3 + hstep, voffB);
            PG8_WAIT_V(6); PG8_BAR; PG8_MMA(1, 1, At, B1); PG8_BAR;
            }
        }
        if constexpr (F8) asm volatile("s_nop 15\n\ts_nop 7" ::: "memory");
        if constexpr (ALIGN_EPI) { if (wr == 0) PG8_BAR; }
        if constexpr (!Epi::AFTER_DRAIN) { E(acc, cur, wr, wc, fr, fq); S.done(cur); }
        if (!has_next) break;
#pragma unroll
        for (int a = 0; a < 2; ++a)
#pragma unroll
            for (int b = 0; b < 2; ++b)
#pragma unroll
                for (int m = 0; m < 4; ++m)
#pragma unroll
                    for (int n = 0; n < 2; ++n) acc[a][b][m][n] = (f32x4){0.f, 0.f, 0.f, 0.f};
        cur = nxt; cA = nA; cB = nB; ++ui;
        if constexpr (ALIGN_EPI) { if (wr == 1) PG8_BAR; }
    }
    PG8_WAIT_V(0);
    if constexpr (!ALIGN_EPI) { if (wr == 0) PG8_BAR; }
    PG8_BAR;
    if constexpr (Epi::AFTER_DRAIN) { E.fused(acc, cur, wr, wc, fr, fq, lds, wid, lane); S.done(cur); }
#undef PG8_SA
#undef PG8_SB
#undef PG8_STAGE
#undef PG8_LDA
#undef PG8_LDB
#undef PG8_MMA
#undef PG8_WAIT_V
#undef PG8_WAIT_L
#undef PG8_BAR
#undef PG8_SCHED
}

typedef unsigned u32x6 __attribute__((ext_vector_type(6)));
__device__ __forceinline__ f32x4 mma6(const u32x6& b, const u32x6& a, f32x4 c) { asm volatile("v_mfma_f32_16x16x128_f8f6f4 %0, %1, %2, %0 cbsz:2 blgp:2" : "+v"(c) : "v"(b), "v"(a)); return c; }
constexpr int F6_BUF = 49152;
template <class Epi, class Sched, bool ALIGN_EPI, int F6_KT  >
__device__ __forceinline__ void gemm_phase6(PG8_LAS unsigned char* lds, const unsigned char* Aimg, const unsigned char* Bimg, const Sched& S, const Epi& E, const int wid) {
    int lane; asm volatile("v_mbcnt_lo_u32_b32 %0, -1, 0\n\tv_mbcnt_hi_u32_b32 %0, -1, %0" : "=v"(lane));
    const int wr = wid >> 2, wc = wid & 3, fr = lane & 15, fq = lane >> 4;
    const unsigned goff = (unsigned)(wid * 1024 + lane * 16);
    const unsigned ldsw = (unsigned)wid * 1024u;
    const size_t kstep = F6_BLOCK, tstep = (size_t)F6_KT * F6_BLOCK;
    const int pa = f6_p_off(wr * 64 + fr, fq), qa = f6_q_off(wr * 64 + fr, fq), pb = f6_p_off(wc * 32 + fr, fq), qb = f6_q_off(wc * 32 + fr, fq);
#define F6_AP(b, h) ((b) * F6_BUF + (h) * 8192)
#define F6_BP(b, h) ((b) * F6_BUF + 16384 + (h) * 8192)
#define F6_AQ(b) ((b) * F6_BUF + 32768)
#define F6_BQ(b) ((b) * F6_BUF + 40960)
#define F6_ST(ldsoff, gptr) __builtin_amdgcn_global_load_lds((const unsigned*)((const char*)(gptr) + goff), (PG8_LAS unsigned*)(lds + (ldsoff) + ldsw), 16, 0, 0)
#define F6_STAGE_X(b, ga, gb) do { F6_ST(F6_BP(b, 0), (gb)); F6_ST(F6_BP(b, 1), (gb) + 8192); F6_ST(F6_BQ(b), (gb) + 16384); F6_ST(F6_AQ(b), (ga) + 16384); F6_ST(F6_AP(b, 0), (ga)); } while (0)
#define F6_STAGE_Y(b, ga) F6_ST(F6_AP(b, 1), (ga) + 8192)
#define F6_FRAG(dst, poff, qoff) do { const u32x4 _lo = *(const PG8_LAS u32x4*)(lds + (poff)); const u32x2 _hi = *(const volatile PG8_LAS u32x2*)(lds + (qoff));     dst = (u32x6){_lo.x, _lo.y, _lo.z, _lo.w, _hi.x, _hi.y}; } while (0)
#define F6_LDB(dst, b, h) do { _Pragma("unroll") for (int n = 0; n < 2; ++n) F6_FRAG(dst[n], F6_BP(b, h) + pb + n * 1024, F6_BQ(b) + (h) * 4096 + qb + n * 512); } while (0)
#define F6_LDA0(b) do { _Pragma("unroll") for (int m = 0; m < 4; ++m) F6_FRAG(At[m], F6_AP(b, 0) + pa + m * 1024, F6_AQ(b) + qa + m * 512); \
        _Pragma("unroll") for (int m = 0; m < 4; ++m) Aq[m] = *(const volatile PG8_LAS u32x2*)(lds + F6_AQ(b) + 4096 + qa + m * 512); } while (0)
#define F6_LDA1(b) do { _Pragma("unroll") for (int m = 0; m < 4; ++m) { const u32x4 _lo = *(const PG8_LAS u32x4*)(lds + F6_AP(b, 1) + pa + m * 1024); At[m] = (u32x6){_lo.x, _lo.y, _lo.z, _lo.w, Aq[m].x, Aq[m].y}; } } while (0)
#define F6_MMA(ai, bj, Bt) do { __builtin_amdgcn_s_setprio(1); _Pragma("unroll") for (int m = 0; m < 4; ++m) _Pragma("unroll") for (int n = 0; n < 2; ++n) \
        acc[ai][bj][m][n] = mma6(Bt[n], At[m], acc[ai][bj][m][n]); __builtin_amdgcn_s_setprio(0); } while (0)
#define F6_WAIT_V(n) asm volatile("s_waitcnt vmcnt(" #n ")" ::: "memory")
#define F6_WAIT_L(n) asm volatile("s_waitcnt lgkmcnt(" #n ")" ::: "memory")
#define F6_BAR __builtin_amdgcn_s_barrier()
#define F6_SCHED __builtin_amdgcn_sched_barrier(0)
    Unit cur, nxt; int ui = 0;
    if (!S.next(0, cur)) return;
    f32x4 acc[2][2][4][2];
#pragma unroll
    for (int a = 0; a < 2; ++a)
#pragma unroll
        for (int b = 0; b < 2; ++b)
#pragma unroll
            for (int m = 0; m < 4; ++m)
#pragma unroll
                for (int n = 0; n < 2; ++n) acc[a][b][m][n] = (f32x4){0.f, 0.f, 0.f, 0.f};
    u32x6 At[4], B0[2], B1[2]; u32x2 Aq[4];
    const char* cA = (const char*)Aimg + (size_t)cur.pm * tstep; const char* cB = (const char*)Bimg + (size_t)cur.pn * tstep;
    F6_STAGE_X(0, cA, cB); F6_STAGE_Y(0, cA);
    if (wr == 1) F6_BAR;
    F6_WAIT_V(1); F6_BAR;
    F6_STAGE_X(1, cA + kstep, cB + kstep);
    F6_WAIT_V(5); F6_BAR;
    for (;;) {
        const bool has_next = S.next(ui + 1, nxt);
        const char* nA = has_next ? (const char*)Aimg + (size_t)nxt.pm * tstep : cA; const char* nB = has_next ? (const char*)Bimg + (size_t)nxt.pn * tstep : cB;
        for (int t = 0; t < F6_KT; t += 2) {
            const bool last = (t == F6_KT - 2);
            const char* a1 = cA + (size_t)(t + 1) * kstep;
            const char* a2 = last ? nA : cA + (size_t)(t + 2) * kstep; const char* b2 = last ? nB : cB + (size_t)(t + 2) * kstep;
            const char* a3 = a2 + kstep; const char* b3 = b2 + kstep;
            F6_LDB(B0, 0, 0); F6_LDB(B1, 0, 1); F6_SCHED; F6_LDA0(0); F6_STAGE_Y(1, a1);
            F6_WAIT_V(6); F6_WAIT_L(0); F6_BAR; F6_MMA(0, 0, B0); F6_MMA(0, 1, B1); F6_BAR; F6_SCHED;
            F6_LDA1(0); F6_STAGE_X(0, a2, b2);
            F6_WAIT_V(6); F6_WAIT_L(0); F6_BAR; F6_MMA(1, 0, B0); F6_MMA(1, 1, B1); F6_BAR; F6_SCHED;
            F6_LDB(B0, 1, 0); F6_LDB(B1, 1, 1); F6_SCHED; F6_LDA0(1); F6_STAGE_Y(0, a2);
            F6_WAIT_V(6); F6_WAIT_L(0); F6_BAR; F6_MMA(0, 0, B0); F6_MMA(0, 1, B1); F6_BAR; F6_SCHED;
            F6_LDA1(1); F6_STAGE_X(1, a3, b3);
            F6_WAIT_V(6); F6_WAIT_L(0); F6_BAR; F6_MMA(1, 0, B0); F6_MMA(1, 1, B1); F6_BAR; F6_SCHED;
        }
        asm volatile("s_nop 15\n\ts_nop 7" ::: "memory");
        if constexpr (ALIGN_EPI) { if (wr == 0) F6_BAR; }
        E(acc, cur, wr, wc, fr, fq);
        if (!has_next) break;
#pragma unroll
        for (int a = 0; a < 2; ++a)
#pragma unroll
            for (int b = 0; b < 2; ++b)
#pragma unroll
                for (int m = 0; m < 4; ++m)
#pragma unroll
                    for (int n = 0; n < 2; ++n) acc[a][b][m][n] = (f32x4){0.f, 0.f, 0.f, 0.f};
        cur = nxt; cA = nA; cB = nB; ++ui;
        if constexpr (ALIGN_EPI) { if (wr == 1) F6_BAR; }
    }
    F6_WAIT_V(0);
    if constexpr (!ALIGN_EPI) { if (wr == 0) F6_BAR; }
    F6_BAR;
#undef F6_AP
#undef F6_BP
#undef F6_AQ
#undef F6_BQ
#undef F6_ST
#undef F6_STAGE_X
#undef F6_STAGE_Y
#undef F6_FRAG
#undef F6_LDB
#undef F6_LDA0
#undef F6_LDA1
#undef F6_MMA
#undef F6_WAIT_V
#undef F6_WAIT_L
#undef F6_BAR
#undef F6_SCHED
}
}

#define GAS __attribute__((address_space(1)))
#define LAS __attribute__((address_space(3)))
typedef unsigned short bf16;
typedef unsigned v4u __attribute__((ext_vector_type(4)));
typedef unsigned v2u __attribute__((ext_vector_type(2)));
typedef float f32x4 __attribute__((ext_vector_type(4)));
typedef float f32x16 __attribute__((ext_vector_type(16)));
typedef short bf16x8 __attribute__((ext_vector_type(8)));
typedef short s16x4 __attribute__((ext_vector_type(4)));
typedef GAS unsigned gu32;
#define RLX_AGENT __ATOMIC_RELAXED, __HIP_MEMORY_SCOPE_AGENT
#define LDS_WAIT() asm volatile("s_waitcnt lgkmcnt(0)" ::: "memory")
#define VM_WAIT() asm volatile("s_waitcnt vmcnt(0)" ::: "memory")
__device__ __forceinline__ unsigned f2bf(float f) { unsigned u = __builtin_bit_cast(unsigned, f); return (u + 0x7fffu + ((u >> 16) & 1u)) >> 16; }
__device__ __forceinline__ unsigned pk2(float lo, float hi) { return f2bf(lo) | (f2bf(hi) << 16); }
__device__ __forceinline__ float bf2f(unsigned short b) { return __builtin_bit_cast(float, (unsigned)b << 16); }
__device__ __forceinline__ float bflo(unsigned w) { return __builtin_bit_cast(float, w << 16); }
__device__ __forceinline__ float bfhi(unsigned w) { return __builtin_bit_cast(float, w & 0xffff0000u); }
__device__ __forceinline__ int fresh_lane() { int l; asm volatile("v_mbcnt_lo_u32_b32 %0, -1, 0\n\tv_mbcnt_hi_u32_b32 %0, -1, %0" : "=v"(l)); return l; }
__device__ __forceinline__ float wave_sum(float v) {
#pragma unroll
    for (int o = 1; o < 64; o <<= 1) v += __shfl_xor(v, o);
    return v;
}
__device__ __forceinline__ int t5_bucket(int rel) {
    const int n = rel < 0 ? -rel : rel;
    const int large = 8 + (n >= 15) + (n >= 27) + (n >= 50) + (n >= 91) + (n >= 166) + (n >= 305) + (n >= 559);
    return (rel > 0 ? 16 : 0) + (n < 8 ? n : large);
}

#define XB_TMO      128
#define XB_XCNT(j)  (256  + 64 * (j))
#define XB_XSUB(j)  (1280 + 64 * (j))
#define XB_XGEN(j)  (2304 + 64 * (j))
#define XB_TOP      3328
#define XB_TOPGEN   3392
#define XCD_BAR_WORDS 3456
#define XB_SPIN_CAP (1u << 18)

__device__ __forceinline__ unsigned xb_ld(unsigned* p)              { return __hip_atomic_load(p, __ATOMIC_RELAXED, __HIP_MEMORY_SCOPE_AGENT); }
__device__ __forceinline__ unsigned xb_add(unsigned* p, unsigned v) { return __hip_atomic_fetch_add(p, v, __ATOMIC_RELAXED, __HIP_MEMORY_SCOPE_AGENT); }
__device__ __forceinline__ unsigned xb_xcc_id() { return (unsigned)__builtin_amdgcn_s_getreg((3 << 11) | 20) & 0xFu; }
#define XB_SPIN(cond, bar) do { unsigned _sp = 0; while (cond) { __builtin_amdgcn_s_sleep(1); \
    if ((++_sp & 255u) == 0u) { if (xb_ld(&(bar)[XB_TMO])) break; if (_sp > XB_SPIN_CAP) { atomicAdd(&(bar)[XB_TMO], 1u); break; } } } } while (0)

struct XcdBarrier {
    unsigned* bar; unsigned x;
    volatile LAS unsigned* st;
};

__device__ __forceinline__ XcdBarrier xcd_barrier_post(unsigned* bar, volatile LAS unsigned* st, int tid) {
    XcdBarrier b; b.bar = bar; b.x = xb_xcc_id(); b.st = st;
    if (tid == 0) (void)xb_add(&bar[XB_XCNT(b.x)], 1u);
    return b;
}
__device__ __forceinline__ void xcd_barrier_complete(unsigned* bar, unsigned x, unsigned& nloc, unsigned& nx) {
    const unsigned G = gridDim.x * gridDim.y * gridDim.z;
    unsigned sum, cnt, mine, sp = 0u;
    for (;;) {
        sum = 0u; cnt = 0u; mine = 0u;
#pragma unroll
        for (unsigned j = 0; j < 16; ++j) { const unsigned c = xb_ld(&bar[XB_XCNT(j)]); sum += c; cnt += (c > 0u) ? 1u : 0u; mine = (j == x) ? c : mine; }
        if (sum == G) break;
        __builtin_amdgcn_s_sleep(1);
        if ((++sp & 255u) == 0u) { if (xb_ld(&bar[XB_TMO])) break; if (sp > XB_SPIN_CAP) { atomicAdd(&bar[XB_TMO], 1u); break; } }
    }
    nloc = mine > 0u ? mine : 1u; nx = cnt > 0u ? cnt : 1u;
}

__device__ __forceinline__ void xcd_barrier(const XcdBarrier& b, int tid) {
    asm volatile("s_waitcnt vmcnt(0)" ::: "memory");
    __syncthreads();
    if (tid == 0) {
        unsigned* bar = b.bar;
        __builtin_amdgcn_s_waitcnt(0);
        unsigned nloc = b.st[0], nx = b.st[1];
        if (nloc == 0u) { xcd_barrier_complete(bar, b.x, nloc, nx); b.st[0] = nloc; b.st[1] = nx; }
        const unsigned old = xb_add(&bar[XB_XSUB(b.x)], 1u);
        const unsigned gen = old / nloc;
        if (old + 1u == (gen + 1u) * nloc) {
            __builtin_amdgcn_fence(__ATOMIC_RELEASE, "agent");
            asm volatile("s_waitcnt vmcnt(0)" ::: "memory");
            const unsigned og = xb_add(&bar[XB_TOP], 1u);
            const unsigned tg = og / nx;
            if (og + 1u == (tg + 1u) * nx) xb_add(&bar[XB_TOPGEN], 1u);
            else XB_SPIN(xb_ld(&bar[XB_TOPGEN]) == tg, bar);
            __builtin_amdgcn_fence(__ATOMIC_ACQUIRE, "agent");
            xb_add(&bar[XB_XGEN(b.x)], 1u);
            asm volatile("s_waitcnt vmcnt(0)" ::: "memory");
        } else {
            XB_SPIN(xb_ld(&bar[XB_XGEN(b.x)]) == gen, bar);
            __builtin_amdgcn_fence(__ATOMIC_ACQUIRE, "agent");
            asm volatile("s_waitcnt vmcnt(0)" ::: "memory");
        }
    }
    __syncthreads();
}

struct Args {
    const float *x, *g1, *w_in, *lq1, *lk1, *lq2, *lk2, *subln, *w_out, *relb, *g2, *w_router, *w_gate, *w_up, *w_down, *gf;
    float* out; unsigned char* ws; int ph_lo, ph_hi, variant, pad;
};
struct Frame {
    LAS unsigned char* lds;
    volatile LAS unsigned* MISC;
    int wave, vcu, G;
};

__device__ __forceinline__ void transpose_item(const float* W, int N, bf16* WT, int KT, int k0, int n0, int orow0, LAS float* scr, int lane) {
#pragma unroll 32
    for (int i = 0; i < 32; ++i) { const int kk = 2 * i + (lane >> 5); scr[kk * 33 + (lane & 31)] = W[(size_t)(k0 + kk) * N + n0 + (lane & 31)]; }
    LDS_WAIT(); asm volatile("" ::: "memory");
    const int c = lane & 7;
#pragma unroll
    for (int j = 0; j < 4; ++j) { const int n = (lane >> 3) + 8 * j; const LAS float* s = scr + (8 * c) * 33 + n;
        v4u o; o.x = pk2(s[0 * 33], s[1 * 33]); o.y = pk2(s[2 * 33], s[3 * 33]); o.z = pk2(s[4 * 33], s[5 * 33]); o.w = pk2(s[6 * 33], s[7 * 33]);
        *(GAS v4u*)(WT + (size_t)(orow0 + n) * KT + k0 + 8 * c) = o; }
    LDS_WAIT(); asm volatile("" ::: "memory");
}
__device__ __forceinline__ int pk4_fp8(float a, float b, float c, float d) { a = pg8::q6(a); b = pg8::q6(b); c = pg8::q6(c); d = pg8::q6(d); int w = 0; w = __builtin_amdgcn_cvt_pk_fp8_f32(a, b, w, false); w = __builtin_amdgcn_cvt_pk_fp8_f32(c, d, w, true); return w; }
typedef float f32x4g __attribute__((ext_vector_type(4)));
__device__ __forceinline__ void t8_load(f32x4g (&wv)[16], const float* W, int N, int k0, int n0, int lane) {
    const float* src = W + (size_t)(k0 + 16 * (lane >> 4)) * N + n0 + 4 * (lane & 15);
#pragma unroll
    for (int j = 0; j < 16; ++j) wv[j] = __builtin_nontemporal_load((const GAS f32x4g*)(src + (size_t)j * N));
}
__device__ __forceinline__ void t8_store(const f32x4g (&wv)[16], unsigned char* WT, int KT, int k0, int orow0, int lane, float sc) {
    unsigned char* dst = WT + (size_t)(orow0 + 4 * (lane & 15)) * KT + k0 + 16 * (lane >> 4);
#pragma unroll
    for (int c = 0; c < 4; ++c) { v4u o;
#pragma unroll
        for (int q = 0; q < 4; ++q) o[q] = (unsigned)pk4_fp8(wv[4 * q][c] * sc, wv[4 * q + 1][c] * sc, wv[4 * q + 2][c] * sc, wv[4 * q + 3][c] * sc);
        __builtin_nontemporal_store(o, (GAS v4u*)(dst + (size_t)c * KT)); }
}
constexpr int CV_G1 = 16 * 44, CV_G = NE * CV_G1, CV_D1 = 44 * 16, CV_D = NE * CV_D1;
struct CvItem { const float* W; unsigned char* WT; int N, KT, k0, n0, orow0; float sc; };
__device__ __forceinline__ CvItem cv_decode(const Args& a, int r) {
    CvItem it;
    if (r < 2 * CV_G) { const int up = r >= CV_G; if (up) r -= CV_G; const int e = r / CV_G1, q = r % CV_G1, kb = q / 44, nb = q % 44, n0 = 64 * nb;
        it.W = (up ? a.w_up : a.w_gate) + (size_t)e * 1024 * DFF; it.N = DFF; it.WT = a.ws + WS_W1T + (size_t)e * 5632 * 1024; it.KT = 1024; it.k0 = 64 * kb; it.n0 = n0; it.orow0 = (n0 >> 7) * 256 + (n0 & 127) + (up ? 128 : 0); it.sc = pg8::WS8; }
    else { r -= 2 * CV_G; const int e = r / CV_D1, q = r % CV_D1, kb = q / 16, nb = q % 16;
        it.W = a.w_down + (size_t)e * DFF * 1024; it.N = 1024; it.WT = a.ws + WS_W2T + (size_t)e * 1024 * DFF; it.KT = DFF; it.k0 = 64 * kb; it.n0 = 64 * nb; it.orow0 = 64 * nb; it.sc = pg8::WS8D; }
    return it;
}
#if MK_FP6
typedef float f32x2g __attribute__((ext_vector_type(2)));
typedef float f32x16 __attribute__((ext_vector_type(16)));
typedef unsigned u32x6 __attribute__((ext_vector_type(6)));
__device__ __forceinline__ float clamp6(float v) { return __builtin_amdgcn_fmed3f(v, -7.5f, 7.5f); }
struct Cv6Item { const float* W; unsigned char* blk; int jb, N; float sc; };
__device__ __forceinline__ Cv6Item cv6_decode(const Args& a, int r) {
    Cv6Item it;
#if MK_FP6 == 2
    if (r >= 2 * CV_G) { r -= 2 * CV_G; const int e = r / CV_D1, q = r % CV_D1, kt = q / 32, nb = q % 32, n0 = 32 * nb;
        it.W = a.w_down + (size_t)e * DFF * 1024 + (size_t)(128 * kt) * 1024 + n0; it.blk = a.ws + WS_W2T + (size_t)((e * 4 + (n0 >> 8)) * 22 + kt) * pg8::F6_BLOCK; it.jb = n0 & 255; it.N = 1024; it.sc = pg8::WS8D;
        return it; }
#endif
    const int up = r >= CV_G; if (up) r -= CV_G; const int e = r / CV_G1, q = r % CV_G1, kt = q / 88, nb = q % 88, n0 = 32 * nb;
    it.W = (up ? a.w_up : a.w_gate) + (size_t)e * 1024 * DFF + (size_t)(128 * kt) * DFF + n0;
    it.blk = a.ws + WS_W1T + (size_t)((e * 22 + (n0 >> 7)) * 8 + kt) * pg8::F6_BLOCK; it.jb = (up ? 128 : 0) + (n0 & 127); it.N = DFF; it.sc = pg8::WS8;
    return it;
}
__device__ __forceinline__ void cv6_load(f32x2g (&wv)[32], const Cv6Item& it, int lane) {
    const float* src = it.W + (size_t)(32 * (lane >> 4)) * it.N + 2 * (lane & 15);
#pragma unroll
    for (int j = 0; j < 32; ++j) wv[j] = __builtin_nontemporal_load((const GAS f32x2g*)(src + (size_t)j * it.N));
}
__device__ __forceinline__ void cv6_store(const f32x2g (&wv)[32], const Cv6Item& it, int lane) {
    const int fq = lane >> 4;
#pragma unroll
    for (int i = 0; i < 2; ++i) { f32x16 lo, hi;
#pragma unroll
        for (int j = 0; j < 16; ++j) { lo[j] = clamp6(wv[j][i] * it.sc); hi[j] = clamp6(wv[16 + j][i] * it.sc); }
        const u32x6 pk = __builtin_amdgcn_cvt_scalef32_2xpk16_fp6_f32(lo, hi, 1.0f);
        const int x = 2 * (lane & 15) + i, rho = it.jb + ((x >> 2) & 1) * 16 + (x >> 3) * 4 + (x & 3), half = rho >> 7, rr = rho & 127;
        __builtin_nontemporal_store((v4u){pk[0], pk[1], pk[2], pk[3]}, (GAS v4u*)(it.blk + half * 8192 + pg8::f6_p_off(rr, fq)));
        __builtin_nontemporal_store((v2u){pk[4], pk[5]}, (GAS v2u*)(it.blk + 16384 + half * 4096 + pg8::f6_q_off(rr, fq))); }
}
__device__ __forceinline__ void cv6_run(const Args& a, int begin, int end, int cw, int CW) {
    const int lane = fresh_lane();
    int r = begin + cw; if (r >= end) return;
    f32x2g wa[32], wb[32];
    Cv6Item ia = cv6_decode(a, r), ib = ia;
    cv6_load(wa, ia, lane);
    for (;;) {
        const bool hb = r + CW < end;
        if (hb) { ib = cv6_decode(a, r + CW); cv6_load(wb, ib, lane); }
        cv6_store(wa, ia, lane);
        if (!hb) break;
        r += CW;
        const bool ha = r + CW < end;
        if (ha) { ia = cv6_decode(a, r + CW); cv6_load(wa, ia, lane); }
        cv6_store(wb, ib, lane);
        if (!ha) break;
        r += CW;
    }
}
#endif
__device__ __forceinline__ void cv_run(Frame& F, const Args& a, int begin, int end, int cw, int CW) {
    const int lane = fresh_lane();
    int r = begin + cw; if (r >= end) return;
    f32x4g wa[16], wb[16];
    CvItem ia = cv_decode(a, r), ib = ia;
    t8_load(wa, ia.W, ia.N, ia.k0, ia.n0, lane);
    for (;;) {
        const bool hb = r + CW < end;
        if (hb) { ib = cv_decode(a, r + CW); t8_load(wb, ib.W, ib.N, ib.k0, ib.n0, lane); }
        t8_store(wa, ia.WT, ia.KT, ia.k0, ia.orow0, lane, ia.sc);
        if (!hb) break;
        r += CW;
        const bool ha = r + CW < end;
        if (ha) { ia = cv_decode(a, r + CW); t8_load(wa, ia.W, ia.N, ia.k0, ia.n0, lane); }
        t8_store(wb, ib.WT, ib.KT, ib.k0, ib.orow0, lane, ib.sc);
        if (!ha) break;
        r += CW;
    }
}
__device__ __forceinline__ void rms_row_to_bf16(const float* xrow, const float* g, bf16* orow, int lane) {
    const GAS f32x4* xr = (const GAS f32x4*)xrow + lane; const GAS f32x4* gr = (const GAS f32x4*)g + lane;
    f32x4 v[4]; float s = 0.f;
#pragma unroll
    for (int j = 0; j < 4; ++j) { v[j] = xr[64 * j]; s += (v[j].x * v[j].x + v[j].y * v[j].y) + (v[j].z * v[j].z + v[j].w * v[j].w); }
    const float rstd = 1.f / sqrtf(wave_sum(s) * (1.f / DM) + NORM_EPS);
    GAS unsigned long long* o8 = (GAS unsigned long long*)orow + lane;
#pragma unroll
    for (int j = 0; j < 4; ++j) { const f32x4 gg = gr[64 * j]; const f32x4 y = v[j] * rstd * gg;
        o8[64 * j] = (unsigned long long)pk2(y.x, y.y) | ((unsigned long long)pk2(y.z, y.w) << 32); }
}
__device__ __forceinline__ void p0_prologue(Frame& F, const Args& a) {
    LAS float* scr = (LAS float*)(F.lds + RING_OFF + F.wave * 16384);
    const int gw = F.vcu * NWAVES + F.wave, NGW = F.G * NWAVES, lane0 = fresh_lane();
    bf16* win_t = (bf16*)(a.ws + WS_WIN); bf16* wout_t = (bf16*)(a.ws + WS_WOUT);
    constexpr int I_IN = 16 * 96, I_OUT = 16 * 32;
    for (int it = gw; it < I_IN + I_OUT; it += NGW) {
        int r = it;
        if (r < I_IN) { const int kb = r / 96, nb = r % 96; transpose_item(a.w_in, NIN, win_t, 1024, 64 * kb, 32 * nb, 32 * nb, scr, lane0); continue; } r -= I_IN;
        { const int kb = r / 32, nb = r % 32; transpose_item(a.w_out, 1024, wout_t, 1024, 64 * kb, 32 * nb, 32 * nb, scr, lane0); }
    }
    bf16* h1 = (bf16*)(a.ws + WS_H1);
    for (int m = gw; m < NTOK; m += NGW) rms_row_to_bf16(a.x + (size_t)m * DM, a.g1, h1 + (size_t)m * DM, lane0);
#if MK_FP6
#if MK_FP6 == 2
    cv6_run(a, 0, 2 * CV_G + CV_D, gw, NGW);
#else
    cv6_run(a, 0, 2 * CV_G, gw, NGW);
    cv_run(F, a, 2 * CV_G, 2 * CV_G + CV_D, gw, NGW);
#endif
#else
    cv_run(F, a, 0, 2 * CV_G + CV_D, gw, NGW);
#endif
}

__device__ __forceinline__ float xshfl(float v, int lane, int msk) { return __builtin_bit_cast(float, __builtin_amdgcn_ds_bpermute((lane ^ msk) << 2, __builtin_bit_cast(int, v))); }
__device__ __forceinline__ float reduce16(const float (&v)[16], int lane) {
    float w8[8], w4[4], w2[2];
    const bool b5 = lane & 32, b4 = lane & 16, b3 = lane & 8, b2 = lane & 4;
#pragma unroll
    for (int j = 0; j < 8; ++j) { const float keep = b5 ? v[j + 8] : v[j], send = b5 ? v[j] : v[j + 8]; w8[j] = keep + xshfl(send, lane, 32); }
#pragma unroll
    for (int j = 0; j < 4; ++j) { const float keep = b4 ? w8[j + 4] : w8[j], send = b4 ? w8[j] : w8[j + 4]; w4[j] = keep + xshfl(send, lane, 16); }
#pragma unroll
    for (int j = 0; j < 2; ++j) { const float keep = b3 ? w4[j + 2] : w4[j], send = b3 ? w4[j] : w4[j + 2]; w2[j] = keep + xshfl(send, lane, 8); }
    float w1 = (b2 ? w2[1] : w2[0]) + xshfl(b2 ? w2[0] : w2[1], lane, 4);
    w1 += xshfl(w1, lane, 2); w1 += xshfl(w1, lane, 1);
    return w1;
}
__device__ __forceinline__ void p4_router(Frame& F, const Args& a) {
    LAS float* wrT = (LAS float*)(F.lds + RING_OFF);
#if MK_FP6
    LAS float* tr = (LAS float*)(F.lds + RING_OFF + 65536 + F.wave * 8192);
#endif
    const int lane = fresh_lane();
    for (int i = F.wave * 64 + lane; i < 1024 * 16; i += NWAVES * 64) { const int k = i >> 4, e = i & 15; wrT[e * 1024 + k] = a.w_router[i]; }
    __syncthreads();
    const int gw = F.vcu * NWAVES + F.wave, NGW = F.G * NWAVES;
    const bf16* x2 = (const bf16*)(a.ws + WS_X2); unsigned char* h2 = a.ws + WS_H2; float* aff = (float*)(a.ws + WS_AFF); int* inv = (int*)(a.ws + WS_INV);
    f32x4 gg[4];
#pragma unroll
    for (int j = 0; j < 4; ++j) gg[j] = ((const GAS f32x4*)a.g2 + lane)[64 * j];
    v2u xn[2][4];
#pragma unroll
    for (int t = 0; t < 2; ++t) { const GAS v2u* xr = (const GAS v2u*)(x2 + (size_t)(gw + t * NGW) * DM) + lane;
#pragma unroll
        for (int j = 0; j < 4; ++j) xn[t][j] = xr[64 * j]; }
    for (int m = gw; m < NTOK; m += 2 * NGW) {
        f32x4 v[2][4]; float ss[2] = {0.f, 0.f};
#pragma unroll
        for (int t = 0; t < 2; ++t)
#pragma unroll
            for (int j = 0; j < 4; ++j) { const v2u xw = xn[t][j]; v[t][j] = (f32x4){bflo(xw.x), bfhi(xw.x), bflo(xw.y), bfhi(xw.y)}; ss[t] += (v[t][j].x * v[t][j].x + v[t][j].y * v[t][j].y) + (v[t][j].z * v[t][j].z + v[t][j].w * v[t][j].w); }
        if (m + 2 * NGW < NTOK) {
#pragma unroll
            for (int t = 0; t < 2; ++t) { const GAS v2u* xr = (const GAS v2u*)(x2 + (size_t)(m + (2 + t) * NGW) * DM) + lane;
#pragma unroll
                for (int j = 0; j < 4; ++j) xn[t][j] = xr[64 * j]; } }
#pragma unroll
        for (int t = 0; t < 2; ++t) { const float rstd = 1.f / sqrtf(wave_sum(ss[t]) * (1.f / DM) + NORM_EPS);
#if MK_FP6
#pragma unroll
            for (int j = 0; j < 4; ++j) { v[t][j] = v[t][j] * rstd * gg[j]; const int idx = t * 1024 + 256 * j + 4 * lane;
                *(LAS f32x4*)((LAS unsigned char*)tr + (idx >> 5) * 128 + ((((idx >> 2) ^ (idx >> 5)) & 7) * 16)) = v[t][j] * pg8::XS8; } }
        { LDS_WAIT(); f32x16 lo, hi;
#pragma unroll
          for (int i = 0; i < 4; ++i) { const f32x4 q0 = *(const LAS f32x4*)((const LAS unsigned char*)tr + lane * 128 + (((i ^ lane) & 7) * 16)), q1 = *(const LAS f32x4*)((const LAS unsigned char*)tr + lane * 128 + ((((4 + i) ^ lane) & 7) * 16));
              lo[4 * i] = clamp6(q0.x); lo[4 * i + 1] = clamp6(q0.y); lo[4 * i + 2] = clamp6(q0.z); lo[4 * i + 3] = clamp6(q0.w);
              hi[4 * i] = clamp6(q1.x); hi[4 * i + 1] = clamp6(q1.y); hi[4 * i + 2] = clamp6(q1.z); hi[4 * i + 3] = clamp6(q1.w); }
          const u32x6 pk = __builtin_amdgcn_cvt_scalef32_2xpk16_fp6_f32(lo, hi, 1.0f);
          unsigned char* hrow = h2 + (size_t)(m + (lane >> 5) * NGW) * 768;
          *(GAS v4u*)(hrow + (lane & 31) * 16) = (v4u){pk[0], pk[1], pk[2], pk[3]}; *(GAS v2u*)(hrow + 512 + (lane & 31) * 8) = (v2u){pk[4], pk[5]};
          asm volatile("" ::: "memory"); }
#else
            GAS int* o4 = (GAS int*)(h2 + (size_t)(m + t * NGW) * DM) + lane;
#pragma unroll
            for (int j = 0; j < 4; ++j) { v[t][j] = v[t][j] * rstd * gg[j]; const f32x4 q = v[t][j] * pg8::XS8; o4[64 * j] = pk4_fp8(pg8::clamp448(q.x), pg8::clamp448(q.y), pg8::clamp448(q.z), pg8::clamp448(q.w)); } }
#endif
        float lg[2][16];
        typedef float f32x2r __attribute__((ext_vector_type(2)));
        f32x2r vp[4][4];
#pragma unroll
        for (int j = 0; j < 4; ++j) { vp[j][0] = (f32x2r){v[0][j].x, v[1][j].x}; vp[j][1] = (f32x2r){v[0][j].y, v[1][j].y}; vp[j][2] = (f32x2r){v[0][j].z, v[1][j].z}; vp[j][3] = (f32x2r){v[0][j].w, v[1][j].w}; }
#pragma unroll
        for (int e = 0; e < 16; ++e) { f32x2r acc = {0.f, 0.f};
#pragma unroll
            for (int j = 0; j < 4; ++j) { const f32x4 w = *(const LAS f32x4*)(wrT + e * 1024 + 256 * j + 4 * lane);
                acc = __builtin_elementwise_fma(vp[j][0], (f32x2r){w.x, w.x}, acc); acc = __builtin_elementwise_fma(vp[j][1], (f32x2r){w.y, w.y}, acc);
                acc = __builtin_elementwise_fma(vp[j][2], (f32x2r){w.z, w.z}, acc); acc = __builtin_elementwise_fma(vp[j][3], (f32x2r){w.w, w.w}, acc); }
            asm volatile("" : "+v"(acc));
            lg[0][e] = acc.x; lg[1][e] = acc.y; __builtin_amdgcn_sched_barrier(0); }
#pragma unroll
        for (int t = 0; t < 2; ++t) {
            __builtin_amdgcn_sched_barrier(0);
            const float lgt = reduce16(lg[t], lane);
            float mx = lgt;
#pragma unroll
            for (int o = 4; o < 64; o <<= 1) mx = fmaxf(mx, xshfl(mx, lane, o));
            const float ex = __expf(lgt - mx); float sum = ex;
#pragma unroll
            for (int o = 4; o < 64; o <<= 1) sum += xshfl(sum, lane, o);
            const int row = m + t * NGW, b = row >> 12, spos = row & 4095;
            if ((lane & 3) == 0) aff[((size_t)(b * 16 + (lane >> 2))) * SEQ + spos] = ex / sum;
            if (lane < 16) inv[(size_t)row * 16 + lane] = -1;
            __builtin_amdgcn_sched_barrier(0); }
    }
}

__device__ __forceinline__ int block_excl_scan(int v, LAS int* tmp, int tid, int& total) {
    const int lane = tid & 63, w = tid >> 6; int x = v;
#pragma unroll
    for (int o = 1; o < 64; o <<= 1) { const int t = __shfl_up(x, o); if (lane >= o) x += t; }
    if (lane == 63) tmp[w] = x;
    __syncthreads();
    int off = 0, tot = 0;
#pragma unroll
    for (int j = 0; j < 8; ++j) { const int t = tmp[j]; tot += t; if (j < w) off += t; }
    __syncthreads();
    total = tot; return off + x - v;
}
__device__ __forceinline__ void p5_topk(Frame& F, const Args& a) {
    LAS unsigned* keys = (LAS unsigned*)(F.lds + RING_OFF);
    LAS unsigned* hist = keys + 4096;
    LAS int* tmp = (LAS int*)(hist + 256);
    LAS unsigned* bc = (LAS unsigned*)(tmp + 8);
    const float* aff = (const float*)(a.ws + WS_AFF); float* gate = (float*)(a.ws + WS_GATE); int* inv = (int*)(a.ws + WS_INV);
    const int tid = F.wave * 64 + fresh_lane();
    for (int pr = F.vcu; pr < BATCH * NE; pr += F.G) {
        const int b = pr >> 4, e = pr & 15;
        const float* src = aff + (size_t)pr * SEQ;
        unsigned k[8];
#pragma unroll
        for (int j = 0; j < 8; ++j) k[j] = __builtin_bit_cast(unsigned, src[tid * 8 + j]);
        unsigned prefix = 0u, need = CAP;
#pragma unroll 1
        for (int pass = 0; pass < 4; ++pass) {
            const int shift = 24 - 8 * pass;
            if (tid < 256) hist[tid] = 0u;
            __syncthreads();
#pragma unroll
            for (int j = 0; j < 8; ++j) { const bool in = (pass == 0) || ((k[j] >> (shift + 8)) == prefix);
                if (in) __hip_atomic_fetch_add(hist + ((k[j] >> shift) & 255u), 1u, __ATOMIC_RELAXED, __HIP_MEMORY_SCOPE_WORKGROUP); }
            __syncthreads();
            {
                const int hb = tid < 256 ? (int)hist[255 - tid] : 0; int tot; const int above = block_excl_scan(hb, tmp, tid, tot);
                if (tid < 256 && above < (int)need && above + hb >= (int)need) { bc[0] = (prefix << 8) | (unsigned)(255 - tid); bc[1] = need - (unsigned)above; } }
            __syncthreads();
            prefix = bc[0]; need = bc[1];
            __syncthreads();
        }
        const unsigned T = prefix;
        int ceq = 0;
#pragma unroll
        for (int j = 0; j < 8; ++j) ceq += (k[j] == T);
        int tot; int eqr = block_excl_scan(ceq, tmp, tid, tot);
        int csel = 0; bool sel[8];
#pragma unroll
        for (int j = 0; j < 8; ++j) { sel[j] = (k[j] > T) || (k[j] == T && eqr < (int)need); eqr += (k[j] == T); csel += sel[j]; }
        int slot = block_excl_scan(csel, tmp, tid, tot);
#pragma unroll
        for (int j = 0; j < 8; ++j) if (sel[j]) { const int s = tid * 8 + j; const size_t o = ((size_t)e * BATCH + b) * CAP + slot;
            gate[o] = __builtin_bit_cast(float, k[j]); inv[((size_t)b * SEQ + s) * 16 + e] = slot; ((LAS int*)keys)[slot] = s; ++slot; }
        __syncthreads();
#if MK_FP6
        { const int lane = tid & 63, G = lane & 31, kt = G >> 2, fq = G & 3; const unsigned char* h2 = a.ws + WS_H2;
          unsigned char* xe = a.ws + WS_XE + ((size_t)(e * BATCH + b) * 2 * 8 + kt) * pg8::F6_BLOCK;
#pragma unroll 4
          for (int c = (tid >> 6) * 2 + (lane >> 5); c < CAP; c += 2 * NWAVES) { const int tok = b * SEQ + ((LAS int*)keys)[c];
              const unsigned char* src = h2 + (size_t)tok * 768; const v4u pv = *(const GAS v4u*)(src + G * 16); const v2u qv = *(const GAS v2u*)(src + 512 + G * 8);
              unsigned char* blk = xe + (size_t)(c >> 8) * 8 * pg8::F6_BLOCK; const int half = (c >> 7) & 1, rr = c & 127;
              *(GAS v4u*)(blk + half * 8192 + pg8::f6_p_off(rr, fq)) = pv; *(GAS v2u*)(blk + 16384 + half * 4096 + pg8::f6_q_off(rr, fq)) = qv; } }
#else
        { const int lane = tid & 63; const unsigned char* h2 = a.ws + WS_H2; unsigned char* xe = a.ws + WS_XE + ((size_t)e * BATCH + b) * CAP * DM;
#pragma unroll 4
          for (int c = tid >> 6; c < CAP; c += NWAVES) { const int tok = b * SEQ + ((LAS int*)keys)[c];
              ((GAS v4u*)(xe + (size_t)c * DM))[lane] = ((const GAS v4u*)(h2 + (size_t)tok * DM))[lane]; } }
#endif
        __syncthreads();
    }
}

__device__ __forceinline__ void p8_combine(Frame& F, const Args& a) {
    const int gw = F.vcu * NWAVES + F.wave, NGW = F.G * NWAVES, lane = fresh_lane();
    const bf16* ye = (const bf16*)(a.ws + WS_YE); const int* inv = (const int*)(a.ws + WS_INV); const bf16* x2 = (const bf16*)(a.ws + WS_X2);
    f32x4 gg[4];
#pragma unroll
    for (int j = 0; j < 4; ++j) gg[j] = ((const GAS f32x4*)a.gf + lane)[64 * j];
    v2u xn[4]; int slotn = -1;
    if (gw < NTOK) { const GAS v2u* xs = (const GAS v2u*)(x2 + (size_t)gw * DM) + lane;
#pragma unroll
        for (int j = 0; j < 4; ++j) xn[j] = xs[64 * j];
        slotn = (lane < 16) ? inv[(size_t)gw * 16 + lane] : -1; }
    for (int m = gw; m < NTOK; m += NGW) {
        f32x4 v[4];
#pragma unroll
        for (int j = 0; j < 4; ++j) v[j] = (f32x4){bflo(xn[j].x), bfhi(xn[j].x), bflo(xn[j].y), bfhi(xn[j].y)};
        const int myslot = slotn;
        if (m + NGW < NTOK) { const GAS v2u* xs = (const GAS v2u*)(x2 + (size_t)(m + NGW) * DM) + lane;
#pragma unroll
            for (int j = 0; j < 4; ++j) xn[j] = xs[64 * j];
            slotn = (lane < 16) ? inv[(size_t)(m + NGW) * 16 + lane] : -1; }
        const int b = m >> 12;
        unsigned mask = (unsigned)__ballot(myslot >= 0) & 0xFFFFu;
        while (mask) {
            const int e0 = __builtin_ctz(mask); mask &= mask - 1; const bool two = mask != 0u; const int e1 = two ? __builtin_ctz(mask) : e0; if (two) mask &= mask - 1;
            const int c0 = __builtin_amdgcn_readlane(myslot, e0), c1 = __builtin_amdgcn_readlane(myslot, e1);
            const GAS v2u* y0 = (const GAS v2u*)(ye + ((size_t)(e0 * BATCH + b) * CAP + c0) * DM) + lane; const GAS v2u* y1 = (const GAS v2u*)(ye + ((size_t)(e1 * BATCH + b) * CAP + c1) * DM) + lane;
            v2u w0[4], w1[4];
#pragma unroll
            for (int j = 0; j < 4; ++j) { w0[j] = __builtin_nontemporal_load(y0 + 64 * j); w1[j] = __builtin_nontemporal_load(y1 + 64 * j); }
#pragma unroll
            for (int j = 0; j < 4; ++j) { v[j].x += bflo(w0[j].x); v[j].y += bfhi(w0[j].x); v[j].z += bflo(w0[j].y); v[j].w += bfhi(w0[j].y); }
            if (two) {
#pragma unroll
                for (int j = 0; j < 4; ++j) { v[j].x += bflo(w1[j].x); v[j].y += bfhi(w1[j].x); v[j].z += bflo(w1[j].y); v[j].w += bfhi(w1[j].y); } }
        }
        float s = 0.f;
#pragma unroll
        for (int j = 0; j < 4; ++j) s += (v[j].x * v[j].x + v[j].y * v[j].y) + (v[j].z * v[j].z + v[j].w * v[j].w);
        const float rstd = 1.f / sqrtf(wave_sum(s) * (1.f / DM) + NORM_EPS);
        GAS f32x4* xr = (GAS f32x4*)(a.out + (size_t)m * DM) + lane;
#pragma unroll
        for (int j = 0; j < 4; ++j) __builtin_nontemporal_store(v[j] * rstd * gg[j], xr + 64 * j);
    }
}

namespace att {
#define KSWZ(row, colB) ((row) * 256 + ((colB) ^ (((row) & 7) << 4)))
#define KSWZ16(row, colB) ((row) * 256 + ((colB) ^ (((row) & 15) << 4)))
#define SBAR() __builtin_amdgcn_sched_barrier(0)
constexpr int SHM_V = 16384, SHM_K = 16384;
constexpr int L_V = 0, L_K = 2 * SHM_V, L_WS = 2 * SHM_V + 2 * SHM_K, L_T = L_WS + NWAVES * 256, TOFF = 704, TLEN = 1408;
constexpr int L_X = 0;
constexpr float THR = 8.f;
__device__ __forceinline__ int crow(int r, int hi) { return (r & 3) + 8 * (r >> 2) + 4 * hi; }
typedef float f32x2_t __attribute__((ext_vector_type(2))); typedef __bf16 bf16x2_t __attribute__((ext_vector_type(2)));
__device__ __forceinline__ unsigned cvtpk(float lo, float hi) { const f32x2_t v = {lo, hi}; return __builtin_bit_cast(unsigned, __builtin_convertvector(v, bf16x2_t)); }
__device__ __forceinline__ float fadd_s(float a, float b) { float r; asm("v_add_f32_e32 %0, %1, %2" : "=v"(r) : "v"(a), "v"(b)); return r; }
__device__ __forceinline__ bf16x8 ld8(const bf16* p) { return *reinterpret_cast<const bf16x8*>(p); }

__device__ __forceinline__ void partialSM(f32x16& p0, f32x16& p1, float& m_reg, float& alpha) {
    float mx4[4] = {p0[0], p0[1], p0[2], p0[3]};
#pragma unroll
    for (int r = 4; r < 16; ++r) mx4[r & 3] = fmaxf(mx4[r & 3], p0[r]);
#pragma unroll
    for (int r = 0; r < 16; ++r) mx4[r & 3] = fmaxf(mx4[r & 3], p1[r]);
    float pmax = fmaxf(fmaxf(mx4[0], mx4[1]), fmaxf(mx4[2], mx4[3]));
    { auto rr = __builtin_amdgcn_permlane32_swap(__float_as_uint(pmax), __float_as_uint(pmax), false, false); pmax = fmaxf(__uint_as_float(rr[0]), __uint_as_float(rr[1])); }
    float mn;
    if (__builtin_expect(__all(pmax - m_reg <= THR), 1)) { mn = m_reg; alpha = 1.f; }
    else { mn = fmaxf(m_reg, pmax); alpha = __builtin_amdgcn_exp2f(m_reg - mn); m_reg = mn; }
#pragma unroll
    for (int r = 0; r < 16; ++r) { p0[r] -= mn; p1[r] -= mn; }
#pragma unroll
    for (int r = 0; r < 16; ++r) p0[r] = __builtin_amdgcn_exp2f(p0[r]);
}
__device__ __forceinline__ void finishSM(f32x16& p0, f32x16& p1, float alpha, float& l_reg, bf16x8& pa0, bf16x8& pa1, bf16x8& pa2, bf16x8& pa3) {
#pragma unroll
    for (int r = 0; r < 16; ++r) p1[r] = __builtin_amdgcn_exp2f(p1[r]);
    float ps4[4] = {p0[0], p0[1], p0[2], p0[3]};
#pragma unroll
    for (int r = 4; r < 16; ++r) ps4[r & 3] += p0[r];
#pragma unroll
    for (int r = 0; r < 16; ++r) ps4[r & 3] += p1[r];
    float ps = (ps4[0] + ps4[1]) + (ps4[2] + ps4[3]);
    { auto rr = __builtin_amdgcn_permlane32_swap(__float_as_uint(ps), __float_as_uint(ps), false, false); ps = __uint_as_float(rr[0]) + __uint_as_float(rr[1]); }
    l_reg = l_reg * alpha + ps;
#define PK4(P, BASE, OUT) do { unsigned a0 = cvtpk(P[BASE + 0], P[BASE + 1]), a1 = cvtpk(P[BASE + 2], P[BASE + 3]);   \
    unsigned b0 = cvtpk(P[BASE + 4], P[BASE + 5]), b1 = cvtpk(P[BASE + 6], P[BASE + 7]);                              \
    auto r0 = __builtin_amdgcn_permlane32_swap(a0, b0, false, false); auto r1 = __builtin_amdgcn_permlane32_swap(a1, b1, false, false); \
    v4u w = {r0[0], r1[0], r0[1], r1[1]}; OUT = __builtin_bit_cast(bf16x8, w); } while (0)
    PK4(p0, 0, pa0); PK4(p0, 8, pa1); PK4(p1, 0, pa2); PK4(p1, 8, pa3);
#undef PK4
}
template <int NC4> __device__ __forceinline__ int v_st(int k, int c) { const int kk = (k & ~0xC) | ((k & 4) << 1) | ((k & 8) >> 1); return ((kk >> 3) * NC4 + (c >> 5)) * 512 + ((kk & 7) * 32 + (c & 31)) * 2; }
__device__ __forceinline__ int v_rd_base(int lane) { return ((lane & 3) << 3) | (((lane >> 2) & 3) << 6) | (((lane >> 4) & 1) << 5) | (((lane >> 5) & 1) << 8); }
template <int NC4> constexpr int v_rd_off(int d0, int ks, int half) { return d0 * 512 + ks * (NC4 * 1024) + half * (NC4 * 512); }
template <int OFF> __device__ __forceinline__ s16x4 tr_read(int vb) { s16x4 r; asm volatile("ds_read_b64_tr_b16 %0, %1 offset:%2" : "=&v"(r) : "v"(vb), "i"(OFF) : "memory"); return r; }
template <int NC4, int ND0, int KS> __device__ __forceinline__ void pv_step(f32x16 (&o)[ND0], int vb, bf16x8 pa) {
    s16x4 lo[ND0], hh[ND0];
#pragma unroll
    for (int d0 = 0; d0 < ND0; ++d0) {
        if (d0 == 0) { lo[0] = tr_read<v_rd_off<NC4>(0, KS, 0)>(vb); hh[0] = tr_read<v_rd_off<NC4>(0, KS, 1)>(vb); }
        if (d0 == 1) { lo[1] = tr_read<v_rd_off<NC4>(1, KS, 0)>(vb); hh[1] = tr_read<v_rd_off<NC4>(1, KS, 1)>(vb); }
        if (d0 == 2) { lo[2] = tr_read<v_rd_off<NC4>(2, KS, 0)>(vb); hh[2] = tr_read<v_rd_off<NC4>(2, KS, 1)>(vb); }
        if (d0 == 3) { lo[3] = tr_read<v_rd_off<NC4>(3, KS, 0)>(vb); hh[3] = tr_read<v_rd_off<NC4>(3, KS, 1)>(vb); } }
    asm volatile("s_waitcnt lgkmcnt(0)" ::: "memory"); SBAR();
#pragma unroll
    for (int d0 = 0; d0 < ND0; ++d0) { const bf16x8 vf = (bf16x8){lo[d0][0], lo[d0][1], lo[d0][2], lo[d0][3], hh[d0][0], hh[d0][1], hh[d0][2], hh[d0][3]};
        o[d0] = __builtin_amdgcn_mfma_f32_32x32x16_bf16(pa, vf, o[d0], 0, 0, 0); }
}
template <int NC4, int ND0> __device__ __forceinline__ void pv_all(f32x16 (&o)[ND0], int vb, bf16x8 pa0, bf16x8 pa1, bf16x8 pa2, bf16x8 pa3) {
    pv_step<NC4, ND0, 0>(o, vb, pa0); pv_step<NC4, ND0, 1>(o, vb, pa1); pv_step<NC4, ND0, 2>(o, vb, pa2); pv_step<NC4, ND0, 3>(o, vb, pa3);
}

__device__ __forceinline__ void diff_unit(const bf16* __restrict__ proj, bf16* __restrict__ attn, const float* relb, const float* subln, float lam, int b, int h, int qb,
                                          LAS unsigned char* lds, int tid) {
    const int wid = __builtin_amdgcn_readfirstlane(tid >> 6), lane = tid & 63, r32 = lane & 31, hi = lane >> 5, sub = wid >> 2, wq = wid & 3;
    LAS unsigned char* V_lds = lds + L_V; LAS unsigned char* K_lds = lds + L_K;
    LAS float* wsf = (LAS float*)(lds + L_WS) + wid * 64; LAS float* li_l = wsf; LAS float* al_l = wsf + 32;
    LAS float* T = (LAS float*)(lds + L_T);
    for (int i = tid; i < TLEN; i += NWAVES * 64) T[i] = relb[(unsigned)(t5_bucket(i - TOFF) * 12 + h)] * LOG2E;
    const float cneg = relb[15 * 12 + h] * LOG2E, cpos = relb[31 * 12 + h] * LOG2E;
    const size_t rowb = (size_t)b * SEQ;
    const int q0w = qb * 128 + wq * 32;
    const bf16* Kh = proj + rowb * NIN + COL_KA + h * 128; const bf16* Vh = proj + rowb * NIN + COL_VA + h * 128;
    float m_reg = -1e30f, l_reg = 0.f; f32x16 o[4]; bf16x8 qr[4];
#pragma unroll
    for (int d = 0; d < 4; ++d) o[d] = f32x16{};
    { const bf16* Qw = proj + (rowb + q0w + r32) * NIN + COL_QA + h * 128 + sub * 64 + hi * 8;
#pragma unroll
      for (int d0 = 0; d0 < 4; ++d0) qr[d0] = ld8(Qw + d0 * 16); }
    const int sr = tid >> 4, sc = (tid & 15) * 8, vst0 = v_st<4>(sr, sc), vst1 = v_st<4>(32 + sr, sc);
    const int vb0 = (int)(unsigned)(uintptr_t)V_lds + v_rd_base(lane);
    struct { bf16x8 vs0, vs1, ks0, ks1; } sr_[2];
#define SLOAD(i, k0) do { sr_[i].vs0 = ld8(&Vh[(size_t)((k0) + sr) * NIN + sc]); sr_[i].vs1 = ld8(&Vh[(size_t)((k0) + 32 + sr) * NIN + sc]); \
    sr_[i].ks0 = ld8(&Kh[(size_t)((k0) + sr) * NIN + sc]); sr_[i].ks1 = ld8(&Kh[(size_t)((k0) + 32 + sr) * NIN + sc]); } while (0)
#define SWRITE(bb, i) do { *(LAS bf16x8*)(V_lds + (bb) * SHM_V + vst0) = sr_[i].vs0; *(LAS bf16x8*)(V_lds + (bb) * SHM_V + vst1) = sr_[i].vs1; const int kc = sc * 2; \
    *(LAS bf16x8*)(K_lds + (bb) * SHM_K + KSWZ(sr, kc)) = sr_[i].ks0; *(LAS bf16x8*)(K_lds + (bb) * SHM_K + KSWZ(32 + sr, kc)) = sr_[i].ks1; } while (0)
#define SWAIT() asm volatile("s_waitcnt vmcnt(4)" ::: "memory")
#define RESC(a_) do { if (__any((a_) < 1.f)) { if (hi == 0) al_l[r32] = (a_); asm volatile("s_waitcnt lgkmcnt(0)" ::: "memory"); \
    _Pragma("unroll") for (int d = 0; d < 4; ++d) _Pragma("unroll") for (int r = 0; r < 16; ++r) o[d][r] *= al_l[crow(r, hi)]; } } while (0)
#define BINIT(P0, P1, kv0) do { const int d_ = (kv0) - q0w; \
    if (d_ > -622 && d_ < 590) { const LAS float* tp = T + (d_ - r32 + 4 * hi + TOFF); \
        _Pragma("unroll") for (int r = 0; r < 16; ++r) { P0[r] = tp[(r & 3) + 8 * (r >> 2)]; P1[r] = tp[32 + (r & 3) + 8 * (r >> 2)]; } } \
    else { const float c_ = d_ < 0 ? cneg : cpos; _Pragma("unroll") for (int r = 0; r < 16; ++r) { P0[r] = c_; P1[r] = c_; } } } while (0)
#define QKT(P0, P1, Ks) do { _Pragma("unroll") for (int d0 = 0; d0 < 4; ++d0) { const int cb = (sub * 64 + d0 * 16 + hi * 8) * 2; \
    const bf16x8 b0 = *(const LAS bf16x8*)((Ks) + KSWZ(r32, cb)); const bf16x8 b1 = *(const LAS bf16x8*)((Ks) + KSWZ(32 + r32, cb)); \
    P0 = __builtin_amdgcn_mfma_f32_32x32x16_bf16(b0, qr[d0], P0, 0, 0, 0); P1 = __builtin_amdgcn_mfma_f32_32x32x16_bf16(b1, qr[d0], P1, 0, 0, 0); } } while (0)
#define PVD0(vb) pv_all<4, 4>(o, vb, pa0, pa1, pa2, pa3)
    f32x16 pA0, pA1, pB0, pB1; float alA, alB; bf16x8 pa0, pa1, pa2, pa3; constexpr int NT = SEQ / 64;
    SLOAD(0, 0); asm volatile("s_waitcnt vmcnt(0)" ::: "memory"); SWRITE(0, 0); __syncthreads();
    BINIT(pA0, pA1, 0); QKT(pA0, pA1, K_lds); partialSM(pA0, pA1, m_reg, alA);
    SLOAD(1, 64); SLOAD(0, 128);
    SWAIT(); SWRITE(1, 1); __syncthreads();
#pragma unroll 1
    for (int j = 1; j + 1 < NT; j += 2) {
        SBAR(); BINIT(pB0, pB1, j * 64); QKT(pB0, pB1, K_lds + SHM_K);
        finishSM(pA0, pA1, alA, l_reg, pa0, pa1, pa2, pa3); SBAR();
        SLOAD(1, (j + 2) * 64); SBAR();
        PVD0(vb0); partialSM(pB0, pB1, m_reg, alB);
        __syncthreads(); SWAIT(); SWRITE(0, 0);
        RESC(alB); __syncthreads();
        SBAR(); BINIT(pA0, pA1, (j + 1) * 64); QKT(pA0, pA1, K_lds);
        finishSM(pB0, pB1, alB, l_reg, pa0, pa1, pa2, pa3); SBAR();
        if (j + 3 < NT) SLOAD(0, (j + 3) * 64); SBAR();
        PVD0(vb0 + SHM_V); partialSM(pA0, pA1, m_reg, alA);
        __syncthreads(); SWAIT(); SWRITE(1, 1);
        RESC(alA); __syncthreads();
    }
    SBAR(); BINIT(pB0, pB1, (NT - 1) * 64); QKT(pB0, pB1, K_lds + SHM_K);
    finishSM(pA0, pA1, alA, l_reg, pa0, pa1, pa2, pa3); SBAR();
    PVD0(vb0); partialSM(pB0, pB1, m_reg, alB);
    __syncthreads(); RESC(alB);
    finishSM(pB0, pB1, alB, l_reg, pa0, pa1, pa2, pa3); SBAR();
    PVD0(vb0 + SHM_V);
    if (hi == 0) li_l[r32] = l_reg; asm volatile("s_waitcnt lgkmcnt(0)" ::: "memory");
    float rli[16];
#pragma unroll
    for (int r = 0; r < 16; ++r) rli[r] = __builtin_amdgcn_rcpf(li_l[crow(r, hi)]);
    __syncthreads();
    LAS float* X = (LAS float*)(lds + L_X) + (size_t)wq * 4096 + lane;
    if (sub == 1) {
#pragma unroll
        for (int d0 = 0; d0 < 4; ++d0)
#pragma unroll
            for (int r = 0; r < 16; ++r) X[(d0 * 16 + r) * 64] = o[d0][r] * rli[r] * (-lam);
    }
    __syncthreads();
    if (sub == 0) {
        float ss[16];
#pragma unroll
        for (int r = 0; r < 16; ++r) ss[r] = 0.f;
#pragma unroll
        for (int d0 = 0; d0 < 4; ++d0)
#pragma unroll
            for (int r = 0; r < 16; ++r) { const float v = o[d0][r] * rli[r] + X[(d0 * 16 + r) * 64]; o[d0][r] = v; ss[r] += v * v; }
#pragma unroll
        for (int r = 0; r < 16; ++r) {
#pragma unroll
            for (int msk = 1; msk < 32; msk <<= 1) ss[r] += __shfl_xor(ss[r], msk);
            ss[r] = (1.f - LAMBDA_INIT) / sqrtf(ss[r] * (1.f / 128.f) + SUBLN_EPS); }
        float gsub[4];
#pragma unroll
        for (int d0 = 0; d0 < 4; ++d0) gsub[d0] = subln[d0 * 32 + r32];
        bf16* Ow = attn + (rowb + q0w) * DM + h * 128 + r32;
#pragma unroll
        for (int r = 0; r < 16; ++r) { const int orow = crow(r, hi);
#pragma unroll
            for (int d0 = 0; d0 < 4; ++d0) Ow[(size_t)orow * DM + d0 * 32] = (bf16)f2bf(o[d0][r] * ss[r] * gsub[d0]); }
    }
    __syncthreads();
#undef SLOAD
#undef SWRITE
#undef SWAIT
#undef RESC
#undef BINIT
#undef QKT
#undef PVD0
}

constexpr int D2_SLOT = 16384, D2_K = 0, D2_V = 3 * D2_SLOT, D2_WS = 6 * D2_SLOT, D2_T = D2_WS + NWAVES * 256;
static_assert(D2_T + TLEN * 4 <= RING_BYTES, "diff v2 LDS map");
#define D2_WAIT_BAR(N) asm volatile("s_waitcnt vmcnt(" #N ") lgkmcnt(0)\n\ts_barrier" ::: "memory")
__device__ __forceinline__ void softmax2(f32x16& p0, f32x16& p1, float& m_run, float& l_reg, bool first, float& alpha, bf16x8& pa0, bf16x8& pa1, bf16x8& pa2, bf16x8& pa3) {
    float mx4[4] = {p0[0], p0[1], p0[2], p0[3]};
#pragma unroll
    for (int r = 4; r < 16; ++r) mx4[r & 3] = fmaxf(mx4[r & 3], p0[r]);
#pragma unroll
    for (int r = 0; r < 16; ++r) mx4[r & 3] = fmaxf(mx4[r & 3], p1[r]);
    float pmax = fmaxf(fmaxf(mx4[0], mx4[1]), fmaxf(mx4[2], mx4[3]));
    { auto rr = __builtin_amdgcn_permlane32_swap(__float_as_uint(pmax), __float_as_uint(pmax), false, false); pmax = fmaxf(__uint_as_float(rr[0]), __uint_as_float(rr[1])); }
    alpha = 1.f;
    if (__builtin_expect(first || !__all(pmax <= THR), 0)) {
        const float delta = first ? pmax : fmaxf(pmax, 0.f);
        m_run += delta; alpha = first ? 1.f : __builtin_amdgcn_exp2f(-delta);
#pragma unroll
        for (int r = 0; r < 16; ++r) { p0[r] -= delta; p1[r] -= delta; }
    }
#pragma unroll
    for (int r = 0; r < 16; ++r) { p0[r] = __builtin_amdgcn_exp2f(p0[r]); p1[r] = __builtin_amdgcn_exp2f(p1[r]); }
    float ps4[4];
#pragma unroll
    for (int c = 0; c < 4; ++c) { float a_ = p0[4 * c] + p0[4 * c + 1]; a_ += p0[4 * c + 2]; a_ += p0[4 * c + 3]; a_ += p1[4 * c]; a_ += p1[4 * c + 1]; a_ += p1[4 * c + 2]; a_ += p1[4 * c + 3]; ps4[c] = a_; }
    float ps = (ps4[0] + ps4[1]) + (ps4[2] + ps4[3]);
    { auto rr = __builtin_amdgcn_permlane32_swap(__float_as_uint(ps), __float_as_uint(ps), false, false); ps = __uint_as_float(rr[0]) + __uint_as_float(rr[1]); }
    l_reg = l_reg * alpha + ps;
#define PK4(P, BASE, OUT) do { unsigned a0 = cvtpk(P[BASE + 0], P[BASE + 1]), a1 = cvtpk(P[BASE + 2], P[BASE + 3]);   \
    unsigned b0 = cvtpk(P[BASE + 4], P[BASE + 5]), b1 = cvtpk(P[BASE + 6], P[BASE + 7]);                              \
    auto r0 = __builtin_amdgcn_permlane32_swap(a0, b0, false, false); auto r1 = __builtin_amdgcn_permlane32_swap(a1, b1, false, false); \
    v4u w = {r0[0], r1[0], r0[1], r1[1]}; OUT = __builtin_bit_cast(bf16x8, w); } while (0)
    PK4(p0, 0, pa0); PK4(p0, 8, pa1); PK4(p1, 0, pa2); PK4(p1, 8, pa3);
#undef PK4
}
struct VFrag { s16x4 l0, h0, l1, h1; };
template <int KS, int DP> __device__ __forceinline__ void pv2_read(VFrag& f, int vb) {
    f.l0 = tr_read<v_rd_off<4>(2 * DP, KS, 0)>(vb); f.h0 = tr_read<v_rd_off<4>(2 * DP, KS, 1)>(vb); f.l1 = tr_read<v_rd_off<4>(2 * DP + 1, KS, 0)>(vb); f.h1 = tr_read<v_rd_off<4>(2 * DP + 1, KS, 1)>(vb);
}
template <int DP> __device__ __forceinline__ void pv2_mma(f32x16 (&o1)[4], f32x16 (&o2)[4], const VFrag& f, bf16x8 pa, bf16x8 pb) {
#define PK(L, H) (bf16x8){L[0], L[1], L[2], L[3], H[0], H[1], H[2], H[3]}
    const bf16x8 v0 = PK(f.l0, f.h0), v1 = PK(f.l1, f.h1);
#undef PK
    o1[2 * DP] = __builtin_amdgcn_mfma_f32_32x32x16_bf16(pa, v0, o1[2 * DP], 0, 0, 0); o1[2 * DP + 1] = __builtin_amdgcn_mfma_f32_32x32x16_bf16(pa, v1, o1[2 * DP + 1], 0, 0, 0);
    o2[2 * DP] = __builtin_amdgcn_mfma_f32_32x32x16_bf16(pb, v0, o2[2 * DP], 0, 0, 0); o2[2 * DP + 1] = __builtin_amdgcn_mfma_f32_32x32x16_bf16(pb, v1, o2[2 * DP + 1], 0, 0, 0);
}
#define PV2_W4() do { asm volatile("s_waitcnt lgkmcnt(4)" ::: "memory"); SBAR(); } while (0)
__device__ __forceinline__ void pv2_all(f32x16 (&o1)[4], f32x16 (&o2)[4], int vb, const bf16x8 (&pa)[4], const bf16x8 (&pb)[4]) {
    VFrag fa, fb;
    pv2_read<0, 0>(fa, vb);
    pv2_read<0, 1>(fb, vb); PV2_W4(); pv2_mma<0>(o1, o2, fa, pa[0], pb[0]); SBAR();
    pv2_read<1, 0>(fa, vb); PV2_W4(); pv2_mma<1>(o1, o2, fb, pa[0], pb[0]); SBAR();
    pv2_read<1, 1>(fb, vb); PV2_W4(); pv2_mma<0>(o1, o2, fa, pa[1], pb[1]); SBAR();
    pv2_read<2, 0>(fa, vb); PV2_W4(); pv2_mma<1>(o1, o2, fb, pa[1], pb[1]); SBAR();
    pv2_read<2, 1>(fb, vb); PV2_W4(); pv2_mma<0>(o1, o2, fa, pa[2], pb[2]); SBAR();
    pv2_read<3, 0>(fa, vb); PV2_W4(); pv2_mma<1>(o1, o2, fb, pa[2], pb[2]); SBAR();
    pv2_read<3, 1>(fb, vb); PV2_W4(); pv2_mma<0>(o1, o2, fa, pa[3], pb[3]); SBAR();
    asm volatile("s_waitcnt lgkmcnt(0)" ::: "memory"); SBAR(); pv2_mma<1>(o1, o2, fb, pa[3], pb[3]);
}
#undef PV2_W4
__device__ __forceinline__ void diff_unit2(const bf16* __restrict__ proj, bf16* __restrict__ attn, const float* relb, const float* subln, float lam, int b, int h, int qb,
                                           LAS unsigned char* lds, int tid_in) {
    int tid = tid_in; asm volatile("" : "+v"(tid));
    const int wid = __builtin_amdgcn_readfirstlane(tid >> 6), lane = tid & 63, r32 = lane & 31, hi = lane >> 5;
    LAS float* wsf = (LAS float*)(lds + D2_WS) + wid * 64; LAS float* T = (LAS float*)(lds + D2_T);
    for (int i = tid; i < TLEN; i += NWAVES * 64) T[i] = relb[(unsigned)(t5_bucket(i - TOFF) * 12 + h)] * LOG2E;
    const float cneg = __builtin_bit_cast(float, __builtin_amdgcn_readfirstlane(__builtin_bit_cast(int, relb[15 * 12 + h] * LOG2E))), cpos = __builtin_bit_cast(float, __builtin_amdgcn_readfirstlane(__builtin_bit_cast(int, relb[31 * 12 + h] * LOG2E)));
    const size_t rowb = (size_t)b * SEQ;
    const int q0w = qb * 256 + wid * 32;
    const bf16* Kh = proj + rowb * NIN + COL_KA + h * 128; const bf16* Vh = proj + rowb * NIN + COL_VA + h * 128;
    unsigned kofs, vofs;
    { const int pc = 2 * wid;
        const int rK = 4 * pc + (lane >> 4), cK = (lane & 15) ^ (rK & 15); kofs = (unsigned)(rK * NIN + cK * 8);
        const int sV = 2 * pc + (lane >> 5), kk = (sV >> 2) * 8 + ((lane & 31) >> 2), kV = (kk & ~0xC) | ((kk & 4) << 1) | ((kk & 8) >> 1), cV = (sV & 3) * 32 + (lane & 3) * 8;
        vofs = (unsigned)(kV * NIN + cV); }
#define D2_DMA(t, slot) do { const bf16* kt_ = Kh + (size_t)(t) * 64 * NIN; const bf16* vt_ = Vh + (size_t)(t) * 64 * NIN; \
    __builtin_amdgcn_global_load_lds((const unsigned*)(kt_ + kofs), (LAS unsigned*)(lds + D2_K + (slot) + (2 * wid) * 1024), 16, 0, 0); \
    __builtin_amdgcn_global_load_lds((const unsigned*)(kt_ + ((kofs ^ 32u) + 4u * NIN)), (LAS unsigned*)(lds + D2_K + (slot) + (2 * wid + 1) * 1024), 16, 0, 0); \
    __builtin_amdgcn_global_load_lds((const unsigned*)(vt_ + vofs), (LAS unsigned*)(lds + D2_V + (slot) + (2 * wid) * 1024), 16, 0, 0); \
    __builtin_amdgcn_global_load_lds((const unsigned*)(vt_ + (vofs + 64u)), (LAS unsigned*)(lds + D2_V + (slot) + (2 * wid + 1) * 1024), 16, 0, 0); } while (0)
    bf16x8 qr[8];
    { const bf16* Qu = proj + (rowb + q0w) * NIN + COL_QA + h * 128; const unsigned qo = (unsigned)(r32 * NIN + hi * 8);
#pragma unroll
      for (int d0 = 0; d0 < 8; ++d0) qr[d0] = ld8(Qu + (qo + d0 * 16)); }
    D2_DMA(0, 0); D2_DMA(1, D2_SLOT);
    f32x16 o1[4], o2[4];
#pragma unroll
    for (int d = 0; d < 4; ++d) { o1[d] = f32x16{}; o2[d] = f32x16{}; }
    float m_run[2] = {0.f, 0.f}, l_reg[2] = {0.f, 0.f};
    const int vbase = (int)(unsigned)(uintptr_t)(lds + D2_V) + v_rd_base(lane);
    constexpr int NT = SEQ / 64;
    int sl_cur = 0, sl_nxt2 = 2 * D2_SLOT;
#pragma unroll 1
    for (int j = 0; j < NT; ++j) {
        if (j + 1 < NT) D2_WAIT_BAR(4); else D2_WAIT_BAR(0);
        if (j + 2 < NT) D2_DMA(j + 2, sl_nxt2);
        const LAS unsigned char* Ks = lds + D2_K + sl_cur;
        const int d_ = j * 64 - q0w; const bool near = d_ > -622 && d_ < 590; const float cfar = d_ < 0 ? cneg : cpos; const bool first = (j == 0);
        const LAS float* tp = T + (d_ - r32 + 4 * hi + TOFF);
        bf16x8 pa[2][4]; float alpha[2];
#pragma unroll
        for (int s2 = 0; s2 < 2; ++s2) {
            f32x16 p0, p1;
            if (near) {
#pragma unroll
                for (int r = 0; r < 16; ++r) { p0[r] = tp[(r & 3) + 8 * (r >> 2)] - m_run[s2]; p1[r] = tp[32 + (r & 3) + 8 * (r >> 2)] - m_run[s2]; } }
            else { const float c_ = cfar - m_run[s2];
#pragma unroll
                for (int r = 0; r < 16; ++r) { p0[r] = c_; p1[r] = c_; } }
#pragma unroll
            for (int d0 = 0; d0 < 4; ++d0) { const int cb = ((4 * s2 + d0) * 16 + hi * 8) * 2;
                const bf16x8 b0 = *(const LAS bf16x8*)(Ks + KSWZ16(r32, cb)); const bf16x8 b1 = *(const LAS bf16x8*)(Ks + KSWZ16(32 + r32, cb));
                p0 = __builtin_amdgcn_mfma_f32_32x32x16_bf16(b0, qr[4 * s2 + d0], p0, 0, 0, 0); p1 = __builtin_amdgcn_mfma_f32_32x32x16_bf16(b1, qr[4 * s2 + d0], p1, 0, 0, 0); }
            softmax2(p0, p1, m_run[s2], l_reg[s2], first, alpha[s2], pa[s2][0], pa[s2][1], pa[s2][2], pa[s2][3]);
            SBAR();
        }
        if (__any(alpha[0] < 1.f)) { if (hi == 0) wsf[r32] = alpha[0]; asm volatile("s_waitcnt lgkmcnt(0)" ::: "memory");
#pragma unroll
            for (int d = 0; d < 4; ++d)
#pragma unroll
                for (int r = 0; r < 16; ++r) o1[d][r] *= wsf[crow(r, hi)]; }
        if (__any(alpha[1] < 1.f)) { if (hi == 0) wsf[32 + r32] = alpha[1]; asm volatile("s_waitcnt lgkmcnt(0)" ::: "memory");
#pragma unroll
            for (int d = 0; d < 4; ++d)
#pragma unroll
                for (int r = 0; r < 16; ++r) o2[d][r] *= wsf[32 + crow(r, hi)]; }
        const int vb = vbase + sl_cur;
        asm volatile("s_waitcnt lgkmcnt(0)" ::: "memory"); SBAR();
        pv2_all(o1, o2, vb, pa[0], pa[1]);
        sl_cur = (sl_cur == 2 * D2_SLOT) ? 0 : sl_cur + D2_SLOT; sl_nxt2 = (sl_nxt2 == 2 * D2_SLOT) ? 0 : sl_nxt2 + D2_SLOT;
    }
    asm volatile("s_waitcnt lgkmcnt(0)\n\ts_barrier" ::: "memory");
    int lane2; asm volatile("v_mbcnt_lo_u32_b32 %0, -1, 0\n\tv_mbcnt_hi_u32_b32 %0, -1, %0" : "=v"(lane2));
    const int r32e = lane2 & 31, hie = lane2 >> 5;
    LAS float* wse = (LAS float*)(lds + D2_WS) + wid * 64;
    if (hie == 0) { wse[r32e] = l_reg[0]; wse[32 + r32e] = l_reg[1]; }
    asm volatile("s_waitcnt lgkmcnt(0)" ::: "memory");
    float ss[16];
    int nlb = __builtin_amdgcn_readfirstlane(__builtin_bit_cast(int, lam)) ^ (int)0x80000000u; asm volatile("" : "+s"(nlb)); const float nlam = __builtin_bit_cast(float, nlb);
#pragma unroll
    for (int r = 0; r < 16; ++r) { const float ra = __builtin_amdgcn_rcpf(wse[crow(r, hie)]), rb = nlam * __builtin_amdgcn_rcpf(wse[32 + crow(r, hie)]); float acc = 0.f;
#pragma unroll
        for (int d0 = 0; d0 < 4; ++d0) { const float v = o1[d0][r] * ra + o2[d0][r] * rb; o1[d0][r] = v; acc += v * v; }
        ss[r] = acc; }
#pragma unroll
    for (int r = 0; r < 16; ++r) {
#pragma unroll
        for (int msk = 1; msk < 32; msk <<= 1) ss[r] += __builtin_bit_cast(float, __builtin_amdgcn_ds_bpermute((lane2 ^ msk) << 2, __builtin_bit_cast(int, ss[r])));
        ss[r] = (1.f - LAMBDA_INIT) * __builtin_amdgcn_rsqf(ss[r] * (1.f / 128.f) + SUBLN_EPS); }
    float gsub[4];
#pragma unroll
    for (int d0 = 0; d0 < 4; ++d0) gsub[d0] = subln[d0 * 32 + r32e];
    bf16* Ou = attn + (rowb + q0w) * DM + h * 128;
#pragma unroll
    for (int r = 0; r < 16; ++r) { const unsigned oo = (unsigned)(crow(r, hie) * DM + r32e);
#pragma unroll
        for (int d0 = 0; d0 < 4; d0 += 2) { const unsigned pk = cvtpk(o1[d0][r] * ss[r] * gsub[d0], o1[d0 + 1][r] * ss[r] * gsub[d0 + 1]); Ou[oo + d0 * 32] = (bf16)(pk & 0xffffu); Ou[oo + d0 * 32 + 32] = (bf16)(pk >> 16); } }
#undef D2_DMA
}

constexpr int D3_K = 0, D3_V = 4 * D2_SLOT, D3_WS = RING_BYTES + 1024, D3_T = D3_WS + NWAVES * 256, D3_FLAG = D3_T + TLEN * 4;
static_assert(D3_V + 4 * D2_SLOT <= RING_BYTES && D3_FLAG + 4 <= LDS_BYTES, "diff v3 LDS map");
__device__ __forceinline__ void softmax3(f32x16& p0, f32x16& p1, float& l_reg, bf16x8& pa0, bf16x8& pa1, bf16x8& pa2, bf16x8& pa3) {
#pragma unroll
    for (int r = 0; r < 16; ++r) { p0[r] = __builtin_amdgcn_exp2f(p0[r]); p1[r] = __builtin_amdgcn_exp2f(p1[r]); }
    float ps4[4];
#pragma unroll
    for (int c = 0; c < 4; ++c) { float a_ = p0[4 * c] + p0[4 * c + 1]; a_ += p0[4 * c + 2]; a_ += p0[4 * c + 3]; a_ += p1[4 * c]; a_ += p1[4 * c + 1]; a_ += p1[4 * c + 2]; a_ += p1[4 * c + 3]; ps4[c] = a_; }
    float ps = (ps4[0] + ps4[1]) + (ps4[2] + ps4[3]);
    { auto rr = __builtin_amdgcn_permlane32_swap(__float_as_uint(ps), __float_as_uint(ps), false, false); ps = __uint_as_float(rr[0]) + __uint_as_float(rr[1]); }
    l_reg += ps;
#define PK4(P, BASE, OUT) do { unsigned a0 = cvtpk(P[BASE + 0], P[BASE + 1]), a1 = cvtpk(P[BASE + 2], P[BASE + 3]);   \
    unsigned b0 = cvtpk(P[BASE + 4], P[BASE + 5]), b1 = cvtpk(P[BASE + 6], P[BASE + 7]);                              \
    auto r0 = __builtin_amdgcn_permlane32_swap(a0, b0, false, false); auto r1 = __builtin_amdgcn_permlane32_swap(a1, b1, false, false); \
    v4u w = {r0[0], r1[0], r0[1], r1[1]}; OUT = __builtin_bit_cast(bf16x8, w); } while (0)
    PK4(p0, 0, pa0); PK4(p0, 8, pa1); PK4(p1, 0, pa2); PK4(p1, 8, pa3);
#undef PK4
}
__device__ __forceinline__ bool diff_unit3(const bf16* __restrict__ proj, bf16* __restrict__ attn, const float* relb, const float* subln, float lam, int b, int h, int qb,
                                           LAS unsigned char* lds, int tid_in) {
    int tid = tid_in; asm volatile("" : "+v"(tid));
    const int wid = __builtin_amdgcn_readfirstlane(tid >> 6), lane = tid & 63, r32 = lane & 31, hi = lane >> 5;
    LAS float* wsf = (LAS float*)(lds + D3_WS) + wid * 64; LAS float* T = (LAS float*)(lds + D3_T);
    const float cneg = __builtin_bit_cast(float, __builtin_amdgcn_readfirstlane(__builtin_bit_cast(int, relb[15 * 12 + h] * LOG2E))), cpos = __builtin_bit_cast(float, __builtin_amdgcn_readfirstlane(__builtin_bit_cast(int, relb[31 * 12 + h] * LOG2E)));
    const size_t rowb = (size_t)b * SEQ;
    const int q0w = qb * 256 + wid * 32;
    const bool refneg = (qb >= 8);
    const float cref = refneg ? cneg : cpos, cother = (refneg ? cpos : cneg) - cref;
    for (int i = tid; i < TLEN; i += NWAVES * 64) T[i] = relb[(unsigned)(t5_bucket(i - TOFF) * 12 + h)] * LOG2E - cref;
    if (tid == 0) *(LAS unsigned*)(lds + D3_FLAG) = 0u;
    const bf16* Kh = proj + rowb * NIN + COL_KA + h * 128; const bf16* Vh = proj + rowb * NIN + COL_VA + h * 128;
    unsigned kofs, vofs;
    { const int pc = 2 * wid;
        const int rK = 4 * pc + (lane >> 4), cK = (lane & 15) ^ (rK & 15); kofs = (unsigned)(rK * NIN + cK * 8);
        const int sV = 2 * pc + (lane >> 5), kk = (sV >> 2) * 8 + ((lane & 31) >> 2), kV = (kk & ~0xC) | ((kk & 4) << 1) | ((kk & 8) >> 1), cV = (sV & 3) * 32 + (lane & 3) * 8;
        vofs = (unsigned)(kV * NIN + cV); }
#define D2_DMA(t, slot) do { const bf16* kt_ = Kh + (size_t)(t) * 64 * NIN; const bf16* vt_ = Vh + (size_t)(t) * 64 * NIN; \
    __builtin_amdgcn_global_load_lds((const unsigned*)(kt_ + kofs), (LAS unsigned*)(lds + D3_K + (slot) + (2 * wid) * 1024), 16, 0, 0); \
    __builtin_amdgcn_global_load_lds((const unsigned*)(kt_ + ((kofs ^ 32u) + 4u * NIN)), (LAS unsigned*)(lds + D3_K + (slot) + (2 * wid + 1) * 1024), 16, 0, 0); \
    __builtin_amdgcn_global_load_lds((const unsigned*)(vt_ + vofs), (LAS unsigned*)(lds + D3_V + (slot) + (2 * wid) * 1024), 16, 0, 0); \
    __builtin_amdgcn_global_load_lds((const unsigned*)(vt_ + (vofs + 64u)), (LAS unsigned*)(lds + D3_V + (slot) + (2 * wid + 1) * 1024), 16, 0, 0); } while (0)
    bf16x8 qr[8];
    { const bf16* Qu = proj + (rowb + q0w) * NIN + COL_QA + h * 128; const unsigned qo = (unsigned)(r32 * NIN + hi * 8);
#pragma unroll
      for (int d0 = 0; d0 < 8; ++d0) qr[d0] = ld8(Qu + (qo + d0 * 16)); }
    D2_DMA(0, 0); D2_DMA(1, D2_SLOT);
    f32x16 o1[4], o2[4];
#pragma unroll
    for (int d = 0; d < 4; ++d) { o1[d] = f32x16{}; o2[d] = f32x16{}; }
    float l_reg[2] = {0.f, 0.f};
    const int vbase = (int)(unsigned)(uintptr_t)(lds + D3_V) + v_rd_base(lane);
    constexpr int NT = SEQ / 64;
    bf16x8 pa[2][4];
#define D3_SM(jj, slk) do { const LAS unsigned char* Ks = lds + D3_K + (slk); \
        const int d_ = (jj) * 64 - q0w; const bool near = d_ > -622 && d_ < 590; const bool zero_init = !near && ((d_ < 0) == refneg); \
        const LAS float* tp = T + (d_ - r32 + 4 * hi + TOFF); \
        _Pragma("unroll") for (int s2 = 0; s2 < 2; ++s2) { \
            f32x16 p0, p1; \
            if (zero_init) { p0 = f32x16{}; p1 = f32x16{}; } \
            else if (near) { _Pragma("unroll") for (int r = 0; r < 16; ++r) { p0[r] = tp[(r & 3) + 8 * (r >> 2)]; p1[r] = tp[32 + (r & 3) + 8 * (r >> 2)]; } } \
            else { _Pragma("unroll") for (int r = 0; r < 16; ++r) { p0[r] = cother; p1[r] = cother; } } \
            _Pragma("unroll") for (int d0 = 0; d0 < 4; ++d0) { const int cb = ((4 * s2 + d0) * 16 + hi * 8) * 2; \
                const bf16x8 b0 = *(const LAS bf16x8*)(Ks + KSWZ16(r32, cb)); const bf16x8 b1 = *(const LAS bf16x8*)(Ks + KSWZ16(32 + r32, cb)); \
                p0 = __builtin_amdgcn_mfma_f32_32x32x16_bf16(b0, qr[4 * s2 + d0], p0, 0, 0, 0); p1 = __builtin_amdgcn_mfma_f32_32x32x16_bf16(b1, qr[4 * s2 + d0], p1, 0, 0, 0); } \
            softmax3(p0, p1, l_reg[s2], pa[s2][0], pa[s2][1], pa[s2][2], pa[s2][3]); \
            SBAR(); } } while (0)
#define D3_PV(slv) do { asm volatile("s_waitcnt lgkmcnt(0)" ::: "memory"); SBAR(); pv2_all(o1, o2, vbase + (slv), pa[0], pa[1]); SBAR(); } while (0)
#define D3_NEXT(x) ((x) == 3 * D2_SLOT ? 0 : (x) + D2_SLOT)
    int sl_prev = 3 * D2_SLOT, sl_cur = 0, sl_nxt2 = 2 * D2_SLOT;
    if (wid < 4) {
#pragma unroll 1
        for (int j = 0; j < NT; ++j) {
            if (j + 1 < NT) D2_WAIT_BAR(4); else D2_WAIT_BAR(0);
            if (j + 2 < NT) D2_DMA(j + 2, sl_nxt2);
            D3_SM(j, sl_cur);
            D3_PV(sl_cur);
            sl_cur = D3_NEXT(sl_cur); sl_nxt2 = D3_NEXT(sl_nxt2);
        }
    } else {
#pragma unroll 1
        for (int j = 0; j < NT; ++j) {
            if (j + 1 < NT) D2_WAIT_BAR(4); else D2_WAIT_BAR(0);
            if (j + 2 < NT) D2_DMA(j + 2, sl_nxt2);
            if (j >= 1) D3_PV(sl_prev);
            D3_SM(j, sl_cur);
            sl_prev = sl_cur; sl_cur = D3_NEXT(sl_cur); sl_nxt2 = D3_NEXT(sl_nxt2);
        }
        D3_PV(sl_prev);
    }
#undef D3_SM
#undef D3_PV
#undef D3_NEXT
    if (!((l_reg[0] > 1e-30f) && (l_reg[0] < 1e30f) && (l_reg[1] > 1e-30f) && (l_reg[1] < 1e30f))) *(LAS unsigned*)(lds + D3_FLAG) = 1u;
    asm volatile("s_waitcnt lgkmcnt(0)\n\ts_barrier" ::: "memory");
    const bool good = (*(const LAS unsigned*)(lds + D3_FLAG) == 0u);
    int lane2; asm volatile("v_mbcnt_lo_u32_b32 %0, -1, 0\n\tv_mbcnt_hi_u32_b32 %0, -1, %0" : "=v"(lane2));
    const int r32e = lane2 & 31, hie = lane2 >> 5;
    LAS float* wse = (LAS float*)(lds + D3_WS) + wid * 64;
    if (hie == 0) { wse[r32e] = l_reg[0]; wse[32 + r32e] = l_reg[1]; }
    asm volatile("s_waitcnt lgkmcnt(0)" ::: "memory");
    float ss[16];
    int nlb = __builtin_amdgcn_readfirstlane(__builtin_bit_cast(int, lam)) ^ (int)0x80000000u; asm volatile("" : "+s"(nlb)); const float nlam = __builtin_bit_cast(float, nlb);
#pragma unroll
    for (int r = 0; r < 16; ++r) { const float ra = __builtin_amdgcn_rcpf(wse[crow(r, hie)]), rb = nlam * __builtin_amdgcn_rcpf(wse[32 + crow(r, hie)]); float acc = 0.f;
#pragma unroll
        for (int d0 = 0; d0 < 4; ++d0) { const float v = o1[d0][r] * ra + o2[d0][r] * rb; o1[d0][r] = v; acc += v * v; }
        ss[r] = acc; }
#pragma unroll
    for (int r = 0; r < 16; ++r) {
#pragma unroll
        for (int msk = 1; msk < 32; msk <<= 1) ss[r] += __builtin_bit_cast(float, __builtin_amdgcn_ds_bpermute((lane2 ^ msk) << 2, __builtin_bit_cast(int, ss[r])));
        ss[r] = (1.f - LAMBDA_INIT) * __builtin_amdgcn_rsqf(ss[r] * (1.f / 128.f) + SUBLN_EPS); }
    float gsub[4];
#pragma unroll
    for (int d0 = 0; d0 < 4; ++d0) gsub[d0] = subln[d0 * 32 + r32e];
    { LAS unsigned char* stb = lds + wid * 8192; LAS unsigned* stg = (LAS unsigned*)stb; const bool odd = r32e & 1;
#pragma unroll
      for (int r = 0; r < 16; ++r) { const int row = crow(r, hie);
          const float v0 = o1[0][r] * ss[r] * gsub[0], v1 = o1[1][r] * ss[r] * gsub[1], v2 = o1[2][r] * ss[r] * gsub[2], v3 = o1[3][r] * ss[r] * gsub[3];
          const float ga = __builtin_bit_cast(float, __builtin_amdgcn_update_dpp(0, __builtin_bit_cast(int, odd ? v0 : v1), 0xB1, 0xF, 0xF, false));
          const float gb = __builtin_bit_cast(float, __builtin_amdgcn_update_dpp(0, __builtin_bit_cast(int, odd ? v2 : v3), 0xB1, 0xF, 0xF, false));
          const unsigned pa_ = odd ? cvtpk(ga, v1) : cvtpk(v0, ga), pb_ = odd ? cvtpk(gb, v3) : cvtpk(v2, gb);
          const int dw = odd ? 16 + (r32e >> 1) : (r32e >> 1);
          stg[row * 64 + dw] = pa_; stg[row * 64 + 32 + dw] = pb_; }
      asm volatile("s_waitcnt lgkmcnt(0)" ::: "memory");
      bf16* Ou = attn + (rowb + q0w) * DM + h * 128;
#pragma unroll
      for (int g = 0; g < 8; ++g) { const int row = g * 4 + (lane2 >> 4), ch = lane2 & 15;
          const v4u wv = *(const LAS v4u*)(stb + row * 256 + ch * 16);
          *(v4u*)(Ou + (unsigned)(row * DM + ch * 8)) = wv; } }
    asm volatile("s_waitcnt lgkmcnt(0)\n\ts_barrier" ::: "memory");
    return good;
#undef D2_DMA
}
#undef D2_WAIT_BAR

constexpr int DL_K = 0, DL_V = 65536;
constexpr int DL_T = RING_BYTES + 1024, DT_OFF = 128, DT_LEN = 256;
constexpr int DL_WS = DL_T + 3 * DT_LEN * 4;
static_assert(DL_WS + NWAVES * 256 <= LDS_BYTES, "dilated LDS map");
constexpr size_t DSCR_O = 0, DSCR_L = (size_t)3 * 1024 * 64 * 2, DSCR_BYTES = DSCR_L + 3 * 1024 * 4;
#define KSWZ64(row, colB) ((row) * 128 + ((colB) ^ (((row) & 7) << 4)))
__device__ __forceinline__ void dil_load(bf16x8 (&buf)[8], const bf16* __restrict__ tile0, size_t gstride, unsigned voff) {
#pragma unroll
    for (int g = 0; g < 8; ++g) buf[g] = ld8(tile0 + g * gstride + voff);
}
template <int HALF> __device__ __forceinline__ void dil_softmax(f32x16& p0, f32x16& p1, float& m_reg, float& l_reg, float& alpha, bf16x8& pa0, bf16x8& pa1, bf16x8& pa2, bf16x8& pa3) {
    float mx4[4];
    if constexpr (HALF != 2) { mx4[0] = p0[0]; mx4[1] = p0[1]; mx4[2] = p0[2]; mx4[3] = p0[3];
#pragma unroll
        for (int r = 4; r < 16; ++r) mx4[r & 3] = fmaxf(mx4[r & 3], p0[r]); }
    else { mx4[0] = p1[0]; mx4[1] = p1[1]; mx4[2] = p1[2]; mx4[3] = p1[3]; }
    if constexpr (HALF != 1) {
#pragma unroll
        for (int r = (HALF == 2 ? 4 : 0); r < 16; ++r) mx4[r & 3] = fmaxf(mx4[r & 3], p1[r]); }
    float pmax = fmaxf(fmaxf(mx4[0], mx4[1]), fmaxf(mx4[2], mx4[3]));
    { auto rr = __builtin_amdgcn_permlane32_swap(__float_as_uint(pmax), __float_as_uint(pmax), false, false); pmax = fmaxf(__uint_as_float(rr[0]), __uint_as_float(rr[1])); }
    float mn;
    if (__builtin_expect(__all(pmax - m_reg <= THR), 1)) { mn = m_reg; alpha = 1.f; }
    else { mn = fmaxf(m_reg, pmax); alpha = __builtin_amdgcn_exp2f(m_reg - mn); m_reg = mn; }
    if constexpr (HALF != 2) {
#pragma unroll
        for (int r = 0; r < 16; ++r) p0[r] = __builtin_amdgcn_exp2f(p0[r] - mn); }
    if constexpr (HALF != 1) {
#pragma unroll
        for (int r = 0; r < 16; ++r) p1[r] = __builtin_amdgcn_exp2f(p1[r] - mn); }
    float ps4[4];
#pragma unroll
    for (int c = 0; c < 4; ++c) { float a_ = 0.f;
        if constexpr (HALF != 2) { a_ = p0[4 * c] + p0[4 * c + 1]; a_ += p0[4 * c + 2]; a_ += p0[4 * c + 3]; }
        if constexpr (HALF != 1) { a_ += p1[4 * c]; a_ += p1[4 * c + 1]; a_ += p1[4 * c + 2]; a_ += p1[4 * c + 3]; }
        ps4[c] = a_; }
    float ps = (ps4[0] + ps4[1]) + (ps4[2] + ps4[3]);
    { auto rr = __builtin_amdgcn_permlane32_swap(__float_as_uint(ps), __float_as_uint(ps), false, false); ps = __uint_as_float(rr[0]) + __uint_as_float(rr[1]); }
    l_reg = l_reg * alpha + ps;
#define PK4(P, BASE, OUT) do { unsigned a0 = cvtpk(P[BASE + 0], P[BASE + 1]), a1 = cvtpk(P[BASE + 2], P[BASE + 3]);   \
    unsigned b0 = cvtpk(P[BASE + 4], P[BASE + 5]), b1 = cvtpk(P[BASE + 6], P[BASE + 7]);                              \
    auto r0 = __builtin_amdgcn_permlane32_swap(a0, b0, false, false); auto r1 = __builtin_amdgcn_permlane32_swap(a1, b1, false, false); \
    v4u w = {r0[0], r1[0], r0[1], r1[1]}; OUT = __builtin_bit_cast(bf16x8, w); } while (0)
    if constexpr (HALF != 2) { PK4(p0, 0, pa0); PK4(p0, 8, pa1); }
    if constexpr (HALF != 1) { PK4(p1, 0, pa2); PK4(p1, 8, pa3); }
#undef PK4
}
template <int T, int QH> __device__ __forceinline__ void dil_step_sm(f32x16 (&o)[2], const bf16x8 (&qr)[4], float& m_reg, float& l_reg, const LAS float* Tb, const LAS unsigned char* Kt, LAS float* wsf,
                                                                      int r32, int hi, bf16x8& pa0, bf16x8& pa1, bf16x8& pa2, bf16x8& pa3) {
    constexpr int HALF = (T == 0 && QH == 1) ? 2 : ((T == 2 && QH == 0) ? 1 : 0);
    f32x16 p0, p1;
    { const LAS float* tp = Tb + (64 * T - 64 - 32 * QH - r32 + 4 * hi + DT_OFF);
      if constexpr (HALF != 2) {
#pragma unroll
        for (int r = 0; r < 16; ++r) p0[r] = tp[(r & 3) + 8 * (r >> 2)]; }
      if constexpr (HALF != 1) {
#pragma unroll
        for (int r = 0; r < 16; ++r) p1[r] = tp[32 + (r & 3) + 8 * (r >> 2)]; } }
#pragma unroll
    for (int d0 = 0; d0 < 4; ++d0) { const int cb = (d0 * 16 + hi * 8) * 2;
        if constexpr (HALF != 2) { const bf16x8 k0 = *(const LAS bf16x8*)(Kt + KSWZ64(r32, cb)); p0 = __builtin_amdgcn_mfma_f32_32x32x16_bf16(k0, qr[d0], p0, 0, 0, 0); }
        if constexpr (HALF != 1) { const bf16x8 k1 = *(const LAS bf16x8*)(Kt + KSWZ64(32 + r32, cb)); p1 = __builtin_amdgcn_mfma_f32_32x32x16_bf16(k1, qr[d0], p1, 0, 0, 0); } }
    float alpha;
    dil_softmax<HALF>(p0, p1, m_reg, l_reg, alpha, pa0, pa1, pa2, pa3);
    if (__any(alpha < 1.f)) { if (hi == 0) wsf[r32] = alpha; asm volatile("s_waitcnt lgkmcnt(0)" ::: "memory");
#pragma unroll
        for (int d = 0; d < 2; ++d)
#pragma unroll
            for (int r = 0; r < 16; ++r) o[d][r] *= wsf[crow(r, hi)]; }
}
template <int T, int QH> __device__ __forceinline__ void dil_step_pv(f32x16 (&o)[2], int vb, bf16x8 pa0, bf16x8 pa1, bf16x8 pa2, bf16x8 pa3) {
    constexpr int HALF = (T == 0 && QH == 1) ? 2 : ((T == 2 && QH == 0) ? 1 : 0);
    asm volatile("s_waitcnt lgkmcnt(0)" ::: "memory"); SBAR();
    if constexpr (HALF != 2) { pv_step<2, 2, 0>(o, vb, pa0); pv_step<2, 2, 1>(o, vb, pa1); }
    if constexpr (HALF != 1) { pv_step<2, 2, 2>(o, vb, pa2); pv_step<2, 2, 3>(o, vb, pa3); }
    SBAR();
}
struct DilState { bf16x8 buf[8]; bf16x8 qr[2][4]; };
__device__ __forceinline__ void dil_prefetch(DilState& st, const bf16* __restrict__ proj, int b, int h, int sb, int it, int lane) {
    const int r32 = lane & 31, hi = lane >> 5;
    const int p = it >> 4, w = it & 15, dsh = 2 * p;
    const int per = 16 >> dsh, res = w / per, mq0 = sb * (1024 >> dsh) + (w % per) * 64;
    const size_t rowb = (size_t)b * SEQ; const int t_lo = (mq0 - 64 < 0) ? 1 : 0;
    const size_t gstride = ((size_t)8 << dsh) * NIN; const unsigned voff = (unsigned)(((lane >> 3) << dsh) * NIN + (lane & 7) * 8);
    const bf16* colK = proj + (rowb + res) * NIN + COL_KD + h * 64;
    dil_load(st.buf, colK + ((size_t)(mq0 - 64 + 64 * t_lo) << dsh) * NIN, gstride, voff);
#pragma unroll
    for (int qh = 0; qh < 2; ++qh) { const bf16* Qw = proj + (rowb + ((size_t)(mq0 + 32 * qh + r32) << dsh) + res) * NIN + COL_QD + h * 64 + hi * 8;
#pragma unroll
      for (int d0 = 0; d0 < 4; ++d0) st.qr[qh][d0] = ld8(Qw + d0 * 16); }
}
__device__ __forceinline__ void dil_item(DilState& st, const bf16* __restrict__ proj, bf16* scrO, float* scrL, int b, int h, int sb, int it, int it_next, LAS unsigned char* lds, int wid, int lane_in) {
    int lane = lane_in; asm volatile("" : "+v"(lane));
    const int r32 = lane & 31, hi = lane >> 5;
    const int p = it >> 4, w = it & 15, dsh = 2 * p;
    const int per = 16 >> dsh, res = w / per, mq0 = sb * (1024 >> dsh) + (w % per) * 64, m_len = SEQ >> dsh;
    const LAS float* Tb = (const LAS float*)(lds + DL_T) + p * DT_LEN; LAS float* wsf = (LAS float*)(lds + DL_WS) + wid * 64;
    LAS unsigned char* Kt = lds + DL_K + wid * 8192; LAS unsigned char* Vt = lds + DL_V + wid * 8192;
    const int vb = (int)(unsigned)(uintptr_t)Vt + v_rd_base(lane);
    const size_t rowb = (size_t)b * SEQ;
    const int t_lo = (mq0 - 64 < 0) ? 1 : 0, t_hi = (mq0 + 64 >= m_len) ? 1 : 2;
    bf16x8 (&buf)[8] = st.buf; bf16x8 (&qr)[2][4] = st.qr;
    const size_t gstride = ((size_t)8 << dsh) * NIN; const unsigned voff = (unsigned)(((lane >> 3) << dsh) * NIN + (lane & 7) * 8);
    const bf16* colK = proj + (rowb + res) * NIN + COL_KD + h * 64; const bf16* colV = proj + (rowb + res) * NIN + COL_VD + h * 64;
    f32x16 o[2][2];
#pragma unroll
    for (int qh = 0; qh < 2; ++qh) { o[qh][0] = f32x16{}; o[qh][1] = f32x16{}; }
    float m_reg[2] = {-1e4f, -1e4f}, l_reg[2] = {0.f, 0.f};
#define DIL_TILE(T) do { if ((T) >= t_lo && (T) <= t_hi) { const int kbase = mq0 - 64 + 64 * (T); bf16x8 pa0, pa1, pa2, pa3; \
        _Pragma("unroll") for (int g = 0; g < 8; ++g) *(LAS bf16x8*)(Kt + KSWZ64(g * 8 + (lane >> 3), (lane & 7) * 16)) = buf[g];        \
        dil_load(buf, colV + ((size_t)kbase << dsh) * NIN, gstride, voff);                                                                \
        dil_step_sm<T, 0>(o[0], qr[0], m_reg[0], l_reg[0], Tb, Kt, wsf, r32, hi, pa0, pa1, pa2, pa3); \
        _Pragma("unroll") for (int g = 0; g < 8; ++g) *(LAS bf16x8*)(Vt + v_st<2>(g * 8 + (lane >> 3), (lane & 7) * 8)) = buf[g];          \
        if ((T) < t_hi) dil_load(buf, colK + ((size_t)(kbase + 64) << dsh) * NIN, gstride, voff);                                         \
        dil_step_pv<T, 0>(o[0], vb, pa0, pa1, pa2, pa3); \
        dil_step_sm<T, 1>(o[1], qr[1], m_reg[1], l_reg[1], Tb, Kt, wsf, r32, hi, pa0, pa1, pa2, pa3); \
        dil_step_pv<T, 1>(o[1], vb, pa0, pa1, pa2, pa3); } } while (0)
    DIL_TILE(0); DIL_TILE(1); DIL_TILE(2);
#undef DIL_TILE
    if (it_next >= 0) dil_prefetch(st, proj, b, h, sb, it_next, lane);
    LAS unsigned* stg = (LAS unsigned*)Kt;
#pragma unroll
    for (int qh = 0; qh < 2; ++qh) {
        if (hi == 0) { wsf[32 + r32] = l_reg[qh]; const int tl = (((mq0 + 32 * qh + r32) << dsh) + res) & 1023; scrL[p * 1024 + tl] = m_reg[qh] + __builtin_amdgcn_logf(l_reg[qh]); }
        asm volatile("s_waitcnt lgkmcnt(0)" ::: "memory");
        const bool odd = r32 & 1;
#pragma unroll
        for (int r = 0; r < 16; ++r) { const int i = 32 * qh + crow(r, hi); const float rl = __builtin_amdgcn_rcpf(wsf[32 + crow(r, hi)]);
            const float v0 = o[qh][0][r] * rl, v1 = o[qh][1][r] * rl;
            const float got = __builtin_bit_cast(float, __builtin_amdgcn_update_dpp(0, __builtin_bit_cast(int, odd ? v0 : v1), 0xB1, 0xF, 0xF, false));
            const unsigned pk = odd ? cvtpk(got, v1) : cvtpk(v0, got);
            stg[i * 32 + (odd ? 16 + (r32 >> 1) : (r32 >> 1))] = pk; }
        asm volatile("s_waitcnt lgkmcnt(0)" ::: "memory");
    }
#pragma unroll
    for (int g = 0; g < 8; ++g) { const int i = g * 8 + (lane >> 3), ch = lane & 7; const int tl = (((mq0 + i) << dsh) + res) & 1023;
        const v4u wv = *(const LAS v4u*)(Kt + i * 128 + ch * 16);
        *(v4u*)(scrO + ((size_t)p * 1024 + tl) * 64 + ch * 8) = wv; }
}
__device__ __forceinline__ void dil_unit(const bf16* __restrict__ proj, bf16* __restrict__ attn, const float* relb, float* scr, int b, int h, int sb, LAS unsigned char* lds, int tid) {
    const int wid = __builtin_amdgcn_readfirstlane(tid >> 6), lane = tid & 63;
    LAS float* T = (LAS float*)(lds + DL_T);
    for (int i = tid; i < 3 * DT_LEN; i += NWAVES * 64) { const int p = i / DT_LEN, off = i % DT_LEN - DT_OFF; const int dil = 1 << (2 * p);
        T[i] = (off >= -64 && off <= 64) ? relb[(unsigned)(t5_bucket(off * dil) * 12 + 4 + h)] * LOG2E : -1e30f; }
    __syncthreads();
    bf16* scrO = (bf16*)((unsigned char*)scr + DSCR_O); float* scrL = (float*)((unsigned char*)scr + DSCR_L);
    DilState st; dil_prefetch(st, proj, b, h, sb, wid, lane);
#pragma unroll 1
    for (int k = 0; k < 6; ++k) dil_item(st, proj, scrO, scrL, b, h, sb, k * 8 + wid, k < 5 ? (k + 1) * 8 + wid : -1, lds, wid, lane);
    asm volatile("s_waitcnt vmcnt(0)" ::: "memory");
    __syncthreads();
    __builtin_amdgcn_fence(__ATOMIC_ACQUIRE, "agent");
    asm volatile("s_waitcnt vmcnt(0)" ::: "memory");
#pragma unroll 1
    for (int n = 0; n < 16; ++n) { const int i = tid + 512 * n, tl = i >> 3, ch = i & 7;
        const float l0 = scrL[tl], l1 = scrL[1024 + tl], l2 = scrL[2048 + tl]; const float mx = fmaxf(l0, fmaxf(l1, l2));
        float w0 = __builtin_amdgcn_exp2f(l0 - mx), w1 = __builtin_amdgcn_exp2f(l1 - mx), w2 = __builtin_amdgcn_exp2f(l2 - mx); const float rs = 1.f / (w0 + w1 + w2); w0 *= rs; w1 *= rs; w2 *= rs;
        const v4u s0 = *(const v4u*)(scrO + (size_t)tl * 64 + ch * 8), s1 = *(const v4u*)(scrO + ((size_t)1024 + tl) * 64 + ch * 8), s2 = *(const v4u*)(scrO + ((size_t)2048 + tl) * 64 + ch * 8);
        f32x4 a0, a1;
        a0.x = bflo(s0.x) * w0 + bflo(s1.x) * w1 + bflo(s2.x) * w2; a0.y = bfhi(s0.x) * w0 + bfhi(s1.x) * w1 + bfhi(s2.x) * w2;
        a0.z = bflo(s0.y) * w0 + bflo(s1.y) * w1 + bflo(s2.y) * w2; a0.w = bfhi(s0.y) * w0 + bfhi(s1.y) * w1 + bfhi(s2.y) * w2;
        a1.x = bflo(s0.z) * w0 + bflo(s1.z) * w1 + bflo(s2.z) * w2; a1.y = bfhi(s0.z) * w0 + bfhi(s1.z) * w1 + bfhi(s2.z) * w2;
        a1.z = bflo(s0.w) * w0 + bflo(s1.w) * w1 + bflo(s2.w) * w2; a1.w = bfhi(s0.w) * w0 + bfhi(s1.w) * w1 + bfhi(s2.w) * w2;
        v4u wv; wv.x = pk2(a0.x, a0.y); wv.y = pk2(a0.z, a0.w); wv.z = pk2(a1.x, a1.y); wv.w = pk2(a1.z, a1.w);
        *(v4u*)(attn + ((size_t)b * SEQ + sb * 1024 + tl) * DM + 512 + h * 64 + ch * 8) = wv; }
    asm volatile("s_waitcnt vmcnt(0)" ::: "memory");
    __syncthreads();
}
#undef KSWZ
#undef KSWZ16
#undef KSWZ64
#undef SBAR
}

__device__ __forceinline__ void p2_attention(Frame& F, const Args& a) {
    const bf16* proj = (const bf16*)(a.ws + WS_PROJ); bf16* attn = (bf16*)(a.ws + WS_ATT);
    float s1 = 0.f, s2 = 0.f;
    for (int i = 0; i < 64; ++i) { s1 += a.lq1[i] * a.lk1[i]; s2 += a.lq2[i] * a.lk2[i]; }
    float lam_v = expf(s1) - expf(s2) + LAMBDA_INIT; asm volatile("" : "+v"(lam_v));
    const int lam_bits = __builtin_amdgcn_readfirstlane(__builtin_bit_cast(int, lam_v));
    const float lam = __builtin_bit_cast(float, lam_bits);
    const int bx = (int)blockIdx.x, G = F.G;
#ifndef NO_DIFF
#if MK_DIFF2
    if (a.variant != 2) for (int L = bx; L < 64 * 16; L += G) {
        int bh, qb; if (G == 256) { const int slot = (L & 255) >> 3; bh = (L >> 8) * 16 + (L & 7) * 2 + (slot >> 4); qb = slot & 15; } else { bh = L >> 4; qb = L & 15; }
        if (!att::diff_unit3(proj, attn, a.relb, a.subln, lam, bh >> 2, bh & 3, qb, F.lds + RING_OFF, F.wave * 64 + fresh_lane()))
            att::diff_unit2(proj, attn, a.relb, a.subln, lam, bh >> 2, bh & 3, qb, F.lds + RING_OFF, F.wave * 64 + fresh_lane());
    }
#else
    if (a.variant != 2) for (int L = bx; L < 64 * 32; L += G) {
        int bh, qb; if (G == 256) { bh = (L >> 8) * 8 + (L & 7); qb = (L & 255) >> 3; } else { bh = L >> 5; qb = L & 31; }
        att::diff_unit(proj, attn, a.relb, a.subln, lam, bh >> 2, bh & 3, qb, F.lds + RING_OFF, F.wave * 64 + fresh_lane());
    }
#endif
#endif
#ifndef NO_DIL
    float* scr = (float*)(a.ws + WS_DSCR + (size_t)bx * att::DSCR_BYTES);
    if (a.variant != 1) for (int L = bx; L < 128 * 4; L += G) {
        int bh, sb; if (G == 256) { bh = (L >> 8) * 64 + (L & 7) * 8 + ((L & 255) >> 5); sb = ((L & 255) >> 3) & 3; } else { bh = L >> 2; sb = L & 3; }
        att::dil_unit(proj, attn, a.relb, scr, bh >> 3, bh & 7, sb, F.lds + RING_OFF, F.wave * 64 + fresh_lane());
    }
#endif
}


constexpr int N_PHASES = 9;
__global__ void __launch_bounds__(NWAVES * 64, 2) mega(Args args) {
    extern __shared__ __attribute__((aligned(16))) unsigned char lds[];
    Frame F;
    F.lds = (LAS unsigned char*)lds;
    F.MISC = (volatile LAS unsigned*)(F.lds + MISC_OFF);
    F.wave = __builtin_amdgcn_readfirstlane((int)threadIdx.x >> 6);
    F.G = gridDim.x; { const int bx = blockIdx.x; F.vcu = (F.G % 8 == 0) ? (bx % 8) * (F.G / 8) + bx / 8 : bx; }
    unsigned char* ws = args.ws;
    gu32* ctl = (gu32*)(ws + WS_CTL);
    const int tid0 = F.wave * 64 + fresh_lane();
    for (int u = tid0; u < (LDS_BYTES - LDSCTL_OFF) / 4; u += NWAVES * 64) ((LAS unsigned*)(F.lds + LDSCTL_OFF))[u] = 0u;
    __syncthreads();
    XcdBarrier bar; bar.bar = (unsigned*)(ctl + CW_BAR); bar.x = 0; bar.st = nullptr;
    const int lo = args.ph_lo, hi = args.ph_hi;
    if (hi - lo > 1) bar = xcd_barrier_post((unsigned*)(ctl + CW_BAR), F.MISC + 8, tid0);
#ifdef ONLY_PHASE
#define IN(k) ((k) == ONLY_PHASE && lo <= (k) && (k) < hi)
#else
#define IN(k) (lo <= (k) && (k) < hi)
#endif
#define SEAM(k) do { if (IN(k) && IN((k) + 1)) xcd_barrier(bar, F.wave * 64 + fresh_lane()); } while (0)
#ifdef FDUP
#define AGAIN(k) (((FDUP >> (k)) & 1) && hi - lo > 1)
#else
#define AGAIN(k) false
#endif

    if (IN(0)) { p0_prologue(F, args); if (AGAIN(0)) { xcd_barrier(bar, F.wave * 64 + fresh_lane()); p0_prologue(F, args); } } SEAM(0);
    const int bxi = (int)blockIdx.x;
    if (IN(1)) {
        pg8::Gemm g{(const bf16*)(ws + WS_H1), (const bf16*)(ws + WS_WIN), NTOK, NIN, DM}; pg8::StaticOrder S; S.init(NTOK, NIN, F.G, bxi);
        pg8::EpiProj E{(bf16*)(ws + WS_PROJ), QSCALE};
        pg8::gemm_phase<pg8::EpiProj, pg8::StaticOrder, true, true>(F.lds + RING_OFF, g, S, E, F.wave);
    } SEAM(1);
    if (IN(2)) { p2_attention(F, args); } SEAM(2);
    if (IN(3)) {
        pg8::Gemm g{(const bf16*)(ws + WS_ATT), (const bf16*)(ws + WS_WOUT), NTOK, DM, DM}; pg8::StaticOrder S; S.init(NTOK, DM, F.G, (int)blockIdx.x);
        pg8::EpiResBf16 E{args.x, (bf16*)(ws + WS_X2)};
        pg8::gemm_phase<pg8::EpiResBf16, pg8::StaticOrder, true, true>(F.lds + RING_OFF, g, S, E, F.wave);
    } SEAM(3);
    if (IN(4)) { p4_router(F, args); if (AGAIN(4)) { xcd_barrier(bar, F.wave * 64 + fresh_lane()); p4_router(F, args); } } SEAM(4);
    if (IN(5)) { p5_topk(F, args); if (AGAIN(5)) { xcd_barrier(bar, F.wave * 64 + fresh_lane()); p5_topk(F, args); } } SEAM(5);
    if (IN(6)) {
        pg8::Gemm g{(const bf16*)(ws + WS_XE), (const bf16*)(ws + WS_W1T), 0, 0, DM / 2}; pg8::MoeOrder S; S.init(5632, F.G, bxi);
        pg8::EpiSwiGLU8 E{ws + WS_HE};
      for (int rep = 0; rep < (AGAIN(6) ? 2 : 1); ++rep) {
        if (rep) xcd_barrier(bar, F.wave * 64 + fresh_lane());
#if MK_FP6
#if MK_FP6 == 2
        pg8::EpiSwiGLU6 E6{ws + WS_HE};
        pg8::gemm_phase6<pg8::EpiSwiGLU6, pg8::MoeOrder, true, 8>(F.lds + RING_OFF, ws + WS_XE, ws + WS_W1T, S, E6, F.wave);
#else
        pg8::gemm_phase6<pg8::EpiSwiGLU8, pg8::MoeOrder, true, 8>(F.lds + RING_OFF, ws + WS_XE, ws + WS_W1T, S, E, F.wave);
#endif
#else
        pg8::gemm_phase<pg8::EpiSwiGLU8, pg8::MoeOrder, true, true, true>(F.lds + RING_OFF, g, S, E, F.wave);
#endif
      }
    } SEAM(6);
    if (IN(7)) {
        pg8::Gemm g{(const bf16*)(ws + WS_HE), (const bf16*)(ws + WS_W2T), 0, 0, DFF / 2}; pg8::MoeOrder S; S.init(1024, F.G, (int)blockIdx.x);
        pg8::EpiDown8 E{(bf16*)(ws + WS_YE), (const float*)(ws + WS_GATE)};
      for (int rep = 0; rep < (AGAIN(7) ? 2 : 1); ++rep) {
        if (rep) xcd_barrier(bar, F.wave * 64 + fresh_lane());
#if MK_FP6 == 2
        pg8::gemm_phase6<pg8::EpiDown8, pg8::MoeOrder, true, 22>(F.lds + RING_OFF, ws + WS_HE, ws + WS_W2T, S, E, F.wave);
#else
        pg8::gemm_phase<pg8::EpiDown8, pg8::MoeOrder, true, true, true>(F.lds + RING_OFF, g, S, E, F.wave);
#endif
      }
    } SEAM(7);
    if (IN(8)) { p8_combine(F, args); }
#undef IN
#undef SEAM
#undef AGAIN
}


#if MK_NAIVE_ATTN
__global__ __launch_bounds__(256) void naive_diff_attn(Args a) {
    __shared__ float Ks[32][128]; __shared__ float Vs[32][128]; __shared__ float T[2048];
    const int bh = blockIdx.x >> 5, qb = blockIdx.x & 31, b = bh >> 2, h = bh & 3;
    const int t = threadIdx.x, qi = t >> 1, sub = t & 1;
    const bf16* proj = (const bf16*)(a.ws + WS_PROJ); bf16* att = (bf16*)(a.ws + WS_ATT);
    for (int i = t; i < 2048; i += 256) T[i] = a.relb[t5_bucket(i - 1024) * 12 + h] * LOG2E;
    float s1 = 0.f, s2 = 0.f;
    for (int i = 0; i < 64; ++i) { s1 += a.lq1[i] * a.lk1[i]; s2 += a.lq2[i] * a.lk2[i]; }
    const float lam = expf(s1) - expf(s2) + LAMBDA_INIT;
    const int qpos = qb * 128 + qi; const size_t qrow = (size_t)(b * SEQ + qpos) * NIN;
    float q[64];
#pragma unroll
    for (int j = 0; j < 64; ++j) q[j] = bf2f(proj[qrow + COL_QA + h * 128 + sub * 64 + j]);
    float o[128];
#pragma unroll
    for (int d = 0; d < 128; ++d) o[d] = 0.f;
    float m = -1e30f, l = 0.f;
    for (int kt = 0; kt < SEQ; kt += 32) {
        __syncthreads();
        for (int i = t; i < 4096; i += 256) { const int r = i >> 7, c = i & 127; const size_t row = (size_t)(b * SEQ + kt + r) * NIN;
            Ks[r][c] = bf2f(proj[row + COL_KA + h * 128 + c]); Vs[r][c] = bf2f(proj[row + COL_VA + h * 128 + c]); }
        __syncthreads();
        for (int kk = 0; kk < 32; ++kk) {
            float s = 0.f;
#pragma unroll
            for (int j = 0; j < 64; ++j) s += q[j] * Ks[kk][sub * 64 + j];
            int rel = kt + kk - qpos; rel = rel < -1024 ? -1024 : (rel > 1023 ? 1023 : rel);
            s += T[rel + 1024];
            if (s > m) { const float f = exp2f(m - s); l *= f;
#pragma unroll
                for (int d = 0; d < 128; ++d) o[d] *= f;
                m = s; }
            const float p = exp2f(s - m); l += p;
#pragma unroll
            for (int d = 0; d < 128; ++d) o[d] += p * Vs[kk][d];
        }
    }
    const float sc = (sub ? -lam : 1.f) / l; float ss = 0.f;
#pragma unroll
    for (int d = 0; d < 128; ++d) { float v = o[d] * sc; v += __shfl_xor(v, 1); o[d] = v; ss += v * v; }
    const float r = 1.f / sqrtf(ss * (1.f / 128.f) + SUBLN_EPS);
    if (sub == 0) {
#pragma unroll
        for (int d = 0; d < 128; ++d) att[(size_t)(b * SEQ + qpos) * DM + h * 128 + d] = (bf16)f2bf(o[d] * r * a.subln[d] * (1.f - LAMBDA_INIT));
    }
}
__global__ __launch_bounds__(256) void naive_dilated(Args a) {
    const int gid = blockIdx.x * 256 + threadIdx.x, h = gid & 7, tok = gid >> 3, b = tok >> 12, pos = tok & 4095;
    const bf16* proj = (const bf16*)(a.ws + WS_PROJ); bf16* att = (bf16*)(a.ws + WS_ATT);
    float q[64], o[64];
#pragma unroll
    for (int j = 0; j < 64; ++j) { q[j] = bf2f(proj[(size_t)tok * NIN + COL_QD + h * 64 + j]); o[j] = 0.f; }
    float m = -1e30f, l = 0.f;
    for (int p = 0; p < 3; ++p) { const int dil = p == 0 ? 1 : (p == 1 ? 4 : 16);
        for (int j = -64; j <= 64; ++j) { const int pk = pos + j * dil; if (pk < 0 || pk >= SEQ) continue;
            const size_t row = (size_t)(b * SEQ + pk) * NIN; float s = 0.f;
#pragma unroll
            for (int d = 0; d < 64; ++d) s += q[d] * bf2f(proj[row + COL_KD + h * 64 + d]);
            s += a.relb[t5_bucket(j * dil) * 12 + 4 + h] * LOG2E;
            if (s > m) { const float f = exp2f(m - s); l *= f;
#pragma unroll
                for (int d = 0; d < 64; ++d) o[d] *= f;
                m = s; }
            const float pw = exp2f(s - m); l += pw;
#pragma unroll
            for (int d = 0; d < 64; ++d) o[d] += pw * bf2f(proj[row + COL_VD + h * 64 + d]);
        } }
    const float il = 1.f / l;
#pragma unroll
    for (int d = 0; d < 64; ++d) att[(size_t)tok * DM + 512 + h * 64 + d] = (bf16)f2bf(o[d] * il);
}
static void launch_naive_attention(const Args& a, hipStream_t stream) {
    hipLaunchKernelGGL(naive_diff_attn, dim3(64 * 32), dim3(256), 0, stream, a);
    hipLaunchKernelGGL(naive_dilated, dim3(NTOK * 8 / 256), dim3(256), 0, stream, a);
}
#endif


extern "C" void kernel_launch(void* const* d_in, const int* in_sizes, int n_in, void* d_out, int out_size, void* d_ws, size_t ws_size, hipStream_t stream) {
    static int grid = 0;
    if (grid == 0) {
        if (n_in != 16 || in_sizes[0] != NTOK * DM || out_size != NTOK * DM || ws_size < WS_END) {
            fprintf(stderr, "kernel_launch: shape/workspace mismatch (n_in %d, in0 %d, out %d, ws %zu, need %zu); nothing launched\n", n_in, n_in > 0 ? in_sizes[0] : -1, out_size, ws_size, (size_t)WS_END); grid = -1; return; }
        int dev = 0, cus = 0, per_cu = 0;
        if (hipGetDevice(&dev) != hipSuccess || hipDeviceGetAttribute(&cus, hipDeviceAttributeMultiprocessorCount, dev) != hipSuccess) { grid = -1; return; }
        if (hipFuncSetAttribute((const void*)mega, hipFuncAttributeMaxDynamicSharedMemorySize, LDS_BYTES) != hipSuccess) { fprintf(stderr, "kernel_launch: hipFuncSetAttribute failed\n"); grid = -1; return; }
        if (hipOccupancyMaxActiveBlocksPerMultiprocessor(&per_cu, (const void*)mega, NWAVES * 64, LDS_BYTES) != hipSuccess || per_cu < 1) { fprintf(stderr, "kernel_launch: occupancy query says %d\n", per_cu); }
        (void)hipGetLastError();
        grid = cus;
    }
    if (grid < 0) return;
    (void)hipMemsetAsync((char*)d_ws + WS_CTL, 0, CTL_ZERO_BYTES, stream);
    Args a{};
    a.x = (const float*)d_in[0]; a.g1 = (const float*)d_in[1]; a.w_in = (const float*)d_in[2]; a.lq1 = (const float*)d_in[3]; a.lk1 = (const float*)d_in[4]; a.lq2 = (const float*)d_in[5]; a.lk2 = (const float*)d_in[6];
    a.subln = (const float*)d_in[7]; a.w_out = (const float*)d_in[8]; a.relb = (const float*)d_in[9]; a.g2 = (const float*)d_in[10]; a.w_router = (const float*)d_in[11];
    a.w_gate = (const float*)d_in[12]; a.w_up = (const float*)d_in[13]; a.w_down = (const float*)d_in[14]; a.gf = (const float*)d_in[15];
    a.out = (float*)d_out; a.ws = (unsigned char*)d_ws;
#if MK_MODE == 0
    a.ph_lo = 0; a.ph_hi = N_PHASES;
    hipLaunchKernelGGL(mega, dim3(grid), dim3(NWAVES * 64), LDS_BYTES, stream, a);
#else
    for (int p = 0; p < N_PHASES; ++p) {
#if MK_NAIVE_ATTN
        if (p == 2) { launch_naive_attention(a, stream); continue; }
#endif
        a.ph_lo = p; a.ph_hi = p + 1; a.variant = 0;
#ifdef MK_FUSE_LO
        if (p == MK_FUSE_LO) { a.ph_hi = MK_FUSE_HI; hipLaunchKernelGGL(mega, dim3(grid), dim3(NWAVES * 64), LDS_BYTES, stream, a); p = MK_FUSE_HI - 1; continue; }
#endif
        hipLaunchKernelGGL(mega, dim3(grid), dim3(NWAVES * 64), LDS_BYTES, stream, a);
#ifdef MK_DUP
        if ((MK_DUP >> p) & 1) { a.variant = MK_DUPVAR; hipLaunchKernelGGL(mega, dim3(grid), dim3(NWAVES * 64), LDS_BYTES, stream, a); }
#endif
    }
#endif
    const hipError_t le = hipPeekAtLastError();
    if (le != hipSuccess) fprintf(stderr, "kernel_launch: launch failed: %s\n", hipGetErrorName(le));
}
```
